# Optimizing an MI355X kernel written in HIP

```python
import math
import jax, jax.numpy as jnp
from jax import lax
import numpy as np

D_MODEL = 1024
BATCH = 8
SEQ = 2048
DEPTH = 4
DEC_BATCH = 128
DEC_SEQ = 1
PAST_LEN = 16384
PAGE_SIZE = 128

N_EVEN = (DEPTH + 1) // 2
N_ODD = DEPTH // 2
POOL_WINDOWS = (2, 4, 8, 16)
N_POOL_GROUPS = len(POOL_WINDOWS)
D_POOL = D_MODEL
POOL_GROUP = D_POOL // N_POOL_GROUPS
POOL_BUF = max(POOL_WINDOWS) - 1
D_CONV = D_MODEL
CONV_K = 3
EVEN_IN = 2 * D_POOL + 4 * D_CONV
EVEN_MIX = D_POOL + D_CONV
SSM_EXPAND = 2
D_INNER = SSM_EXPAND * D_MODEL
SSM_HEAD_DIM = 64
SSM_HEADS = D_INNER // SSM_HEAD_DIM
SSM_GROUPS = 4
SSM_HEADS_PER_GROUP = SSM_HEADS // SSM_GROUPS
SSM_STATE = 128
SSM_CONV_K = 4
SSM_CONV_DIM = D_INNER + 2 * SSM_GROUPS * SSM_STATE
ODD_IN = D_INNER + SSM_CONV_DIM + SSM_HEADS
SSM_CHUNK = 128
N_MEM = 256
XA_HEADS = 4
XA_HEAD_DIM = D_MODEL // XA_HEADS
EPS = 1e-6

kernel_name = 'pool_conv_ssd_memxattn_decoder_step'


def rmsnorm(x, g):
    xf = x.astype(jnp.float32)
    y = xf * lax.rsqrt(jnp.mean(xf * xf, axis=-1, keepdims=True) + EPS)
    return (y * g.astype(jnp.float32)).astype(x.dtype)


def causal_dwconv(v, prefix, w):
    K = w.shape[0]
    L = v.shape[1]
    ext = jnp.concatenate([prefix.astype(v.dtype), v], axis=1)
    out = ext[:, 0:L] * w[0]
    for k in range(1, K):
        out = out + ext[:, k:k + L] * w[k]
    return out, ext[:, ext.shape[1] - (K - 1):]


def pool_mixer(u, prefix, pos0, w_grp, scale):
    b, L, _ = u.shape
    f32 = jnp.float32
    ext = jnp.concatenate([prefix.astype(u.dtype), u], axis=1).astype(f32)
    cs = jnp.concatenate([jnp.zeros((b, 1, D_POOL), f32), jnp.cumsum(ext, axis=1)], axis=1)
    pos = pos0 + jnp.arange(L)
    end = cs[:, POOL_BUF + 1:]
    uf = u.astype(f32)
    outs = []
    for g, w in enumerate(POOL_WINDOWS):
        sl = slice(g * POOL_GROUP, (g + 1) * POOL_GROUP)
        start = cs[:, POOL_BUF + 1 - w:POOL_BUF + 1 - w + L, sl]
        cnt = jnp.minimum(pos + 1, w).astype(f32)[None, :, None]
        diff = ((end[..., sl] - start) / cnt - uf[..., sl]).astype(u.dtype)
        outs.append(diff @ w_grp[g])
    y = jnp.concatenate(outs, axis=-1) * scale
    return y, ext[:, ext.shape[1] - POOL_BUF:].astype(u.dtype)


def even_mixer(h, pool_prefix, conv_prefix, pos0, w_in, pool_w, pool_scale, conv_w, w_out):
    proj = h @ w_in
    c0 = D_POOL
    c1 = c0 + D_POOL
    c2 = c1 + D_CONV
    c3 = c2 + D_CONV
    c4 = c3 + D_CONV
    u, g_pool = proj[..., :c0], proj[..., c0:c1]
    b_gate, c_gate, v, g_conv = proj[..., c1:c2], proj[..., c2:c3], proj[..., c3:c4], proj[..., c4:]
    y_pool, pool_buf = pool_mixer(u, pool_prefix, pos0, pool_w, pool_scale)
    y_pool = y_pool * jax.nn.silu(g_pool)
    conv_out, conv_buf = causal_dwconv(c_gate * v, conv_prefix, conv_w)
    y_conv = b_gate * conv_out * jax.nn.silu(g_conv)
    return jnp.concatenate([y_pool, y_conv], axis=-1) @ w_out, pool_buf, conv_buf


def ssd_scan(x, dt, A, Bm, Cm, s0):
    b, L = x.shape[:2]
    Q = SSM_CHUNK if L % SSM_CHUNK == 0 else L
    nc = L // Q
    x = x.reshape((b, nc, Q) + x.shape[2:])
    dt = dt.reshape((b, nc, Q) + dt.shape[2:])
    Bm = Bm.reshape((b, nc, Q) + Bm.shape[2:])
    Cm = Cm.reshape((b, nc, Q) + Cm.shape[2:])
    a_cs = jnp.cumsum(dt * A, axis=2)
    xdt = x * dt[..., None]
    causal = jnp.tril(jnp.ones((Q, Q), bool))[:, :, None, None]
    seg = a_cs[:, :, :, None] - a_cs[:, :, None, :]
    decay = jnp.exp(jnp.where(causal, seg, -jnp.inf))
    cb = jnp.einsum('bclgn,bcsgn->bclsg', Cm, Bm)
    y_diag = jnp.einsum('bclsge,bcsgep->bclgep', cb[..., None] * decay, xdt)
    to_end = jnp.exp(a_cs[:, :, -1:] - a_cs)
    chunk_states = jnp.einsum('bcsgn,bcsgep->bcgepn', Bm, xdt * to_end[..., None])
    chunk_decay = jnp.exp(a_cs[:, :, -1])

    def step(s, inp):
        dec, st = inp
        return dec[..., None, None] * s + st, s

    s_fin, s_in = lax.scan(step, s0, (jnp.moveaxis(chunk_decay, 1, 0), jnp.moveaxis(chunk_states, 1, 0)))
    s_in = jnp.moveaxis(s_in, 0, 1)
    y_off = jnp.einsum('bclgn,bcgepn->bclgep', Cm, s_in) * jnp.exp(a_cs)[..., None]
    y = (y_diag + y_off).reshape((b, L) + x.shape[3:])
    return y, s_fin


def mamba2_mixer(h, conv_prefix, s0, w_in, conv_w, conv_b, dt_bias, a_log, d_skip, norm_w, w_out):
    b, L, _ = h.shape
    f32 = jnp.float32
    G, E, P, N = SSM_GROUPS, SSM_HEADS_PER_GROUP, SSM_HEAD_DIM, SSM_STATE
    proj = h @ w_in
    z = proj[..., :D_INNER]
    xbc = proj[..., D_INNER:D_INNER + SSM_CONV_DIM]
    dt_raw = proj[..., D_INNER + SSM_CONV_DIM:]
    xbc_c, conv_buf = causal_dwconv(xbc, conv_prefix, conv_w)
    xbc_c = jax.nn.silu(xbc_c + conv_b).astype(f32)
    gn = G * N
    xs = xbc_c[..., :D_INNER].reshape(b, L, G, E, P)
    Bm = xbc_c[..., D_INNER:D_INNER + gn].reshape(b, L, G, N)
    Cm = xbc_c[..., D_INNER + gn:].reshape(b, L, G, N)
    dt = jax.nn.softplus(dt_raw.astype(f32) + dt_bias.astype(f32)).reshape(b, L, G, E)
    A = -jnp.exp(a_log.astype(f32)).reshape(G, E)
    y, s_fin = ssd_scan(xs, dt, A, Bm, Cm, s0.astype(f32).reshape(b, G, E, P, N))
    y = y + d_skip.astype(f32).reshape(G, E)[..., None] * xs
    yg = y.reshape(b, L, G, E * P) * jax.nn.silu(z.astype(f32)).reshape(b, L, G, E * P)
    yg = yg * lax.rsqrt(jnp.mean(yg * yg, axis=-1, keepdims=True) + EPS)
    yg = (yg.reshape(b, L, D_INNER) * norm_w.astype(f32)).astype(h.dtype)
    return yg @ w_out, conv_buf, s_fin.reshape(b, SSM_HEADS, P, N).astype(h.dtype)


def mem_xattn(h, mk, mv, wq, wo):
    b, L, _ = h.shape
    q = (h @ wq).reshape(b, L, XA_HEADS, XA_HEAD_DIM).astype(jnp.float32)
    s = jnp.einsum('blhd,bmhd->bhlm', q, mk.astype(jnp.float32)) * (XA_HEAD_DIM ** -0.5)
    p = jax.nn.softmax(s, axis=-1)
    o = jnp.einsum('bhlm,bmhd->blhd', p, mv.astype(jnp.float32)).astype(h.dtype).reshape(b, L, D_MODEL)
    return o @ wo


def run_trunk(x, mem_k, mem_v, pool_st, conv_st, sconv_st, ssm_st, pos0, weights):
    (norm_mix, norm_xa, norm_final, w_in_even, pool_w, pool_scale, conv_w, w_out_even,
     w_in_odd, ssm_conv_w, ssm_conv_b, dt_bias, a_log, d_skip, ssm_norm, w_out_odd,
     w_xa_q, w_xa_o) = weights
    new_pool, new_conv, new_sconv, new_ssm = [], [], [], []
    for l in range(DEPTH):
        i = l // 2
        h = rmsnorm(x, norm_mix[l])
        if l % 2 == 0:
            out, pb, cbuf = even_mixer(h, pool_st[i], conv_st[i], pos0, w_in_even[i], pool_w[i],
                                       pool_scale[i], conv_w[i], w_out_even[i])
            new_pool.append(pb)
            new_conv.append(cbuf)
        else:
            out, sb, ss = mamba2_mixer(h, sconv_st[i], ssm_st[i], w_in_odd[i], ssm_conv_w[i], ssm_conv_b[i],
                                       dt_bias[i], a_log[i], d_skip[i], ssm_norm[i], w_out_odd[i])
            new_sconv.append(sb)
            new_ssm.append(ss)
        x = x + out
        x = x + mem_xattn(rmsnorm(x, norm_xa[l]), mem_k[l], mem_v[l], w_xa_q[l], w_xa_o[l])
    y = rmsnorm(x, norm_final)
    return y, jnp.stack(new_pool), jnp.stack(new_conv), jnp.stack(new_sconv), jnp.stack(new_ssm)


def setup_inputs(seed: int = 0) -> dict:
    key = jax.random.key(seed)
    ks = iter(jax.random.split(key, 32))
    f32 = jnp.float32

    def nrm(shape, scale):
        return jax.random.normal(next(ks), shape, f32) * scale

    x_prompt = nrm((BATCH, SEQ, D_MODEL), 1.0)
    x_sample = nrm((DEC_BATCH, DEC_SEQ, D_MODEL), 1.0)
    mem_prompt = nrm((BATCH, N_MEM, D_MODEL), 1.0)
    cache_mem_k = nrm((DEPTH, DEC_BATCH, N_MEM, XA_HEADS, XA_HEAD_DIM), 1.0)
    cache_mem_v = nrm((DEPTH, DEC_BATCH, N_MEM, XA_HEADS, XA_HEAD_DIM), 1.0)
    state_pool = nrm((N_EVEN, DEC_BATCH, POOL_BUF, D_POOL), 1.0)
    state_conv = nrm((N_EVEN, DEC_BATCH, CONV_K - 1, D_CONV), 1.0)
    state_ssm_conv = nrm((N_ODD, DEC_BATCH, SSM_CONV_K - 1, SSM_CONV_DIM), 1.0)
    state_ssm = nrm((N_ODD, DEC_BATCH, SSM_HEADS, SSM_HEAD_DIM, SSM_STATE), 0.1)

    norm_mix = 1.0 + nrm((DEPTH, D_MODEL), 0.02)
    norm_xa = 1.0 + nrm((DEPTH, D_MODEL), 0.02)
    norm_final = 1.0 + nrm((D_MODEL,), 0.02)

    w_in_even = nrm((N_EVEN, D_MODEL, EVEN_IN), D_MODEL ** -0.5)
    pool_w = nrm((N_EVEN, N_POOL_GROUPS, POOL_GROUP, POOL_GROUP), POOL_GROUP ** -0.5)
    pool_scale = 1.0 + nrm((N_EVEN, D_POOL), 0.02)
    conv_w = nrm((N_EVEN, CONV_K, D_CONV), CONV_K ** -0.5)
    w_out_even = nrm((N_EVEN, EVEN_MIX, D_MODEL), EVEN_MIX ** -0.5)

    w_in_odd = nrm((N_ODD, D_MODEL, ODD_IN), D_MODEL ** -0.5)
    ssm_conv_w = nrm((N_ODD, SSM_CONV_K, SSM_CONV_DIM), SSM_CONV_K ** -0.5)
    ssm_conv_b = nrm((N_ODD, SSM_CONV_DIM), 0.02)
    log_dt = jax.random.uniform(next(ks), (N_ODD, SSM_HEADS), f32, math.log(1e-3), math.log(1e-1))
    dt0 = jnp.exp(log_dt)
    dt_bias = dt0 + jnp.log(-jnp.expm1(-dt0))
    a_log = jnp.log(jax.random.uniform(next(ks), (N_ODD, SSM_HEADS), f32, 1.0, 16.0))
    d_skip = 1.0 + nrm((N_ODD, SSM_HEADS), 0.1)
    ssm_norm = 1.0 + nrm((N_ODD, D_INNER), 0.02)
    w_out_odd = nrm((N_ODD, D_INNER, D_MODEL), D_INNER ** -0.5)

    w_xa_q = nrm((DEPTH, D_MODEL, D_MODEL), D_MODEL ** -0.5)
    w_xa_k = nrm((DEPTH, D_MODEL, D_MODEL), D_MODEL ** -0.5)
    w_xa_v = nrm((DEPTH, D_MODEL, D_MODEL), D_MODEL ** -0.5)
    w_xa_o = nrm((DEPTH, D_MODEL, D_MODEL), D_MODEL ** -0.5)

    return {'x_prompt': x_prompt, 'x_sample': x_sample, 'mem_prompt': mem_prompt,
            'cache_mem_k': cache_mem_k, 'cache_mem_v': cache_mem_v, 'state_pool': state_pool,
            'state_conv': state_conv, 'state_ssm_conv': state_ssm_conv, 'state_ssm': state_ssm,
            'norm_mix': norm_mix, 'norm_xa': norm_xa, 'norm_final': norm_final,
            'w_in_even': w_in_even, 'pool_w': pool_w, 'pool_scale': pool_scale, 'conv_w': conv_w,
            'w_out_even': w_out_even, 'w_in_odd': w_in_odd, 'ssm_conv_w': ssm_conv_w,
            'ssm_conv_b': ssm_conv_b, 'dt_bias': dt_bias, 'a_log': a_log, 'd_skip': d_skip,
            'ssm_norm': ssm_norm, 'w_out_odd': w_out_odd, 'w_xa_q': w_xa_q, 'w_xa_k': w_xa_k,
            'w_xa_v': w_xa_v, 'w_xa_o': w_xa_o}


def reference(x_prompt, x_sample, mem_prompt, cache_mem_k, cache_mem_v, state_pool, state_conv,
              state_ssm_conv, state_ssm, norm_mix, norm_xa, norm_final, w_in_even, pool_w, pool_scale,
              conv_w, w_out_even, w_in_odd, ssm_conv_w, ssm_conv_b, dt_bias, a_log, d_skip, ssm_norm,
              w_out_odd, w_xa_q, w_xa_k, w_xa_v, w_xa_o):
    weights = (norm_mix, norm_xa, norm_final, w_in_even, pool_w, pool_scale, conv_w, w_out_even,
               w_in_odd, ssm_conv_w, ssm_conv_b, dt_bias, a_log, d_skip, ssm_norm, w_out_odd,
               w_xa_q, w_xa_o)
    bp = x_prompt.shape[0]
    dtype = x_prompt.dtype
    mem_k_prompt = jnp.einsum('bmd,lde->lbme', mem_prompt, w_xa_k).reshape(DEPTH, bp, N_MEM, XA_HEADS, XA_HEAD_DIM)
    mem_v_prompt = jnp.einsum('bmd,lde->lbme', mem_prompt, w_xa_v).reshape(DEPTH, bp, N_MEM, XA_HEADS, XA_HEAD_DIM)
    zero_pool = jnp.zeros((N_EVEN, bp, POOL_BUF, D_POOL), dtype)
    zero_conv = jnp.zeros((N_EVEN, bp, CONV_K - 1, D_CONV), dtype)
    zero_sconv = jnp.zeros((N_ODD, bp, SSM_CONV_K - 1, SSM_CONV_DIM), dtype)
    zero_ssm = jnp.zeros((N_ODD, bp, SSM_HEADS, SSM_HEAD_DIM, SSM_STATE), dtype)
    y_prompt, pool_prompt, conv_prompt, ssm_conv_prompt, ssm_prompt = run_trunk(
        x_prompt, mem_k_prompt, mem_v_prompt, zero_pool, zero_conv, zero_sconv, zero_ssm, 0, weights)
    y_sample, pool_sample, conv_sample, ssm_conv_sample, ssm_sample = run_trunk(
        x_sample, cache_mem_k, cache_mem_v, state_pool, state_conv, state_ssm_conv, state_ssm, PAST_LEN, weights)
    return (y_prompt, y_sample, mem_k_prompt, mem_v_prompt, pool_prompt, pool_sample, conv_prompt, conv_sample,
            ssm_conv_prompt, ssm_conv_sample, ssm_prompt, ssm_sample)
```

```cpp
#include <hip/hip_runtime.h>
#include <cstdio>
#include <cstdint>

#ifndef REP_SSD
#define REP_SSD 1
#endif
#ifndef REP_SSDS
#define REP_SSDS 1
#endif
#ifndef REP_SATTN
#define REP_SATTN 1
#endif
#ifndef REP_THIN
#define REP_THIN 1
#endif
#ifndef REP_G1
#define REP_G1 1
#endif
#ifndef REP_G2
#define REP_G2 1
#endif
#ifndef REP_G4
#define REP_G4 1
#endif
#ifndef REP_G5
#define REP_G5 1
#endif
#ifndef REP_G6
#define REP_G6 1
#endif
#ifndef REP_P1
#define REP_P1 1
#endif
#ifndef REP_RES
#define REP_RES 1
#endif
#ifndef REP_BAR
#define REP_BAR 1
#endif
#ifndef REP_MINI
#define REP_MINI 1
#endif
#ifndef REP_P0
#define REP_P0 1
#endif
#ifndef MK_PER_PHASE
#define MK_PER_PHASE 0
#endif

namespace pg8 {
#define PG8_LAS __attribute__((address_space(3)))
typedef unsigned short bf16_t;
typedef short bf16x8 __attribute__((ext_vector_type(8)));
typedef float f32x4 __attribute__((ext_vector_type(4)));
typedef unsigned u32x4 __attribute__((ext_vector_type(4)));
typedef unsigned u32x2 __attribute__((ext_vector_type(2)));
constexpr int BM = 256, BK = 64, HALF = 128, HTB = HALF * BK * 2  , STAGE_BYTES = 8 * HTB, NXCD = 8, WGM = 8;

__host__ __device__ __forceinline__ int lds_byte(int r, int c) { const int st = (r >> 4) * 2 + (c >> 5), rr = r & 15, cc = c & 31, ob = rr * 64 + cc * 2; return st * 1024 + (ob ^ (((ob >> 9) & 1) << 5)); }
__host__ __device__ __forceinline__ void stage_rc(int b, int& R, int& C) { const int st = b / 1024, sb = b % 1024, swz = sb ^ (((sb >> 9) & 1) << 5); R = (st >> 1) * 16 + swz / 64; C = (st & 1) * 32 + (swz % 64) / 2; }
__host__ __device__ __forceinline__ int perm32(int rho) { const int n = rho >> 4, i = rho & 15; return 8 * (i >> 2) + 4 * n + (i & 3); }

struct Unit { int pm, pn; };
struct Gemm { const bf16_t* A; const bf16_t* Bt; int lda, ldb, K; };

struct StaticOrder {
    int nM, nN, nwg, G, c;
    __host__ __device__ void init(int nM_, int nN_, int G_, int c_) { nM = nM_; nN = nN_; nwg = nM * nN; G = G_; c = c_; }
    __host__ __device__ bool next(int i, Unit& u) const {
        const long L = (long)i * G + c; if (L >= nwg) return false;
        int wgid = (int)L; { const int q = nwg / NXCD, r = nwg % NXCD, xcd = wgid % NXCD, off = wgid / NXCD; wgid = (xcd < r ? xcd * (q + 1) : r * (q + 1) + (xcd - r) * q) + off; }
        const int nig = WGM * nN, gid = wgid / nig, fm = gid * WGM, gsz = (nM - fm) < WGM ? (nM - fm) : WGM;
        u.pm = fm + ((wgid % nig) % gsz); u.pn = (wgid % nig) / gsz; return true;
    }
};
struct AddrStd  { __device__ __forceinline__ size_t a(const Unit& u, const Gemm& g) const { return (size_t)u.pm * 256 * g.lda; }
                  __device__ __forceinline__ size_t b(const Unit& u, const Gemm& g) const { return (size_t)u.pn * 256 * g.ldb; } };
struct AddrColA { __device__ __forceinline__ size_t a(const Unit& u, const Gemm& g) const { return (size_t)u.pm * 256 * g.lda + (size_t)u.pn * 256; }
                  __device__ __forceinline__ size_t b(const Unit& u, const Gemm& g) const { return (size_t)u.pn * 256 * g.ldb; } };
struct AddrScore { __device__ __forceinline__ size_t a(const Unit& u, const Gemm& g) const { return (size_t)u.pm * 256 * g.lda + (size_t)u.pn * 256; }
                   __device__ __forceinline__ size_t b(const Unit& u, const Gemm& g) const { return (size_t)(u.pm >> 3) * 256 * g.ldb + (size_t)u.pn * 256; } };
struct AddrPV   { __device__ __forceinline__ size_t a(const Unit& u, const Gemm& g) const { return (size_t)u.pm * 256 * g.lda + (size_t)u.pn * 256; }
                  __device__ __forceinline__ size_t b(const Unit& u, const Gemm& g) const { return ((size_t)(u.pm >> 3) * 1024 + (size_t)u.pn * 256) * 256; } };

__device__ __forceinline__ unsigned cvt_pk_bf16(float lo, float hi) { unsigned r; asm volatile("v_cvt_pk_bf16_f32 %0, %1, %2" : "=v"(r) : "v"(lo), "v"(hi)); return r; }
__device__ __forceinline__ float bf_lo(unsigned w) { return __uint_as_float(w << 16); }
__device__ __forceinline__ float bf_hi(unsigned w) { return __uint_as_float(w & 0xffff0000u); }
__device__ __forceinline__ float silu_f(float z) { return z * __builtin_amdgcn_rcpf(1.0f + __builtin_amdgcn_exp2f(-1.44269504089f * z)); }

struct EpiBf16S {
    static constexpr bool PERM = true, AFTER_DRAIN = false;
    bf16_t* O; int ldc; const unsigned long long* ssq;
    __device__ __forceinline__ void operator()(const f32x4 (&acc)[2][2][4][2], const Unit& u, int wr, int wc, int fr, int fq) const {
        const int row0 = u.pm * BM + wr * 64 + fr, col0 = u.pn * BM + wc * 32 + 8 * fq;
#pragma unroll
        for (int ai = 0; ai < 2; ++ai)
#pragma unroll
            for (int m = 0; m < 4; ++m) { const size_t row = (size_t)(row0 + ai * HALF + m * 16); bf16_t* rowp = O + row * ldc + col0;
                float rs = 1.0f;
                if (ssq) rs = 1.0f / sqrtf((float)ssq[row] * (1.0f / (1024.0f * 1048576.0f)) + 1e-6f);
#pragma unroll
                for (int bj = 0; bj < 2; ++bj) { const f32x4 v0 = acc[ai][bj][m][0] * rs, v1 = acc[ai][bj][m][1] * rs;
                    u32x4 w; w.x = cvt_pk_bf16(v0[0], v0[1]); w.y = cvt_pk_bf16(v0[2], v0[3]); w.z = cvt_pk_bf16(v1[0], v1[1]); w.w = cvt_pk_bf16(v1[2], v1[3]);
                    *(u32x4*)(rowp + bj * HALF) = w; } }
    }
};
struct EpiResAdd {
    static constexpr bool PERM = true, AFTER_DRAIN = false;
    bf16_t* Xb; unsigned long long* ssq; int dry;
    __device__ __forceinline__ void operator()(const f32x4 (&acc)[2][2][4][2], const Unit& u, int wr, int wc, int fr, int fq) const {
        if (dry) return;
        const int row0 = u.pm * BM + wr * 64 + fr, col0 = u.pn * BM + wc * 32 + 8 * fq;
#pragma unroll
        for (int ai = 0; ai < 2; ++ai)
#pragma unroll
            for (int m = 0; m < 4; ++m) { const size_t row = (size_t)(row0 + ai * HALF + m * 16); bf16_t* rowp = Xb + row * 1024 + col0;
                u32x4 w[2];
#pragma unroll
                for (int bj = 0; bj < 2; ++bj) w[bj] = *(const u32x4*)(rowp + bj * HALF);
                float sq = 0.f;
#pragma unroll
                for (int bj = 0; bj < 2; ++bj) { const unsigned int ww[4] = {w[bj].x, w[bj].y, w[bj].z, w[bj].w}; float o[8];
#pragma unroll
                    for (int e = 0; e < 4; ++e) { o[2 * e] = __uint_as_float(ww[e] << 16) + acc[ai][bj][m][e >> 1][2 * (e & 1)]; o[2 * e + 1] = __uint_as_float(ww[e] & 0xffff0000u) + acc[ai][bj][m][e >> 1][2 * (e & 1) + 1]; }
#pragma unroll
                    for (int e = 0; e < 8; e += 2) sq += o[e] * o[e] + o[e + 1] * o[e + 1];
                    u32x4 v; v.x = cvt_pk_bf16(o[0], o[1]); v.y = cvt_pk_bf16(o[2], o[3]); v.z = cvt_pk_bf16(o[4], o[5]); v.w = cvt_pk_bf16(o[6], o[7]);
                    *(u32x4*)(rowp + bj * HALF) = v; }
                sq += __shfl_xor(sq, 16); sq += __shfl_xor(sq, 32);
                if (fq == 0) atomicAdd(ssq + row, (unsigned long long)(sq * 1048576.0f));
                asm volatile("" ::: "memory"); }
    }
};
struct EpiPoolGate {
    static constexpr bool PERM = true, AFTER_DRAIN = false;
    bf16_t* O; int ldc; const bf16_t* gate; int ldg; const float* scale;
    __device__ __forceinline__ void operator()(const f32x4 (&acc)[2][2][4][2], const Unit& u, int wr, int wc, int fr, int fq) const {
        const int row0 = u.pm * BM + wr * 64 + fr, col0 = u.pn * BM + wc * 32 + 8 * fq;
        f32x4 sc[2][2];
#pragma unroll
        for (int bj = 0; bj < 2; ++bj)
#pragma unroll
            for (int n = 0; n < 2; ++n) sc[bj][n] = *(const f32x4*)(scale + col0 + bj * HALF + 4 * n);
#pragma unroll
        for (int ai = 0; ai < 2; ++ai)
#pragma unroll
            for (int m = 0; m < 4; ++m) { const size_t row = (size_t)(row0 + ai * HALF + m * 16);
#pragma unroll
                for (int bj = 0; bj < 2; ++bj) { const u32x4 gw = *(const u32x4*)(gate + row * ldg + col0 + bj * HALF);
                    const f32x4 v0 = acc[ai][bj][m][0] * sc[bj][0], v1 = acc[ai][bj][m][1] * sc[bj][1];
                    u32x4 w; w.x = cvt_pk_bf16(v0[0] * silu_f(bf_lo(gw.x)), v0[1] * silu_f(bf_hi(gw.x))); w.y = cvt_pk_bf16(v0[2] * silu_f(bf_lo(gw.y)), v0[3] * silu_f(bf_hi(gw.y)));
                    w.z = cvt_pk_bf16(v1[0] * silu_f(bf_lo(gw.z)), v1[1] * silu_f(bf_hi(gw.z))); w.w = cvt_pk_bf16(v1[2] * silu_f(bf_lo(gw.w)), v1[3] * silu_f(bf_hi(gw.w)));
                    *(u32x4*)(O + row * ldc + col0 + bj * HALF) = w; } }
    }
};
struct EpiKproj {
    static constexpr bool PERM = false, AFTER_DRAIN = false;
    float* outK; bf16_t* KB;
    __device__ __forceinline__ void operator()(const f32x4 (&acc)[2][2][4][2], const Unit& u, int wr, int wc, int fr, int fq) const {
        const int l = u.pn >> 2, row0 = u.pm * BM + wr * 64 + fr, col0 = (u.pn & 3) * BM + wc * 32 + 4 * fq;
        float* ob = outK + (size_t)l * 2048 * 1024; bf16_t* kb = KB + (size_t)l * 2048 * 1024;
#pragma unroll
        for (int ai = 0; ai < 2; ++ai)
#pragma unroll
            for (int m = 0; m < 4; ++m) { const size_t ro = (size_t)(row0 + ai * HALF + m * 16) * 1024 + col0;
#pragma unroll
                for (int bj = 0; bj < 2; ++bj)
#pragma unroll
                    for (int n = 0; n < 2; ++n) { const f32x4 v = acc[ai][bj][m][n]; *(f32x4*)(ob + ro + bj * HALF + n * 16) = v;
                        if (KB) { u32x2 w; w.x = cvt_pk_bf16(v[0], v[1]); w.y = cvt_pk_bf16(v[2], v[3]); *(u32x2*)(kb + ro + bj * HALF + n * 16) = w; } } }
    }
};
struct EpiVT {
    static constexpr bool PERM = false, AFTER_DRAIN = false;
    float* outV; bf16_t* VT;
    __device__ __forceinline__ void operator()(const f32x4 (&acc)[2][2][4][2], const Unit& u, int wr, int wc, int fr, int fq) const {
        const int l = u.pm >> 2, e0 = (u.pm & 3) * BM + wr * 64 + fr, b = u.pn, m0 = wc * 32 + 4 * fq;
        bf16_t* vb = VT + ((size_t)l * 8 + b) * 1024 * 256;
#pragma unroll
        for (int ai = 0; ai < 2; ++ai)
#pragma unroll
            for (int m = 0; m < 4; ++m) { const int e = e0 + ai * HALF + m * 16;
#pragma unroll
                for (int bj = 0; bj < 2; ++bj)
#pragma unroll
                    for (int n = 0; n < 2; ++n) { const f32x4 v = acc[ai][bj][m][n]; const int mm = m0 + bj * HALF + n * 16;
                        u32x2 w; w.x = cvt_pk_bf16(v[0], v[1]); w.y = cvt_pk_bf16(v[2], v[3]); *(u32x2*)(vb + (size_t)e * 256 + mm) = w; } }
    }
};
struct EpiSoftmax {
    static constexpr bool PERM = true, AFTER_DRAIN = true;
    bf16_t* P; int ldc; float c2;
    __device__ __forceinline__ void fused(f32x4 (&acc)[2][2][4][2], const Unit& u, int wr, int wc, int fr, int fq, PG8_LAS unsigned char* lds, int wid, int lane) const {
        PG8_LAS f32x4* TM = (PG8_LAS f32x4*)lds;
        PG8_LAS f32x4* TS = (PG8_LAS f32x4*)(lds + 4096);
        PG8_LAS float* TMf = (PG8_LAS float*)lds; PG8_LAS float* TSf = (PG8_LAS float*)(lds + 4096);
#pragma unroll
        for (int ai = 0; ai < 2; ++ai)
#pragma unroll
            for (int m = 0; m < 4; ++m) { float mx = -3.0e38f;
#pragma unroll
                for (int bj = 0; bj < 2; ++bj)
#pragma unroll
                    for (int n = 0; n < 2; ++n) { const f32x4 x = acc[ai][bj][m][n]; mx = fmaxf(mx, fmaxf(fmaxf(x[0], x[1]), fmaxf(x[2], x[3]))); }
                mx = fmaxf(mx, __shfl_xor(mx, 16)); mx = fmaxf(mx, __shfl_xor(mx, 32));
                if (fq == 0) TMf[(ai * HALF + wr * 64 + m * 16 + fr) * 4 + wc] = mx; }
        asm volatile("s_waitcnt lgkmcnt(0)" ::: "memory"); __builtin_amdgcn_s_barrier(); asm volatile("" ::: "memory");
#pragma unroll
        for (int ai = 0; ai < 2; ++ai)
#pragma unroll
            for (int m = 0; m < 4; ++m) { const int rl = ai * HALF + wr * 64 + m * 16 + fr; const f32x4 t = TM[rl]; const float mx = fmaxf(fmaxf(t[0], t[1]), fmaxf(t[2], t[3])); float s = 0.f;
#pragma unroll
                for (int bj = 0; bj < 2; ++bj)
#pragma unroll
                    for (int n = 0; n < 2; ++n) { f32x4 x = acc[ai][bj][m][n];
#pragma unroll
                        for (int j = 0; j < 4; ++j) { x[j] = __builtin_amdgcn_exp2f((x[j] - mx) * c2); s += x[j]; }
                        acc[ai][bj][m][n] = x; }
                s += __shfl_xor(s, 16); s += __shfl_xor(s, 32);
                if (fq == 0) TSf[rl * 4 + wc] = s; }
        asm volatile("s_waitcnt lgkmcnt(0)" ::: "memory"); __builtin_amdgcn_s_barrier(); asm volatile("" ::: "memory");
        const int row0 = u.pm * BM + wr * 64 + fr, col0 = u.pn * BM + wc * 32 + 8 * fq;
#pragma unroll
        for (int ai = 0; ai < 2; ++ai)
#pragma unroll
            for (int m = 0; m < 4; ++m) { const int rl = ai * HALF + wr * 64 + m * 16 + fr; const f32x4 t = TS[rl]; const float inv = 1.0f / ((t[0] + t[1]) + (t[2] + t[3]));
                bf16_t* rowp = P + (size_t)(row0 + ai * HALF + m * 16) * ldc + col0;
#pragma unroll
                for (int bj = 0; bj < 2; ++bj) { const f32x4 v0 = acc[ai][bj][m][0] * inv, v1 = acc[ai][bj][m][1] * inv;
                    u32x4 w; w.x = cvt_pk_bf16(v0[0], v0[1]); w.y = cvt_pk_bf16(v0[2], v0[3]); w.z = cvt_pk_bf16(v1[0], v1[1]); w.w = cvt_pk_bf16(v1[2], v1[3]);
                    *(u32x4*)(rowp + bj * HALF) = w; } }
    }
};

template <class Epi, class Addr, bool ALIGN_EPI = false, bool SP2 = false, bool KS = false>
__device__ __forceinline__ void gemm_phase(PG8_LAS unsigned char* lds, const Gemm g, const StaticOrder& S, const Epi& E, const Addr AD, const float* ssqh = nullptr) {
    int tid = threadIdx.x; asm volatile("" : "+v"(tid));
    const int wid = __builtin_amdgcn_readfirstlane(tid >> 6), lane = tid & 63, wr = wid >> 2, wc = wid & 3, fr = lane & 15, fq = lane >> 4;
    const int K = g.K, nt = K / BK;
    unsigned voffA[2], voffB[2];
#pragma unroll
    for (int i = 0; i < 2; ++i) { int R, C; stage_rc(tid * 16 + i * 8192, R, C); const int Rb = Epi::PERM ? ((R & ~31) + perm32(R & 31)) : R;
        voffA[i] = (unsigned)(R * g.lda + C) * 2u; voffB[i] = (unsigned)(Rb * g.ldb + C) * 2u; }
    const size_t kstep = (size_t)(BK * 2);
    const size_t hstepA = (size_t)HALF * g.lda * 2, hstepB = (size_t)HALF * g.ldb * 2;
    const unsigned ldsw = (unsigned)wid * 1024u;
    const int aoff = lds_byte(wr * 64 + fr, fq * 8), boff = lds_byte(wc * 32 + fr, fq * 8);
#define PG8_SA(b, h) (((b) * 2 + (h)) * HTB)
#define PG8_SB(b, h) ((4 + (b) * 2 + (h)) * HTB)
#define PG8_STAGE(bufoff, gbase, voff) do { _Pragma("unroll") for (int _i = 0; _i < 2; ++_i) \
        __builtin_amdgcn_global_load_lds((const unsigned*)((const char*)(gbase) + (voff)[_i]), (PG8_LAS unsigned*)(lds + (bufoff) + ldsw + _i * 8192), 16, 0, 0); } while (0)
#define PG8_LDA(dst, b, h) do { _Pragma("unroll") for (int m = 0; m < 4; ++m) _Pragma("unroll") for (int k = 0; k < 2; ++k) dst[m][k] = *(const PG8_LAS bf16x8*)(lds + PG8_SA(b, h) + aoff + m * 2048 + k * 1024); } while (0)
#define PG8_LDB(dst, b, h) do { _Pragma("unroll") for (int n = 0; n < 2; ++n) _Pragma("unroll") for (int k = 0; k < 2; ++k) dst[n][k] = *(const PG8_LAS bf16x8*)(lds + PG8_SB(b, h) + boff + n * 2048 + k * 1024); } while (0)
#define PG8_MMA(ai, bj, At, Bt) do { __builtin_amdgcn_s_setprio(1); _Pragma("unroll") for (int m = 0; m < 4; ++m) _Pragma("unroll") for (int n = 0; n < 2; ++n) _Pragma("unroll") for (int k = 0; k < 2; ++k) \
        acc[ai][bj][m][n] = __builtin_amdgcn_mfma_f32_16x16x32_bf16(Bt[n][k], At[m][k], acc[ai][bj][m][n], 0, 0, 0); __builtin_amdgcn_s_setprio(0); } while (0)
#define PG8_WAIT_V(n) asm volatile("s_waitcnt vmcnt(" #n ")" ::: "memory")
#define PG8_WAIT_L(n) asm volatile("s_waitcnt lgkmcnt(" #n ")" ::: "memory")
#define PG8_BAR __builtin_amdgcn_s_barrier()
#define PG8_SCHED __builtin_amdgcn_sched_barrier(0)
    Unit cur, nxt; int ui = 0;
    if (!S.next(0, cur)) return;
    f32x4 acc[2][2][4][2];
#pragma unroll
    for (int a = 0; a < 2; ++a)
#pragma unroll
        for (int b = 0; b < 2; ++b)
#pragma unroll
            for (int m = 0; m < 4; ++m)
#pragma unroll
                for (int n = 0; n < 2; ++n) acc[a][b][m][n] = (f32x4){0.f, 0.f, 0.f, 0.f};
    bf16x8 At[4][2], B0[2][2], B1[2][2];
    const char* cA = (const char*)g.A + 2 * AD.a(cur, g); const char* cB = (const char*)g.Bt + 2 * AD.b(cur, g);
    PG8_LAS float* kstab = (PG8_LAS float*)(lds + STAGE_BYTES);
    if constexpr (KS) { if (tid < 256) { const float* q = ssqh + (size_t)(cur.pm * BM + tid); float r[4];
#pragma unroll
            for (int gi = 0; gi < 4; ++gi) { float a = 0.f;
#pragma unroll
                for (int e = 0; e < 8; ++e) a += q[(size_t)(gi * 8 + e) * 16640];
                r[gi] = 1.0f / sqrtf(a * (1.0f / 512.0f) + 1e-6f); }
            *(PG8_LAS f32x4*)(kstab + tid * 4) = (f32x4){r[0] / r[1], r[1] / r[2], r[2] / r[3], r[3]}; } }
#define PG8_KSCALE(gi) do { _Pragma("unroll") for (int ai = 0; ai < 2; ++ai) _Pragma("unroll") for (int m = 0; m < 4; ++m) { const float f_ = kstab[(ai * HALF + wr * 64 + m * 16 + fr) * 4 + (gi)]; \
        _Pragma("unroll") for (int bj = 0; bj < 2; ++bj) _Pragma("unroll") for (int n = 0; n < 2; ++n) acc[ai][bj][m][n] = acc[ai][bj][m][n] * f_; } } while (0)
    if constexpr (SP2) {
        PG8_STAGE(PG8_SB(0, 0), cB, voffB); PG8_STAGE(PG8_SB(0, 1), cB + hstepB, voffB); PG8_STAGE(PG8_SA(0, 0), cA, voffA); PG8_STAGE(PG8_SA(0, 1), cA + hstepA, voffA);
        if (wr == 1) PG8_BAR;
        PG8_WAIT_V(2); PG8_BAR;
        PG8_STAGE(PG8_SB(1, 0), cB + kstep, voffB); PG8_STAGE(PG8_SA(1, 0), cA + kstep, voffA); PG8_STAGE(PG8_SB(1, 1), cB + hstepB + kstep, voffB);
        PG8_WAIT_V(6); PG8_BAR;
    } else {
        PG8_STAGE(PG8_SB(0, 0), cB, voffB); PG8_STAGE(PG8_SA(0, 0), cA, voffA); PG8_STAGE(PG8_SB(0, 1), cB + hstepB, voffB); PG8_STAGE(PG8_SA(0, 1), cA + hstepA, voffA);
        if (wr == 1) PG8_BAR;
        PG8_WAIT_V(4); PG8_BAR;
        PG8_STAGE(PG8_SB(1, 0), cB + kstep, voffB); PG8_STAGE(PG8_SA(1, 0), cA + kstep, voffA); PG8_STAGE(PG8_SB(1, 1), cB + hstepB + kstep, voffB);
        PG8_WAIT_V(6); PG8_BAR;
    }
    for (;;) {
        const bool has_next = S.next(ui + 1, nxt);
        const char* nA = has_next ? (const char*)g.A + 2 * AD.a(nxt, g) : cA; const char* nB = has_next ? (const char*)g.Bt + 2 * AD.b(nxt, g) : cB;
        for (int seg = 0; seg < (KS ? 4 : 1); ++seg) {
        if constexpr (KS) { if (seg > 0) PG8_KSCALE(seg - 1); }
        for (int t = KS ? seg * 8 : 0; t < (KS ? seg * 8 + 8 : nt); t += 2) {
            const bool last = (t == nt - 2);
            const char* a1 = cA + (size_t)(t + 1) * kstep;
            const char* a2 = last ? nA : cA + (size_t)(t + 2) * kstep; const char* b2 = last ? nB : cB + (size_t)(t + 2) * kstep;
            const char* a3 = a2 + kstep; const char* b3 = b2 + kstep;
            if constexpr (SP2) {
            PG8_LDB(B0, 0, 0); PG8_LDB(B1, 0, 1); PG8_SCHED; PG8_LDA(At, 0, 0); PG8_STAGE(PG8_SA(1, 1), a1 + hstepA, voffA);
            PG8_WAIT_V(8); PG8_WAIT_L(0); PG8_BAR; PG8_MMA(0, 0, At, B0); PG8_MMA(0, 1, At, B1); PG8_BAR; PG8_SCHED;
            PG8_LDA(At, 0, 1); PG8_STAGE(PG8_SB(0, 0), b2, voffB); PG8_STAGE(PG8_SB(0, 1), b2 + hstepB, voffB); PG8_STAGE(PG8_SA(0, 0), a2, voffA);
            PG8_WAIT_V(8); PG8_WAIT_L(0); PG8_BAR; PG8_MMA(1, 0, At, B0); PG8_MMA(1, 1, At, B1); PG8_BAR; PG8_SCHED;
            PG8_LDB(B0, 1, 0); PG8_LDB(B1, 1, 1); PG8_SCHED; PG8_LDA(At, 1, 0); PG8_STAGE(PG8_SA(0, 1), a2 + hstepA, voffA);
            PG8_WAIT_V(8); PG8_WAIT_L(0); PG8_BAR; PG8_MMA(0, 0, At, B0); PG8_MMA(0, 1, At, B1); PG8_BAR; PG8_SCHED;
            PG8_LDA(At, 1, 1); PG8_STAGE(PG8_SB(1, 0), b3, voffB); PG8_STAGE(PG8_SB(1, 1), b3 + hstepB, voffB); PG8_STAGE(PG8_SA(1, 0), a3, voffA);
            PG8_WAIT_V(8); PG8_WAIT_L(0); PG8_BAR; PG8_MMA(1, 0, At, B0); PG8_MMA(1, 1, At, B1); PG8_BAR; PG8_SCHED;
            } else {
            PG8_LDB(B0, 0, 0); PG8_SCHED; PG8_LDA(At, 0, 0); PG8_STAGE(PG8_SA(1, 1), a1 + hstepA, voffA);
            PG8_WAIT_L(8); PG8_BAR; PG8_WAIT_L(0); PG8_MMA(0, 0, At, B0); PG8_BAR; PG8_SCHED;
            PG8_LDB(B1, 0, 1); PG8_STAGE(PG8_SB(0, 0), b2, voffB);
            PG8_BAR; PG8_WAIT_L(0); PG8_MMA(0, 1, At, B1); PG8_BAR;
            PG8_LDA(At, 0, 1); PG8_STAGE(PG8_SA(0, 0), a2, voffA);
            PG8_BAR; PG8_WAIT_L(0); PG8_MMA(1, 0, At, B0); PG8_BAR; PG8_SCHED;
            PG8_STAGE(PG8_SB(0, 1), b2 + hstepB, voffB);
            PG8_WAIT_V(6); PG8_BAR; PG8_MMA(1, 1, At, B1); PG8_BAR;
            PG8_LDB(B0, 1, 0); PG8_SCHED; PG8_LDA(At, 1, 0); PG8_STAGE(PG8_SA(0, 1), a2 + hstepA, voffA);
            PG8_WAIT_L(8); PG8_BAR; PG8_WAIT_L(0); PG8_MMA(0, 0, At, B0); PG8_BAR; PG8_SCHED;
            PG8_LDB(B1, 1, 1); PG8_STAGE(PG8_SB(1, 0), b3, voffB);
            PG8_BAR; PG8_WAIT_L(0); PG8_MMA(0, 1, At, B1); PG8_BAR;
            PG8_LDA(At, 1, 1); PG8_STAGE(PG8_SA(1, 0), a3, voffA);
            PG8_BAR; PG8_WAIT_L(0); PG8_MMA(1, 0, At, B0); PG8_BAR; PG8_SCHED;
            PG8_STAGE(PG8_SB(1, 1), b3 + hstepB, voffB);
            PG8_WAIT_V(6); PG8_BAR; PG8_MMA(1, 1, At, B1); PG8_BAR;
            }
        }
        }
        if constexpr (KS) PG8_KSCALE(3);
        if constexpr (ALIGN_EPI) { if (wr == 0) PG8_BAR; }
        if constexpr (!Epi::AFTER_DRAIN) { E(acc, cur, wr, wc, fr, fq); }
        if (!has_next) break;
#pragma unroll
        for (int a = 0; a < 2; ++a)
#pragma unroll
            for (int b = 0; b < 2; ++b)
#pragma unroll
                for (int m = 0; m < 4; ++m)
#pragma unroll
                    for (int n = 0; n < 2; ++n) acc[a][b][m][n] = (f32x4){0.f, 0.f, 0.f, 0.f};
        cur = nxt; cA = nA; cB = nB; ++ui;
        if constexpr (ALIGN_EPI) { if (wr == 1) PG8_BAR; }
    }
    PG8_WAIT_V(0);
    if constexpr (!ALIGN_EPI) { if (wr == 0) PG8_BAR; }
    PG8_BAR;
    if constexpr (Epi::AFTER_DRAIN) { E.fused(acc, cur, wr, wc, fr, fq, lds, wid, lane); }
#undef PG8_KSCALE
#undef PG8_SA
#undef PG8_SB
#undef PG8_STAGE
#undef PG8_LDA
#undef PG8_LDB
#undef PG8_MMA
#undef PG8_WAIT_V
#undef PG8_WAIT_L
#undef PG8_BAR
#undef PG8_SCHED
}
}

constexpr int NWAVES = 8;
constexpr int DM = 1024, TP = 16384, NBATCH = 8, SEQ = 2048, NSMP = 128, MV = TP + NSMP  , MP = 16640  , NPAN = 65;
constexpr int EVEN_IN = 6144, ODD_IN = 5152, ODD_WROWS = 5376  , ODD_INP = 5120  , DIN = 2048, CONVD = 3072, NHEAD = 32, NMEM = 256;
constexpr float EPS = 1e-6f;
constexpr size_t OUT_Y = 0, OUT_MK = 16908288, OUT_MV = 25296896, OUT_PP = 33685504, OUT_PS = 33931264, OUT_CP = 37863424, OUT_CS = 37896192,
                 OUT_SCP = 38420480, OUT_SCS = 38567936, OUT_SP = 40927232, OUT_SS = 45121536, OUT_TOTAL = 112230400;
constexpr size_t MiB = 1u << 20;
constexpr size_t WS_CTL = 0, CTL_ZERO_BYTES = 5 * MiB;
constexpr size_t WS_SSQ = 1 * MiB;
constexpr size_t WS_GSSQ = 3 * MiB;
constexpr size_t WS_WTE_IN = 5 * MiB;
constexpr size_t WS_WTE_OUT = WS_WTE_IN + 24 * MiB;
constexpr size_t WS_WTO_IN = WS_WTE_OUT + 8 * MiB;
constexpr size_t WS_WTO_OUT = WS_WTO_IN + 21 * MiB;
constexpr size_t WS_WTQ = WS_WTO_OUT + 8 * MiB;
constexpr size_t WS_WTK = WS_WTQ + 8 * MiB, WS_WTV = WS_WTK + 8 * MiB, WS_WTO = WS_WTV + 8 * MiB;
constexpr size_t WS_WTP = WS_WTO + 8 * MiB;
constexpr size_t WS_MEMB = WS_WTP + 1 * MiB;
constexpr size_t WS_KB = WS_MEMB + 4 * MiB;
constexpr size_t WS_VT = WS_KB + 16 * MiB;
constexpr size_t WS_H = WS_VT + 16 * MiB;
constexpr size_t WS_Q = WS_H + 34 * MiB, WS_PB = WS_Q + 34 * MiB, WS_O = WS_PB + 34 * MiB, WS_DIFF = WS_O + 34 * MiB;
constexpr size_t WS_MIX = WS_DIFF + 34 * MiB;
constexpr size_t WS_YG = WS_MIX + 66 * MiB;
constexpr size_t WS_CONVX = WS_YG + 66 * MiB;
constexpr size_t WS_DT = WS_CONVX + 98 * MiB;
constexpr size_t WS_PROJ = WS_DT + 3 * MiB;
constexpr size_t WS_WTU = WS_PROJ + 196 * MiB;
constexpr size_t WS_SSQH = WS_WTU + 4 * MiB;
constexpr size_t WS_END = WS_SSQH + 5 * MiB;
constexpr int CW_BAR = 4096;
constexpr int RING_BYTES = 131072, SSD_SMALL_OFF = 131072, MISC_OFF = 163840 - 128, LDS_BYTES = 163840;

#define GAS __attribute__((address_space(1)))
#define LAS __attribute__((address_space(3)))
#define DI __device__ __forceinline__
typedef unsigned short bf16;
typedef unsigned v4u __attribute__((ext_vector_type(4)));
typedef unsigned v2u __attribute__((ext_vector_type(2)));
typedef float f32x4 __attribute__((ext_vector_type(4)));
typedef float f32x16 __attribute__((ext_vector_type(16)));
typedef short bf16x8 __attribute__((ext_vector_type(8)));
typedef GAS unsigned gu32;
#define LDS_WAIT() asm volatile("s_waitcnt lgkmcnt(0)" ::: "memory")
DI unsigned f2bf(float f) { unsigned u = __builtin_bit_cast(unsigned, f); return (u + 0x7fffu + ((u >> 16) & 1u)) >> 16; }
DI unsigned pk2(float lo, float hi) { unsigned r; asm("v_cvt_pk_bf16_f32 %0, %1, %2" : "=v"(r) : "v"(lo), "v"(hi)); return r; }
DI float bflo(unsigned w) { return __uint_as_float(w << 16); }
DI float bfhi(unsigned w) { return __uint_as_float(w & 0xffff0000u); }
DI float bf1(bf16 h) { return __uint_as_float(((unsigned)h) << 16); }
DI void unpack8(const v4u v, float (&f)[8]) { f[0] = bflo(v.x); f[1] = bfhi(v.x); f[2] = bflo(v.y); f[3] = bfhi(v.y); f[4] = bflo(v.z); f[5] = bfhi(v.z); f[6] = bflo(v.w); f[7] = bfhi(v.w); }
DI v4u pack8(const float (&f)[8]) { v4u o; o.x = pk2(f[0], f[1]); o.y = pk2(f[2], f[3]); o.z = pk2(f[4], f[5]); o.w = pk2(f[6], f[7]); return o; }
DI void ld8(const bf16* p, float (&f)[8]) { unpack8(*(const GAS v4u*)p, f); }
DI void ld8f(const float* p, float (&f)[8]) { const f32x4 a = *(const GAS f32x4*)p, b = *(const GAS f32x4*)(p + 4); f[0] = a[0]; f[1] = a[1]; f[2] = a[2]; f[3] = a[3]; f[4] = b[0]; f[5] = b[1]; f[6] = b[2]; f[7] = b[3]; }
DI void st8(bf16* p, const float (&f)[8]) { *(GAS v4u*)p = pack8(f); }
DI void st8f(float* p, const float (&f)[8]) { *(GAS f32x4*)p = (f32x4){f[0], f[1], f[2], f[3]}; *(GAS f32x4*)(p + 4) = (f32x4){f[4], f[5], f[6], f[7]}; }
DI float silu(float z) { return z * __builtin_amdgcn_rcpf(1.0f + __builtin_amdgcn_exp2f(-1.44269504089f * z)); }
DI float wave_sum(float v) {
#pragma unroll
    for (int o = 1; o < 64; o <<= 1) v += __shfl_xor(v, o);
    return v;
}

#define XB_TMO      128
#define XB_XCNT(j)  (256  + 64 * (j))
#define XB_XSUB(j)  (1280 + 64 * (j))
#define XB_XGEN(j)  (2304 + 64 * (j))
#define XB_TOP      3328
#define XB_TOPGEN   3392
#define XCD_BAR_WORDS 3456
#define XB_SPIN_CAP (1u << 18)
DI unsigned xb_ld(unsigned* p)              { return __hip_atomic_load(p, __ATOMIC_RELAXED, __HIP_MEMORY_SCOPE_AGENT); }
DI unsigned xb_add(unsigned* p, unsigned v) { return __hip_atomic_fetch_add(p, v, __ATOMIC_RELAXED, __HIP_MEMORY_SCOPE_AGENT); }
DI unsigned xb_xcc_id() { return (unsigned)__builtin_amdgcn_s_getreg((3 << 11) | 20) & 0xFu; }
#define XB_SPIN(cond, bar) do { unsigned _sp = 0; while (cond) { __builtin_amdgcn_s_sleep(1); \
    if ((++_sp & 255u) == 0u) { if (xb_ld(&(bar)[XB_TMO])) break; if (_sp > XB_SPIN_CAP) { atomicAdd(&(bar)[XB_TMO], 1u); break; } } } } while (0)
struct XcdBarrier { unsigned* bar; unsigned x; volatile LAS unsigned* st; };
DI XcdBarrier xcd_barrier_post(unsigned* bar, volatile LAS unsigned* st) {
    XcdBarrier b; b.bar = bar; b.x = xb_xcc_id(); b.st = st;
    if (threadIdx.x == 0) (void)xb_add(&bar[XB_XCNT(b.x)], 1u);
    return b;
}
DI void xcd_barrier_complete(unsigned* bar, unsigned x, unsigned& nloc, unsigned& nx) {
    const unsigned G = gridDim.x * gridDim.y * gridDim.z;
    unsigned sum, cnt, mine, sp = 0u;
    for (;;) {
        sum = 0u; cnt = 0u; mine = 0u;
#pragma unroll
        for (unsigned j = 0; j < 16; ++j) { const unsigned c = xb_ld(&bar[XB_XCNT(j)]); sum += c; cnt += (c > 0u) ? 1u : 0u; mine = (j == x) ? c : mine; }
        if (sum == G) break;
        __builtin_amdgcn_s_sleep(1);
        if ((++sp & 255u) == 0u) { if (xb_ld(&bar[XB_TMO])) break; if (sp > XB_SPIN_CAP) { atomicAdd(&bar[XB_TMO], 1u); break; } }
    }
    nloc = mine > 0u ? mine : 1u; nx = cnt > 0u ? cnt : 1u;
}
DI void xcd_barrier(const XcdBarrier& b) {
    asm volatile("s_waitcnt vmcnt(0)" ::: "memory");
    __syncthreads();
    if (threadIdx.x == 0) {
        unsigned* bar = b.bar;
        __builtin_amdgcn_s_waitcnt(0);
        unsigned nloc = b.st[0], nx = b.st[1];
        if (nloc == 0u) { xcd_barrier_complete(bar, b.x, nloc, nx); b.st[0] = nloc; b.st[1] = nx; }
        const unsigned old = xb_add(&bar[XB_XSUB(b.x)], 1u);
        const unsigned gen = old / nloc;
        if (old + 1u == (gen + 1u) * nloc) {
            __builtin_amdgcn_fence(__ATOMIC_RELEASE, "agent");
            asm volatile("s_waitcnt vmcnt(0)" ::: "memory");
            const unsigned og = xb_add(&bar[XB_TOP], 1u);
            const unsigned tg = og / nx;
            if (og + 1u == (tg + 1u) * nx) xb_add(&bar[XB_TOPGEN], 1u);
            else XB_SPIN(xb_ld(&bar[XB_TOPGEN]) == tg, bar);
            __builtin_amdgcn_fence(__ATOMIC_ACQUIRE, "agent");
            xb_add(&bar[XB_XGEN(b.x)], 1u);
            asm volatile("s_waitcnt vmcnt(0)" ::: "memory");
        } else {
            XB_SPIN(xb_ld(&bar[XB_XGEN(b.x)]) == gen, bar);
            __builtin_amdgcn_fence(__ATOMIC_ACQUIRE, "agent");
            asm volatile("s_waitcnt vmcnt(0)" ::: "memory");
        }
    }
    __syncthreads();
}

struct Args { const float* in[29]; float* out; unsigned char* ws; int ph_lo, ph_hi; };
struct Frame {
    LAS unsigned char* lds;
    int tid, lane, wave, vcu, G;
    const float* const* in; float* out; unsigned char* ws;
};
enum { I_XP = 0, I_XS, I_MEM, I_CK, I_CV, I_SPOOL, I_SCONV, I_SSCONV, I_SSSM, I_NMIX, I_NXA, I_NFIN, I_WINE, I_POOLW, I_POOLS, I_CONVW, I_WOUTE, I_WINO, I_SCW, I_SCB, I_DTB, I_ALOG, I_DSKIP, I_SNORM, I_WOUTO, I_WQ, I_WK, I_WV, I_WO };

DI void p0_transpose_item(const float* W, int K, int N, bf16* WT, LAS float* scr, int item, int lane, const float* gk = nullptr) {
    const int nblk = N / 32, kb = item / nblk, nb = item % nblk, k0 = 64 * kb, n0 = 32 * nb;
    {
        const int kr = lane >> 3, ns = lane & 7; f32x4 v[8];
#pragma unroll
        for (int i = 0; i < 8; ++i) v[i] = *(const GAS f32x4*)(W + (size_t)(k0 + 8 * i + kr) * N + n0 + 4 * ns);
#pragma unroll
        for (int i = 0; i < 8; ++i) { const int kk = 8 * i + kr; const float gg = gk ? ((const GAS float*)gk)[k0 + kk] : 1.0f; LAS float* d = scr + kk * 33 + 4 * ns;
            d[0] = v[i][0] * gg; d[1] = v[i][1] * gg; d[2] = v[i][2] * gg; d[3] = v[i][3] * gg; } }
    LDS_WAIT(); asm volatile("" ::: "memory");
    const int c = lane & 7;
#pragma unroll
    for (int j = 0; j < 4; ++j) { const int n = (lane >> 3) + 8 * j; const LAS float* s = scr + (8 * c) * 33 + n;
        v4u o; o.x = pk2(s[0 * 33], s[1 * 33]); o.y = pk2(s[2 * 33], s[3 * 33]); o.z = pk2(s[4 * 33], s[5 * 33]); o.w = pk2(s[6 * 33], s[7 * 33]);
        *(GAS v4u*)(WT + (size_t)(n0 + n) * K + k0 + 8 * c) = o; }
    LDS_WAIT(); asm volatile("" ::: "memory");
}
DI void p0_prologue(Frame& F) {
    LAS float* scr = (LAS float*)(F.lds + F.wave * 16384);
    const int gw = F.vcu * NWAVES + F.wave, NGW = F.G * NWAVES;
    unsigned char* ws = F.ws;
    constexpr int IT_WINE = 16 * 192, IT_WOUT = 32 * 32, IT_WINO = 16 * 161, IT_SQ = 16 * 32, IT_PW = 4 * 8;
    constexpr int N0 = 2 * IT_WINE, N1 = N0 + 2 * IT_WOUT, N2 = N1 + 2 * IT_WINO, N3 = N2 + 2 * IT_WOUT, N4 = N3 + 16 * IT_SQ, N5 = N4 + 8 * IT_PW;
    for (int it = gw; it < N5; it += NGW) {
        if (it < N0) { const int mi = it / IT_WINE, r = it % IT_WINE;
            bf16* dst = (r % 192) < 32 ? (bf16*)(ws + WS_WTU) + (size_t)mi * DM * DM : (bf16*)(ws + WS_WTE_IN) + (size_t)mi * EVEN_IN * DM;
            p0_transpose_item(F.in[I_WINE] + (size_t)mi * DM * EVEN_IN, DM, EVEN_IN, dst, scr, r, F.lane, F.in[I_NMIX] + (size_t)(2 * mi) * DM); }
        else if (it < N1) { const int q = it - N0, mi = q / IT_WOUT, r = q % IT_WOUT; p0_transpose_item(F.in[I_WOUTE] + (size_t)mi * 2048 * DM, 2048, DM, (bf16*)(ws + WS_WTE_OUT) + (size_t)mi * DM * 2048, scr, r, F.lane); }
        else if (it < N2) { const int q = it - N1, mi = q / IT_WINO, r = q % IT_WINO; p0_transpose_item(F.in[I_WINO] + (size_t)mi * DM * ODD_IN, DM, ODD_IN, (bf16*)(ws + WS_WTO_IN) + (size_t)mi * ODD_WROWS * DM, scr, r, F.lane, F.in[I_NMIX] + (size_t)(2 * mi + 1) * DM); }
        else if (it < N3) { const int q = it - N2, mi = q / IT_WOUT, r = q % IT_WOUT; p0_transpose_item(F.in[I_WOUTO] + (size_t)mi * 2048 * DM, 2048, DM, (bf16*)(ws + WS_WTO_OUT) + (size_t)mi * DM * 2048, scr, r, F.lane, F.in[I_SNORM] + (size_t)mi * DIN); }
        else if (it < N4) { const int q = it - N3, mi = q / IT_SQ, r = q % IT_SQ, which = mi >> 2, l = mi & 3;
            const float* src = F.in[I_WQ + which] + (size_t)l * DM * DM;
            bf16* dst = (bf16*)(ws + (which == 0 ? WS_WTQ : which == 1 ? WS_WTK : which == 2 ? WS_WTV : WS_WTO)) + (size_t)l * DM * DM;
            p0_transpose_item(src, DM, DM, dst, scr, r, F.lane, which == 0 ? F.in[I_NXA] + (size_t)l * DM : nullptr); }
        else { const int q = it - N4, mi = q / IT_PW, r = q % IT_PW; p0_transpose_item(F.in[I_POOLW] + (size_t)mi * 65536, 256, 256, (bf16*)(ws + WS_WTP) + (size_t)mi * 65536, scr, r, F.lane); }
    }
    for (int it = gw; it < 2 * 4 * 32 * 8; it += NGW) {
        const int mi = it >> 10, gg = (it >> 8) & 3, kb = (it >> 3) & 31, nb = it & 7, r = F.lane & 31, h = F.lane >> 5;
        const float* Wi = F.in[I_WINE] + (size_t)mi * DM * EVEN_IN + (size_t)(32 * kb + r) * EVEN_IN + gg * 256;
        const float* Wp = F.in[I_POOLW] + (size_t)(mi * 4 + gg) * 65536 + nb * 32 + r;
        f32x16 acc;
#pragma unroll
        for (int k = 0; k < 16; ++k) acc[k] = 0.f;
        for (int j0 = 0; j0 < 256; j0 += 16) {
            f32x4 a4[4]; float b[16];
#pragma unroll
            for (int q = 0; q < 4; ++q) a4[q] = *(const GAS f32x4*)(Wi + j0 + 4 * q);
#pragma unroll
            for (int q = 0; q < 8; ++q) { b[2 * q] = ((const GAS float*)Wp)[(size_t)(j0 + 2 * q + h) * 256]; }
#pragma unroll
            for (int q = 0; q < 8; ++q) { const float av = (q & 1) ? (h ? a4[q >> 1][3] : a4[q >> 1][2]) : (h ? a4[q >> 1][1] : a4[q >> 1][0]);
                acc = __builtin_amdgcn_mfma_f32_32x32x2f32(av, b[2 * q], acc, 0, 0, 0); }
        }
        bf16* dst = (bf16*)(ws + WS_WTE_IN) + (size_t)mi * EVEN_IN * DM + (size_t)(gg * 256 + nb * 32 + r) * DM + 32 * kb;
        const float* gk = F.in[I_NMIX] + (size_t)(2 * mi) * DM + 32 * kb;
#pragma unroll
        for (int q4 = 0; q4 < 4; ++q4) { const int k0 = 8 * q4 + 4 * h; const f32x4 g4 = *(const GAS f32x4*)(gk + k0);
            *(GAS v2u*)(dst + k0) = (v2u){pk2(acc[4 * q4] * g4[0], acc[4 * q4 + 1] * g4[1]), pk2(acc[4 * q4 + 2] * g4[2], acc[4 * q4 + 3] * g4[3])}; }
    }
    const int gt = F.vcu * 512 + F.tid, NGT = F.G * 512;
    for (int i = gt; i < 2 * 224 * 128; i += NGT) { const int mi = i / (224 * 128), r = i % (224 * 128);
        *(GAS v4u*)((bf16*)(ws + WS_WTO_IN) + ((size_t)mi * ODD_WROWS + ODD_IN) * DM + (size_t)r * 8) = (v4u){0u, 0u, 0u, 0u}; }
    for (int i = gt; i < 2048 * 128; i += NGT) { float f[8]; ld8f(F.in[I_MEM] + (size_t)i * 8, f); st8((bf16*)(ws + WS_MEMB) + (size_t)i * 8, f); }
    bf16* H = (bf16*)(ws + WS_H); unsigned long long* SSQ = (unsigned long long*)(ws + WS_SSQ);
    for (int m0 = 2 * gw; m0 < MV; m0 += 2 * NGW) {
        f32x4 v[2][4];
#pragma unroll
        for (int rr = 0; rr < 2; ++rr) { const int m = m0 + rr; const float* xrow = m < TP ? F.in[I_XP] + (size_t)m * DM : F.in[I_XS] + (size_t)(m - TP) * DM; const GAS f32x4* xr = (const GAS f32x4*)xrow + F.lane;
#pragma unroll
            for (int j = 0; j < 4; ++j) v[rr][j] = xr[64 * j]; }
#pragma unroll
        for (int rr = 0; rr < 2; ++rr) { const int m = m0 + rr; GAS v2u* o8 = (GAS v2u*)(H + (size_t)m * DM) + F.lane; float s = 0.f;
#pragma unroll
            for (int j = 0; j < 4; ++j) { const f32x4 x = v[rr][j]; s += (x.x * x.x + x.y * x.y) + (x.z * x.z + x.w * x.w); o8[64 * j] = (v2u){pk2(x.x, x.y), pk2(x.z, x.w)}; }
            s = wave_sum(s);
            if (F.lane == 0) ((GAS unsigned long long*)SSQ)[m] = (unsigned long long)(s * 1048576.0f); }
    }
}
DI void t_norm(Frame& F, const float* g, bool fin) {
    const int gw = F.vcu * NWAVES + F.wave, NGW = F.G * NWAVES;
    const bf16* H = (const bf16*)(F.ws + WS_H);
    for (int m0 = 2 * gw; m0 < MV; m0 += 2 * NGW) {
        v4u w[2][2];
#pragma unroll
        for (int rr = 0; rr < 2; ++rr) { const GAS v4u* hr = (const GAS v4u*)(H + (size_t)(m0 + rr) * DM) + F.lane; w[rr][0] = hr[0]; w[rr][1] = hr[64]; }
#pragma unroll
        for (int rr = 0; rr < 2; ++rr) { float x[2][8]; float s = 0.f;
#pragma unroll
            for (int j = 0; j < 2; ++j)
#pragma unroll
                for (int e = 0; e < 4; ++e) { x[j][2 * e] = __uint_as_float(w[rr][j][e] << 16); x[j][2 * e + 1] = __uint_as_float(w[rr][j][e] & 0xffff0000u); s += x[j][2 * e] * x[j][2 * e] + x[j][2 * e + 1] * x[j][2 * e + 1]; }
            const float rstd = 1.f / sqrtf(wave_sum(s) * (1.f / DM) + EPS);
            GAS f32x4* yo = (GAS f32x4*)(F.out + (size_t)(m0 + rr) * DM);
#pragma unroll
            for (int j = 0; j < 2; ++j) { const int c0 = 512 * j + 8 * F.lane; const f32x4 g0 = *(const GAS f32x4*)(g + c0), g1 = *(const GAS f32x4*)(g + c0 + 4);
                yo[(c0 >> 2)] = (f32x4){x[j][0] * rstd * g0.x, x[j][1] * rstd * g0.y, x[j][2] * rstd * g0.z, x[j][3] * rstd * g0.w};
                yo[(c0 >> 2) + 1] = (f32x4){x[j][4] * rstd * g1.x, x[j][5] * rstd * g1.y, x[j][6] * rstd * g1.z, x[j][7] * rstd * g1.w}; }
        }
    }
}
DI void t_even_mix(Frame& F, int i, int hf) {
    const bf16* PROJ = (const bf16*)(F.ws + WS_PROJ); bf16* MIX = (bf16*)(F.ws + WS_MIX);
    const int c8 = F.tid & 127, sub = F.tid >> 7, ch = c8 * 8, w = 2 << (ch >> 8);
    float cw0[8], cw1[8], cw2[8], psc[8];
    ld8f(F.in[I_CONVW] + (size_t)(i * 3 + 0) * DM + ch, cw0); ld8f(F.in[I_CONVW] + (size_t)(i * 3 + 1) * DM + ch, cw1); ld8f(F.in[I_CONVW] + (size_t)(i * 3 + 2) * DM + ch, cw2);
    ld8f(F.in[I_POOLS] + (size_t)i * DM + ch, psc);
    for (int item = F.vcu * 512 + F.tid; item < (TP / 32) * 128; item += F.G * 512) {
        const int run = (item >> 7) + hf * (TP / 32), t0 = run * 16, b = t0 >> 11, tt0 = t0 & 2047;
        const bf16* pr0 = PROJ + (size_t)t0 * EVEN_IN;
        float S[8], cv1[8], cv2[8], tmp[8], cg[8], vv[8];
#pragma unroll
        for (int j = 0; j < 8; ++j) { S[j] = 0.f; cv1[j] = 0.f; cv2[j] = 0.f; }
        if (tt0 > 0) {
            for (int k = 1; k < w; ++k) { ld8(pr0 - (size_t)k * EVEN_IN + ch, tmp);
#pragma unroll
                for (int j = 0; j < 8; ++j) S[j] += tmp[j]; }
            ld8(pr0 - EVEN_IN + 3072 + ch, cg); ld8(pr0 - EVEN_IN + 4096 + ch, vv);
#pragma unroll
            for (int j = 0; j < 8; ++j) cv1[j] = cg[j] * vv[j];
            ld8(pr0 - 2 * EVEN_IN + 3072 + ch, cg); ld8(pr0 - 2 * EVEN_IN + 4096 + ch, vv);
#pragma unroll
            for (int j = 0; j < 8; ++j) cv2[j] = cg[j] * vv[j];
        }
        if (tt0 > 0 && tt0 + 16 <= SEQ - 15) {
            const float inv = 1.0f / (float)w;
#pragma unroll 4
            for (int k = 0; k < 16; ++k) {
                const size_t t = (size_t)t0 + k; const bf16* pr = pr0 + (size_t)k * EVEN_IN;
                float u0[8], uo[8], gp[8], bg[8], gc[8], cv0[8];
                ld8(pr + ch, u0); ld8(pr + 1024 + ch, gp); ld8(pr + 3072 + ch, cg); ld8(pr + 4096 + ch, vv); ld8(pr + 2048 + ch, bg); ld8(pr + 5120 + ch, gc); ld8(pr - (size_t)(w - 1) * EVEN_IN + ch, uo);
#pragma unroll
                for (int j = 0; j < 8; ++j) { S[j] += u0[j]; tmp[j] = (S[j] * inv - u0[j]) * psc[j] * silu(gp[j]); S[j] -= uo[j]; }
                st8(MIX + t * DIN + ch, tmp);
#pragma unroll
                for (int j = 0; j < 8; ++j) { cv0[j] = cg[j] * vv[j]; tmp[j] = bg[j] * (cw0[j] * cv2[j] + cw1[j] * cv1[j] + cw2[j] * cv0[j]) * silu(gc[j]); cv2[j] = cv1[j]; cv1[j] = cv0[j]; }
                st8(MIX + t * DIN + 1024 + ch, tmp);
            }
        } else {
#pragma unroll 2
        for (int k = 0; k < 16; ++k) {
            const int tt = tt0 + k; const size_t t = (size_t)t0 + k; const bf16* pr = pr0 + (size_t)k * EVEN_IN;
            float u0[8], uo[8], gp[8], bg[8], gc[8], cv0[8];
            ld8(pr + ch, u0); ld8(pr + 1024 + ch, gp); ld8(pr + 3072 + ch, cg); ld8(pr + 4096 + ch, vv); ld8(pr + 2048 + ch, bg); ld8(pr + 5120 + ch, gc);
            const bool drop = tt - (w - 1) >= 0;
            if (drop) ld8(pr - (size_t)(w - 1) * EVEN_IN + ch, uo);
            const float inv = 1.0f / (float)(tt + 1 < w ? tt + 1 : w);
#pragma unroll
            for (int j = 0; j < 8; ++j) { S[j] += u0[j]; tmp[j] = (S[j] * inv - u0[j]) * psc[j] * silu(gp[j]); if (drop) S[j] -= uo[j]; }
            st8(MIX + t * DIN + ch, tmp);
#pragma unroll
            for (int j = 0; j < 8; ++j) { cv0[j] = cg[j] * vv[j]; tmp[j] = bg[j] * (cw0[j] * cv2[j] + cw1[j] * cv1[j] + cw2[j] * cv0[j]) * silu(gc[j]); cv2[j] = cv1[j]; cv1[j] = cv0[j]; }
            st8(MIX + t * DIN + 1024 + ch, tmp);
            if (tt >= SEQ - 2) st8f(F.out + OUT_CP + ((size_t)(i * NBATCH + b) * 2 + (tt - (SEQ - 2))) * DM + ch, cv0);
        }
        }
    }
    LAS float* DF = (LAS float*)F.lds;
    const bf16* WTP = (const bf16*)(F.ws + WS_WTP) + (size_t)i * 4 * 65536;
    if (hf == 0) for (int it = F.vcu; it < (NSMP / 4) * 8; it += F.G) {
        const int rq = it >> 3, os = it & 7, bb = rq * 4 + sub; const size_t row = TP + bb;
        const bf16* pr = PROJ + row * EVEN_IN;
        const float* pref = F.in[I_SPOOL] + ((size_t)(i * NSMP + bb) * 15) * DM + ch;
        float* pso = F.out + OUT_PS + ((size_t)(i * NSMP + bb) * 15) * DM + ch;
        float u0[8], sum[8], tmp[8];
        ld8(pr + ch, u0);
#pragma unroll
        for (int j = 0; j < 8; ++j) sum[j] = u0[j];
        for (int k = 0; k < 15; ++k) { ld8f(pref + (size_t)k * DM, tmp);
            if (os == 0 && k >= 1) st8f(pso + (size_t)(k - 1) * DM, tmp);
            if (15 - k < w) {
#pragma unroll
                for (int j = 0; j < 8; ++j) sum[j] += tmp[j]; } }
        const float inv = 1.0f / (float)w;
#pragma unroll
        for (int j = 0; j < 8; ++j) DF[sub * 1024 + ch + j] = sum[j] * inv - u0[j];
        if (os == 0) {
            st8f(pso + (size_t)14 * DM, u0);
            float cg[8], vv[8], cv0[8], p0[8], p1[8], bg[8], gc[8];
            ld8(pr + 3072 + ch, cg); ld8(pr + 4096 + ch, vv);
#pragma unroll
            for (int j = 0; j < 8; ++j) cv0[j] = cg[j] * vv[j];
            ld8f(F.in[I_SCONV] + ((size_t)(i * NSMP + bb) * 2 + 0) * DM + ch, p0); ld8f(F.in[I_SCONV] + ((size_t)(i * NSMP + bb) * 2 + 1) * DM + ch, p1);
            ld8(pr + 2048 + ch, bg); ld8(pr + 5120 + ch, gc);
#pragma unroll
            for (int j = 0; j < 8; ++j) tmp[j] = bg[j] * (cw0[j] * p0[j] + cw1[j] * p1[j] + cw2[j] * cv0[j]) * silu(gc[j]);
            st8(MIX + row * DIN + 1024 + ch, tmp);
            st8f(F.out + OUT_CS + ((size_t)(i * NSMP + bb) * 2 + 0) * DM + ch, p1); st8f(F.out + OUT_CS + ((size_t)(i * NSMP + bb) * 2 + 1) * DM + ch, cv0);
        }
        __syncthreads();
        {   const int n = os * 128 + (F.tid & 127), gg = n >> 8; const LAS float* dfr = DF + sub * 1024 + gg * 256; const bf16* wr = WTP + (size_t)gg * 65536 + (size_t)(n & 255) * 256;
            float acc = 0.f;
#pragma unroll 8
            for (int k0 = 0; k0 < 256; k0 += 8) { float wv[8]; ld8(wr + k0, wv); const f32x4 d0 = *(const LAS f32x4*)(dfr + k0), d1 = *(const LAS f32x4*)(dfr + k0 + 4);
                acc += (d0[0] * wv[0] + d0[1] * wv[1]) + (d0[2] * wv[2] + d0[3] * wv[3]) + (d1[0] * wv[4] + d1[1] * wv[5]) + (d1[2] * wv[6] + d1[3] * wv[7]); }
            const float gpv = bf1(((const GAS bf16*)pr)[1024 + n]), sc = ((const GAS float*)F.in[I_POOLS])[(size_t)i * DM + n];
            ((GAS bf16*)MIX)[row * DIN + n] = (bf16)f2bf(acc * sc * silu(gpv));
        }
        __syncthreads();
    }
}
DI void t_conv(Frame& F, int i) {
    const bf16* PROJ = (const bf16*)(F.ws + WS_PROJ); bf16* CONVX = (bf16*)(F.ws + WS_CONVX); float* DT = (float*)(F.ws + WS_DT);
    const int gt = F.vcu * 512 + F.tid, NGT = F.G * 512;
    const float* cwp = F.in[I_SCW] + (size_t)i * 4 * CONVD; const float* cbp = F.in[I_SCB] + (size_t)i * CONVD;
    for (int idx = gt; idx < (TP / 16) * 384; idx += NGT) {
        const int run = idx / 384, c8 = idx - run * 384, ch = c8 * 8, t0 = run * 16, tt0 = t0 & 2047, b = t0 >> 11;
        const bf16* pr0 = PROJ + (size_t)t0 * ODD_INP + 2048 + ch;
        float w0[8], w1[8], w2[8], w3[8], bb[8], x0[8], x1[8], x2[8];
        ld8f(cwp + ch, w0); ld8f(cwp + CONVD + ch, w1); ld8f(cwp + 2 * CONVD + ch, w2); ld8f(cwp + 3 * CONVD + ch, w3); ld8f(cbp + ch, bb);
        if (tt0 > 0) { ld8(pr0 - 3 * ODD_INP, x0); ld8(pr0 - 2 * ODD_INP, x1); ld8(pr0 - ODD_INP, x2); }
        else {
#pragma unroll
            for (int j = 0; j < 8; ++j) { x0[j] = 0.f; x1[j] = 0.f; x2[j] = 0.f; } }
        v4u xr[16];
#pragma unroll
        for (int k = 0; k < 16; ++k) xr[k] = *(const GAS v4u*)(pr0 + (size_t)k * ODD_INP);
#pragma unroll
        for (int k = 0; k < 16; ++k) {
            float x3[8], acc[8]; unpack8(xr[k], x3);
#pragma unroll
            for (int j = 0; j < 8; ++j) { acc[j] = silu(bb[j] + w0[j] * x0[j] + w1[j] * x1[j] + w2[j] * x2[j] + w3[j] * x3[j]); x0[j] = x1[j]; x1[j] = x2[j]; x2[j] = x3[j]; }
            st8(CONVX + (size_t)(t0 + k) * CONVD + ch, acc);
            const int tt = tt0 + k;
            if (tt >= SEQ - 3) st8f(F.out + OUT_SCP + ((size_t)(i * NBATCH + b) * 3 + (tt - (SEQ - 3))) * CONVD + ch, x3);
        }
    }
    for (int idx = gt; idx < NSMP * 384; idx += NGT) {
        const int bb = idx / 384, c8 = idx - bb * 384, ch = c8 * 8; const size_t row = TP + bb;
        const float* st = F.in[I_SSCONV] + ((size_t)(i * NSMP + bb) * 3) * CONVD + ch; float* so = F.out + OUT_SCS + ((size_t)(i * NSMP + bb) * 3) * CONVD + ch;
        float x3[8], s0[8], s1[8], s2[8], acc[8], w[8];
        ld8(PROJ + row * ODD_INP + 2048 + ch, x3); ld8f(st, s0); ld8f(st + CONVD, s1); ld8f(st + 2 * CONVD, s2);
        ld8f(cbp + ch, acc);
        ld8f(cwp + ch, w);
#pragma unroll
        for (int j = 0; j < 8; ++j) acc[j] += w[j] * s0[j];
        ld8f(cwp + CONVD + ch, w);
#pragma unroll
        for (int j = 0; j < 8; ++j) acc[j] += w[j] * s1[j];
        ld8f(cwp + 2 * CONVD + ch, w);
#pragma unroll
        for (int j = 0; j < 8; ++j) acc[j] += w[j] * s2[j];
        ld8f(cwp + 3 * CONVD + ch, w);
#pragma unroll
        for (int j = 0; j < 8; ++j) acc[j] = silu(acc[j] + w[j] * x3[j]);
        st8(CONVX + row * CONVD + ch, acc);
        st8f(so, s1); st8f(so + CONVD, s2); st8f(so + 2 * CONVD, x3);
    }
    for (int idx = gt; idx < MV * 32; idx += NGT) {
        const int hd = idx / MV, row = idx - hd * MV; GAS float* p = (GAS float*)DT + (size_t)hd * MP + row;
        const float x = *p + ((const GAS float*)F.in[I_DTB])[i * 32 + hd];
        *p = x > 20.f ? x : log1pf(__expf(x));
    }
}
DI void t_gnorm(Frame& F, int i) {
    const int gw = F.vcu * NWAVES + F.wave, NGW = F.G * NWAVES;
    const bf16* YG = (const bf16*)(F.ws + WS_YG); bf16* MIX = (bf16*)(F.ws + WS_MIX); const float* nw = F.in[I_SNORM] + (size_t)i * DIN;
    for (int m = gw; m < MV; m += NGW) {
#pragma unroll
        for (int j = 0; j < 4; ++j) { float f[8], g[8]; const int ch = (F.lane + 64 * j) * 8;
            ld8(YG + (size_t)m * DIN + ch, f); float s = 0.f;
#pragma unroll
            for (int k = 0; k < 8; ++k) s += f[k] * f[k];
            const float rstd = 1.f / sqrtf(wave_sum(s) * (1.f / 512.f) + EPS);
            ld8f(nw + ch, g);
#pragma unroll
            for (int k = 0; k < 8; ++k) f[k] = f[k] * rstd * g[k];
            st8(MIX + (size_t)m * DIN + ch, f); }
    }
}
DI void t_sattn(Frame& F, int l) {
    const bf16* Q = (const bf16*)(F.ws + WS_Q); bf16* O = (bf16*)(F.ws + WS_O);
    LAS float* SC = (LAS float*)F.lds; LAS float* RED = (LAS float*)(F.lds + 4096);
    const int hd = F.lane >> 5, l32 = F.lane & 31;
    const float c2 = 0.0625f * 1.44269504089f;
#define SA_LOAD(buf, base, r0) do { _Pragma("unroll") for (int u = 0; u < 8; ++u) { buf[u][0] = *(const GAS f32x4*)((base) + (size_t)((r0) + u) * DM); buf[u][1] = *(const GAS f32x4*)((base) + (size_t)((r0) + u) * DM + 4); } } while (0)
#define SA_DOT(buf, r0) do { _Pragma("unroll") for (int u = 0; u < 8; ++u) { float d = (q[0] * buf[u][0][0] + q[1] * buf[u][0][1]) + (q[2] * buf[u][0][2] + q[3] * buf[u][0][3]) + (q[4] * buf[u][1][0] + q[5] * buf[u][1][1]) + (q[6] * buf[u][1][2] + q[7] * buf[u][1][3]); \
        _Pragma("unroll") for (int o = 1; o < 32; o <<= 1) d += __shfl_xor(d, o); if (l32 == 0) SC[hd * 256 + (r0) + u] = d; } } while (0)
#define SA_PV(buf, r0) do { _Pragma("unroll") for (int u = 0; u < 8; ++u) { const float p = __builtin_amdgcn_exp2f((SC[hd * 256 + (r0) + u] - mx) * c2) * inv; \
        acc[0] += p * buf[u][0][0]; acc[1] += p * buf[u][0][1]; acc[2] += p * buf[u][0][2]; acc[3] += p * buf[u][0][3]; acc[4] += p * buf[u][1][0]; acc[5] += p * buf[u][1][1]; acc[6] += p * buf[u][1][2]; acc[7] += p * buf[u][1][3]; } } while (0)
    for (int it = F.vcu; it < 256; it += F.G) {
        const int b = it >> 1, hp = it & 1, w0 = F.wave * 32;
        const float* Kc = F.in[I_CK] + ((size_t)(l * NSMP + b) * NMEM) * DM + hp * 512 + F.lane * 8;
        const float* Vc = F.in[I_CV] + ((size_t)(l * NSMP + b) * NMEM) * DM + hp * 512 + F.lane * 8;
        f32x4 A[8][2], B[8][2];
        SA_LOAD(A, Kc, w0); SA_LOAD(B, Kc, w0 + 8);
        float q[8]; ld8(Q + (size_t)(TP + b) * DM + hp * 512 + F.lane * 8, q);
        SA_DOT(A, w0); SA_LOAD(A, Kc, w0 + 16);
        SA_DOT(B, w0 + 8); SA_LOAD(B, Kc, w0 + 24);
        SA_DOT(A, w0 + 16); SA_LOAD(A, Vc, w0);
        SA_DOT(B, w0 + 24); SA_LOAD(B, Vc, w0 + 8);
        __syncthreads();
        float mx = -3.0e38f;
#pragma unroll
        for (int j = 0; j < 8; ++j) mx = fmaxf(mx, SC[hd * 256 + l32 * 8 + j]);
#pragma unroll
        for (int o = 1; o < 32; o <<= 1) mx = fmaxf(mx, __shfl_xor(mx, o));
        float sm = 0.f;
#pragma unroll
        for (int j = 0; j < 8; ++j) sm += __builtin_amdgcn_exp2f((SC[hd * 256 + l32 * 8 + j] - mx) * c2);
#pragma unroll
        for (int o = 1; o < 32; o <<= 1) sm += __shfl_xor(sm, o);
        const float inv = 1.0f / sm;
        float acc[8];
#pragma unroll
        for (int j = 0; j < 8; ++j) acc[j] = 0.f;
        SA_PV(A, w0); SA_LOAD(A, Vc, w0 + 16);
        SA_PV(B, w0 + 8); SA_LOAD(B, Vc, w0 + 24);
        SA_PV(A, w0 + 16); SA_PV(B, w0 + 24);
#pragma unroll
        for (int j = 0; j < 8; ++j) RED[F.wave * 512 + F.lane * 8 + j] = acc[j];
        __syncthreads();
        float o = 0.f;
#pragma unroll
        for (int w = 0; w < 8; ++w) o += RED[w * 512 + F.tid];
        ((GAS bf16*)O)[(size_t)(TP + b) * DM + hp * 512 + F.tid] = (bf16)f2bf(o);
        __syncthreads();
    }
#undef SA_LOAD
#undef SA_DOT
#undef SA_PV
}
struct MiniBf16 { bf16* O; int ldc; const unsigned long long* ssq;
    DI void operator()(const f32x4 acc, size_t row, int col) const { const float rs = ssq ? 1.0f / sqrtf((float)((const GAS unsigned long long*)ssq)[row] * (1.0f / (1024.0f * 1048576.0f)) + EPS) : 1.0f;
        *(GAS v2u*)(O + row * ldc + col) = (v2u){pk2(acc[0] * rs, acc[1] * rs), pk2(acc[2] * rs, acc[3] * rs)}; } };
struct MiniResAdd { bf16* Xb; unsigned long long* ssq;
    DI void operator()(const f32x4 acc, size_t row, int col) const { GAS v2u* p = (GAS v2u*)(Xb + row * 1024 + col); const v2u w = *p;
        const float x[4] = {__uint_as_float(w[0] << 16) + acc[0], __uint_as_float(w[0] & 0xffff0000u) + acc[1], __uint_as_float(w[1] << 16) + acc[2], __uint_as_float(w[1] & 0xffff0000u) + acc[3]};
        *p = (v2u){pk2(x[0], x[1]), pk2(x[2], x[3])};
        float sq = (x[0] * x[0] + x[1] * x[1]) + (x[2] * x[2] + x[3] * x[3]); sq += __shfl_xor(sq, 16); sq += __shfl_xor(sq, 32);
        if ((col & 15) == 0) atomicAdd(ssq + row, (unsigned long long)(sq * 1048576.0f)); } };
struct MiniPoolState { float* out; const unsigned long long* ssq;
    DI void operator()(const f32x4 acc, size_t row, int col) const { const int b = (int)(row >> 11), j = (int)(row & 2047) - (SEQ - 15); if (j < 0) return;
        const float rs = 1.0f / sqrtf((float)((const GAS unsigned long long*)ssq)[row] * (1.0f / (1024.0f * 1048576.0f)) + EPS);
        *(GAS f32x4*)(out + ((size_t)b * 15 + j) * DM + col) = acc * rs; } };
struct MiniPoolGate { bf16* O; int ldc; const bf16* gate; int ldg; const float* scale;
    DI void operator()(const f32x4 acc, size_t row, int c) const { const f32x4 sc = *(const GAS f32x4*)(scale + c); const v2u gw = *(const GAS v2u*)(gate + row * ldg + c);
        *(GAS v2u*)(O + row * ldc + c) = (v2u){pk2(acc[0] * sc[0] * silu(bflo(gw.x)), acc[1] * sc[1] * silu(bfhi(gw.x))), pk2(acc[2] * sc[2] * silu(bflo(gw.y)), acc[3] * sc[3] * silu(bfhi(gw.y)))}; } };
template <int KB  , class Epi> DI void mini_gemm(Frame& F, const bf16* A  , int lda, const bf16* Bt, int ldb, int K, int nCB, const Epi& E, int shift, const float* gssq = nullptr  , int rbase = TP, int rstride = 16  ) {
    const int NGW = F.G * NWAVES; int vc = F.vcu - shift; vc = vc < 0 ? vc + F.G : vc; const int gw = F.wave * F.G + vc;
    const int fr = F.lane & 15, fq = F.lane >> 4;
    for (int u = gw; u < 8 * nCB; u += NGW) {
        const int rb = u & 7, cb = u >> 3;
        const size_t grow = (size_t)rbase + (size_t)rb * rstride + fr;
        const bf16* ap = A + grow * lda + 8 * fq;
        const bf16* bp = Bt + (size_t)(16 * cb + fr) * ldb + 8 * fq;
        f32x4 acc = (f32x4){0.f, 0.f, 0.f, 0.f};
        float rg[4] = {1.f, 1.f, 1.f, 1.f};
        if (gssq) { const GAS float* q = (const GAS float*)gssq + grow;
#pragma unroll
            for (int gi = 0; gi < 4; ++gi) { float a = 0.f;
#pragma unroll
                for (int e = 0; e < 8; ++e) a += q[(size_t)(gi * 8 + e) * MP];
                rg[gi] = 1.0f / sqrtf(a * (1.0f / 512.0f) + EPS); } }
        for (int k0 = 0; k0 < K; k0 += 32 * KB) {
            if (gssq && k0 > 0) { const int gi = k0 / 512; acc = acc * (gi == 1 ? rg[0] / rg[1] : gi == 2 ? rg[1] / rg[2] : rg[2] / rg[3]); }
            bf16x8 a[KB], b[KB];
#pragma unroll
            for (int s2 = 0; s2 < KB; ++s2) { a[s2] = *(const GAS bf16x8*)(ap + k0 + 32 * s2); b[s2] = *(const GAS bf16x8*)(bp + k0 + 32 * s2); }
#pragma unroll
            for (int s2 = 0; s2 < KB; ++s2) acc = __builtin_amdgcn_mfma_f32_16x16x32_bf16(b[s2], a[s2], acc, 0, 0, 0);
        }
        if (gssq) acc = acc * rg[3];
        E(acc, grow, 16 * cb + 4 * fq);
    }
}

DI void dt_gemm(Frame& F, const bf16* A, const bf16* Bt  , const unsigned long long* ssq, float* out  ) {
    const int NGW = F.G * NWAVES, gw = F.wave * F.G + F.vcu, fr = F.lane & 15, fq = F.lane >> 4;
    for (int u = gw; u < MV / 16; u += NGW) {
        const size_t row = (size_t)u * 16 + fr;
        const bf16* ap = A + row * DM + 8 * fq; const bf16* bp0 = Bt + (size_t)fr * DM + 8 * fq; const bf16* bp1 = bp0 + 16 * DM;
        f32x4 acc0 = (f32x4){0.f, 0.f, 0.f, 0.f}, acc1 = acc0;
        for (int k0 = 0; k0 < DM; k0 += 256) {
            bf16x8 a[8], b0[8], b1[8];
#pragma unroll
            for (int s2 = 0; s2 < 8; ++s2) { a[s2] = *(const GAS bf16x8*)(ap + k0 + 32 * s2); b0[s2] = *(const GAS bf16x8*)(bp0 + k0 + 32 * s2); b1[s2] = *(const GAS bf16x8*)(bp1 + k0 + 32 * s2); }
#pragma unroll
            for (int s2 = 0; s2 < 8; ++s2) { acc0 = __builtin_amdgcn_mfma_f32_16x16x32_bf16(b0[s2], a[s2], acc0, 0, 0, 0); acc1 = __builtin_amdgcn_mfma_f32_16x16x32_bf16(b1[s2], a[s2], acc1, 0, 0, 0); }
        }
        const float rs = 1.0f / sqrtf((float)((const GAS unsigned long long*)ssq)[row] * (1.0f / (1024.0f * 1048576.0f)) + EPS);
#pragma unroll
        for (int j = 0; j < 4; ++j) { ((GAS float*)out)[(size_t)(4 * fq + j) * MP + row] = acc0[j] * rs; ((GAS float*)out)[(size_t)(16 + 4 * fq + j) * MP + row] = acc1[j] * rs; }
    }
}

#define MFMA32(a, b, c) __builtin_amdgcn_mfma_f32_32x32x16_bf16((a), (b), (c), 0, 0, 0)
typedef short s16x4 __attribute__((ext_vector_type(4)));
constexpr int RS = 272;
DI bf16x8 frag_row(const LAS unsigned char* rowbase  , int ks) { return *(const LAS bf16x8*)(rowbase + ks * 32); }
DI bf16x8 frag_tr(const LAS unsigned char* trbase, int krow0, int c) {
    const s16x4 lo = __builtin_amdgcn_ds_read_tr16_b64_v4i16((LAS s16x4*)(trbase + krow0 * RS + c * 64));
    const s16x4 hi = __builtin_amdgcn_ds_read_tr16_b64_v4i16((LAS s16x4*)(trbase + (krow0 + 4) * RS + c * 64));
    return (bf16x8){lo[0], lo[1], lo[2], lo[3], hi[0], hi[1], hi[2], hi[3]};
}
DI void ssd_prompt_item(Frame& F, int i, int b, int head, float* ssqh) {
    LAS unsigned char* BM = F.lds;
    LAS unsigned char* CM = F.lds + 128 * RS;
    LAS unsigned char* LL = F.lds + 256 * RS;
    LAS unsigned char* XD = F.lds + 384 * RS;
    LAS unsigned char* SB = F.lds + 448 * RS;
    LAS unsigned char* XE = F.lds + 512 * RS;
    LAS float* DTL = (LAS float*)(F.lds + 576 * RS + 2048);
    LAS float* ACSB = (LAS float*)(F.lds + 576 * RS);
    const bf16* CONVX = (const bf16*)(F.ws + WS_CONVX); const bf16* PROJ = (const bf16*)(F.ws + WS_PROJ); const float* DT = (const float*)(F.ws + WS_DT); bf16* YG = (bf16*)(F.ws + WS_YG);
    const int w = F.wave, g = head >> 3, lb = w & 3, pb = w >> 2;
    const float Ah = -__expf(((const GAS float*)F.in[I_ALOG])[i * 32 + head]), Dh = ((const GAS float*)F.in[I_DSKIP])[i * 32 + head];
    f32x16 st;
#pragma unroll
    for (int k = 0; k < 16; ++k) st[k] = 0.f;
    for (int idx = F.tid; idx < 64 * RS / 16; idx += 512) *(LAS v4u*)(SB + idx * 16) = (v4u){0u, 0u, 0u, 0u};
    v4u vb[4], vc[4], vx[2], zt[2]; float dtx[2]; float d0 = 0.f, d1 = 0.f;
#define SSD_ISSUE(cc) do { const size_t r0_ = (size_t)b * SEQ + (size_t)(cc) * 128; \
        _Pragma("unroll") for (int i4 = 0; i4 < 4; ++i4) { const int q_ = F.tid + 512 * i4, s_ = q_ >> 4, ch_ = q_ & 15; const bf16* src_ = CONVX + (r0_ + s_) * CONVD + 2048 + g * 128 + ch_ * 8; \
            vb[i4] = *(const GAS v4u*)src_; vc[i4] = *(const GAS v4u*)(src_ + 512); } \
        _Pragma("unroll") for (int i2 = 0; i2 < 2; ++i2) { const int q_ = F.tid + 512 * i2, s_ = q_ >> 3, ch_ = q_ & 7; vx[i2] = *(const GAS v4u*)(CONVX + (r0_ + s_) * CONVD + head * 64 + ch_ * 8); \
            dtx[i2] = ((const GAS float*)DT)[(size_t)head * MP + r0_ + s_]; } \
        } while (0)
#define SSD_SCAN(cc) do { if (w == 0) { const int ln_ = F.lane; float a0 = d0 * Ah * 1.44269504089f, a1 = d1 * Ah * 1.44269504089f; \
        _Pragma("unroll") for (int o = 1; o < 64; o <<= 1) { const float t0 = __shfl_up(a0, o), t1 = __shfl_up(a1, o); if (ln_ >= o) { a0 += t0; a1 += t1; } } \
        a1 += __shfl(a0, 63); const float al_ = __shfl(a1, 63); LAS float* A_ = ACSB + ((cc) & 1) * 256; \
        A_[ln_] = a0; A_[ln_ + 64] = a1; A_[128 + ln_] = __builtin_amdgcn_exp2f(al_ - a0); A_[192 + ln_] = __builtin_amdgcn_exp2f(al_ - a1); } } while (0)
#define SSD_ISSUE_D(cc) do { const size_t r0_ = (size_t)b * SEQ + (size_t)(cc) * 128; d0 = ((const GAS float*)DT)[(size_t)head * MP + r0_ + F.lane]; d1 = ((const GAS float*)DT)[(size_t)head * MP + r0_ + 64 + F.lane]; } while (0)
#define SSD_ISSUE_Z(cc) do { const size_t r0_ = (size_t)b * SEQ + (size_t)(cc) * 128; _Pragma("unroll") for (int i2 = 0; i2 < 2; ++i2) { const int q_ = F.tid + 512 * i2; zt[i2] = *(const GAS v4u*)(PROJ + (r0_ + (q_ >> 3)) * ODD_INP + head * 64 + (q_ & 7) * 8); } } while (0)
    SSD_ISSUE(0); SSD_ISSUE_D(0); SSD_ISSUE_Z(0);
    SSD_SCAN(0);
    SSD_ISSUE_D(1);
    __syncthreads();
#define SSD_BAR() asm volatile("s_waitcnt lgkmcnt(0)\n\ts_barrier" ::: "memory")
    for (int c = 0; c < 16; ++c) {
        const size_t row0 = (size_t)b * SEQ + (size_t)c * 128;
        int tid = F.tid; asm volatile("" : "+v"(tid));
        const int lane = tid & 63, r = lane & 31, h = lane >> 5;
        LAS float* ACS = ACSB + (c & 1) * 256; LAS float* TE = ACS + 128;
#pragma unroll
        for (int i4 = 0; i4 < 4; ++i4) { const int q = tid + 512 * i4, s = q >> 4, ch = q & 15;
            *(LAS v4u*)(BM + s * RS + ch * 16) = vb[i4]; *(LAS v4u*)(CM + s * RS + ch * 16) = vc[i4]; }
        {
#pragma unroll
            for (int i2 = 0; i2 < 2; ++i2) { const int q = tid + 512 * i2, s = q >> 3, ch = q & 7;
                const float dts = dtx[i2], tes = TE[s]; float f[8]; unpack8(vx[i2], f);
                if (ch == 0) DTL[s] = dts;
#pragma unroll
                for (int j = 0; j < 8; ++j) f[j] *= dts;
                *(LAS v4u*)(XD + (s & 63) * RS + ((s >> 6) * 8 + ch) * 16) = pack8(f);
#pragma unroll
                for (int j = 0; j < 8; ++j) f[j] *= tes;
                *(LAS v4u*)(XE + (s & 63) * RS + ((s >> 6) * 8 + ch) * 16) = pack8(f); } }
        SSD_ISSUE((c + 1 < 16 ? c + 1 : 15));
        SSD_BAR();
        if (c + 1 < 16) SSD_SCAN(c + 1);
        SSD_ISSUE_D((c + 2 < 16 ? c + 2 : 15));
        const int rowoff = r * RS + 16 * h;
        const int troff = (8 * h + ((lane & 15) >> 2)) * RS + (2 * ((lane >> 4) & 1) + ((lane & 3) >> 1)) * 16 + 8 * (lane & 1);
        const int l = lb * 32 + r; const float al = ACS[l];
        const f32x16 zero16 = {0.f, 0.f, 0.f, 0.f, 0.f, 0.f, 0.f, 0.f, 0.f, 0.f, 0.f, 0.f, 0.f, 0.f, 0.f, 0.f};
#define SSD_CHAIN8(acc, first, AF, BF) do { _Pragma("unroll") for (int kb_ = 0; kb_ < 8; kb_ += 4) { bf16x8 fa_[4], fb_[4]; \
            _Pragma("unroll") for (int j_ = 0; j_ < 4; ++j_) { const int ks = kb_ + j_; fa_[j_] = AF; fb_[j_] = BF; } \
            __builtin_amdgcn_sched_barrier(0); \
            _Pragma("unroll") for (int j_ = 0; j_ < 4; ++j_) acc = MFMA32(fa_[j_], fb_[j_], (first && kb_ == 0 && j_ == 0) ? zero16 : acc); } } while (0)
#pragma unroll
        for (int bi = 0; bi < 2; ++bi) { const int sb = 2 * pb + bi;
            if (sb <= lb) {
                f32x16 cb;
                SSD_CHAIN8(cb, true, frag_row(BM + sb * 32 * RS + rowoff, ks), frag_row(CM + lb * 32 * RS + rowoff, ks));
                if (sb < lb) {
#pragma unroll
                    for (int k = 0; k < 16; ++k) { const int s0 = sb * 32 + (k & 3) + 8 * (k >> 2) + 4 * h; cb[k] = cb[k] * __builtin_amdgcn_exp2f(al - ACS[s0]); }
                } else {
#pragma unroll
                    for (int k = 0; k < 16; ++k) { const int s0 = sb * 32 + (k & 3) + 8 * (k >> 2) + 4 * h; cb[k] = cb[k] * (__builtin_amdgcn_exp2f(fminf(al - ACS[s0], 0.f)) * (s0 <= l ? 1.f : 0.f)); }
                }
#pragma unroll
                for (int q4 = 0; q4 < 4; ++q4) *(LAS v2u*)(LL + l * RS + (sb * 4 + q4) * 16 + 8 * h) = (v2u){pk2(cb[4 * q4], cb[4 * q4 + 1]), pk2(cb[4 * q4 + 2], cb[4 * q4 + 3])};
            } }
        f32x16 yo;
        SSD_CHAIN8(yo, true, frag_row(SB + pb * 32 * RS + rowoff, ks), frag_row(CM + lb * 32 * RS + rowoff, ks));
        { const float dec = __builtin_amdgcn_exp2f(ACS[127]);
#pragma unroll
          for (int k = 0; k < 16; ++k) st[k] *= dec; }
        SSD_CHAIN8(st, false, frag_tr(BM + troff, 16 * ks, lb), frag_tr(XE + troff, 16 * (ks & 3), 2 * (ks >> 2) + pb));
        SSD_BAR();
        f32x16 yd = zero16;
        for (int sbk = 0; sbk <= lb; ++sbk) { bf16x8 fx[2], fl[2];
#pragma unroll
            for (int j = 0; j < 2; ++j) { const int ks = 2 * sbk + j; fx[j] = frag_tr(XD + troff, 16 * (ks & 3), 2 * (ks >> 2) + pb); fl[j] = frag_row(LL + lb * 32 * RS + rowoff, ks); }
            __builtin_amdgcn_sched_barrier(0);
            yd = MFMA32(fx[0], fl[0], yd); yd = MFMA32(fx[1], fl[1], yd); }
#undef SSD_CHAIN8
        { const float el = __builtin_amdgcn_exp2f(al);
#pragma unroll
          for (int q4 = 0; q4 < 4; ++q4) { const int p0 = pb * 32 + 8 * q4 + 4 * h;
              *(LAS f32x4*)(BM + l * RS + p0 * 4) = (f32x4){yd[4 * q4] + el * yo[4 * q4], yd[4 * q4 + 1] + el * yo[4 * q4 + 1], yd[4 * q4 + 2] + el * yo[4 * q4 + 2], yd[4 * q4 + 3] + el * yo[4 * q4 + 3]}; } }
        SSD_BAR();
#pragma unroll
        for (int i2 = 0; i2 < 2; ++i2) { const int q = tid + 512 * i2, tk = q >> 3, c16 = q & 7;
            const f32x4 ya = *(const LAS f32x4*)(BM + tk * RS + c16 * 32), yb = *(const LAS f32x4*)(BM + tk * RS + c16 * 32 + 16);
            float xf[8], zf[8], f[8]; unpack8(*(const LAS v4u*)(XD + (tk & 63) * RS + ((tk >> 6) * 64 + c16 * 8) * 2), xf); unpack8(zt[i2], zf);
            { const float rdt = Dh * __builtin_amdgcn_rcpf(DTL[tk]);
#pragma unroll
              for (int j = 0; j < 8; ++j) xf[j] *= rdt; }
            f[0] = (ya[0] + xf[0]) * silu(zf[0]); f[1] = (ya[1] + xf[1]) * silu(zf[1]); f[2] = (ya[2] + xf[2]) * silu(zf[2]); f[3] = (ya[3] + xf[3]) * silu(zf[3]);
            f[4] = (yb[0] + xf[4]) * silu(zf[4]); f[5] = (yb[1] + xf[5]) * silu(zf[5]); f[6] = (yb[2] + xf[6]) * silu(zf[6]); f[7] = (yb[3] + xf[7]) * silu(zf[7]);
            *(GAS v4u*)(YG + (row0 + tk) * DIN + head * 64 + c16 * 8) = pack8(f);
            float sq = (f[0] * f[0] + f[1] * f[1]) + (f[2] * f[2] + f[3] * f[3]) + (f[4] * f[4] + f[5] * f[5]) + (f[6] * f[6] + f[7] * f[7]);
            sq += __shfl_xor(sq, 1); sq += __shfl_xor(sq, 2); sq += __shfl_xor(sq, 4);
            if (c16 == 0) ((GAS float*)ssqh)[(size_t)head * MP + row0 + tk] = sq; }
        SSD_ISSUE_Z((c + 1 < 16 ? c + 1 : 15));
        SSD_BAR();
        { const int p = pb * 32 + r;
#pragma unroll
          for (int q4 = 0; q4 < 4; ++q4) *(LAS v2u*)(SB + p * RS + (lb * 4 + q4) * 16 + 8 * h) = (v2u){pk2(st[4 * q4], st[4 * q4 + 1]), pk2(st[4 * q4 + 2], st[4 * q4 + 3])}; }
    }
#undef SSD_BAR
#undef SSD_ISSUE
#undef SSD_ISSUE_Z
#undef SSD_ISSUE_D
#undef SSD_SCAN
    { const int r = F.lane & 31, h = F.lane >> 5; const int p = pb * 32 + r; float* so = F.out + OUT_SP + (((size_t)(i * NBATCH + b) * NHEAD + head) * 64 + p) * 128;
#pragma unroll
      for (int q4 = 0; q4 < 4; ++q4) { const int n0 = lb * 32 + 8 * q4 + 4 * h; *(GAS f32x4*)(so + n0) = (f32x4){st[4 * q4], st[4 * q4 + 1], st[4 * q4 + 2], st[4 * q4 + 3]}; } }
    __syncthreads();
}
DI void ssd_sample(Frame& F, int i, float* ssqh) {
    const bf16* CONVX = (const bf16*)(F.ws + WS_CONVX); const bf16* PROJ = (const bf16*)(F.ws + WS_PROJ); const float* DT = (const float*)(F.ws + WS_DT); bf16* YG = (bf16*)(F.ws + WS_YG);
    const int gw = F.vcu * NWAVES + F.wave, NGW = F.G * NWAVES, psub = F.lane >> 5, n4 = (F.lane & 31) * 4;
    for (int it = gw; it < NSMP * NHEAD; it += NGW) {
        const int b = it >> 5, head = it & 31, g = head >> 3; const size_t row = TP + b;
        const size_t sbase = (((size_t)(i * NSMP + b) * NHEAD + head) * 64) * 128 + n4;
        const float* sin = F.in[I_SSSM] + sbase + (size_t)psub * 128; float* sout = F.out + OUT_SS + sbase + (size_t)psub * 128;
        f32x4 s0[32];
#pragma unroll
        for (int pp = 0; pp < 32; ++pp) s0[pp] = *(const GAS f32x4*)(sin + (size_t)pp * 256);
        const float dt = ((const GAS float*)DT)[(size_t)head * MP + row], Ah = -__expf(((const GAS float*)F.in[I_ALOG])[i * 32 + head]), Dh = ((const GAS float*)F.in[I_DSKIP])[i * 32 + head];
        const float dA = __expf(dt * Ah);
        const v2u bw = *(const GAS v2u*)(CONVX + row * CONVD + 2048 + g * 128 + n4), cw = *(const GAS v2u*)(CONVX + row * CONVD + 2560 + g * 128 + n4);
        const f32x4 B4 = (f32x4){bflo(bw.x), bfhi(bw.x), bflo(bw.y), bfhi(bw.y)}, C4 = (f32x4){bflo(cw.x), bfhi(cw.x), bflo(cw.y), bfhi(cw.y)};
        const float xl = bf1(((const GAS bf16*)CONVX)[row * CONVD + head * 64 + F.lane]), zl = bf1(((const GAS bf16*)PROJ)[row * ODD_INP + head * 64 + F.lane]);
        float sq = 0.f;
#pragma unroll
        for (int pp = 0; pp < 32; ++pp) { const int p = 2 * pp + psub;
            const float xe = __shfl(xl, 2 * pp), xo = __shfl(xl, 2 * pp + 1), xv = psub ? xo : xe, dx = dt * xv;
            const f32x4 sn = s0[pp] * dA + B4 * dx; *(GAS f32x4*)(sout + (size_t)pp * 256) = sn;
            float d = (sn[0] * C4[0] + sn[1] * C4[1]) + (sn[2] * C4[2] + sn[3] * C4[3]);
#pragma unroll
            for (int o = 1; o < 32; o <<= 1) d += __shfl_xor(d, o);
            const float ze = __shfl(zl, 2 * pp), zo = __shfl(zl, 2 * pp + 1), z = psub ? zo : ze;
            if ((F.lane & 31) == 0) { const float yv = (d + Dh * xv) * silu(z); sq += yv * yv; ((GAS bf16*)YG)[row * DIN + head * 64 + p] = (bf16)f2bf(yv); } }
        sq += __shfl_xor(sq, 32);
        if (F.lane == 0) ((GAS float*)ssqh)[(size_t)head * MP + row] = sq;
    }
}

#if MK_PER_PHASE
#define GRID_BAR() do { } while (0)
#else
#define GRID_BAR() do { for (int rb_ = 0; rb_ < REP_BAR; ++rb_) xcd_barrier(bar); } while (0)
#endif
#ifdef DBG_ONLY
#define IN(k) (lo <= (k) && (k) < hi && ((((k) < 2) ? (k) : 2 + ((k) - 2) % 11) == DBG_ONLY))
#else
#define IN(k) (lo <= (k) && (k) < hi)
#endif
#define SEAM(k) do { if ((k) + 1 < hi) GRID_BAR(); } while (0)
#define REFRESH() do { int t_ = threadIdx.x; asm volatile("" : "+v"(t_)); F.tid = t_; F.lane = t_ & 63; } while (0)
constexpr int PH_PER_LAYER = 11, PH_LAYER0 = 2, N_PHASES = PH_LAYER0 + 4 * PH_PER_LAYER;
template <int l, int hf> DI void phase_in_mix(Frame& F, const int lo, const int hi, const XcdBarrier& bar) {
    unsigned char* ws = F.ws; LAS unsigned char* ring = F.lds; const int c = (int)blockIdx.x;
    bf16* H = (bf16*)(ws + WS_H); bf16* PROJ = (bf16*)(ws + WS_PROJ);
    constexpr int pb = PH_LAYER0 + l * PH_PER_LAYER, i = l >> 1; constexpr bool evn = (l & 1) == 0;
    unsigned long long* SSQ = (unsigned long long*)(ws + WS_SSQ); constexpr size_t SSQ_I = (size_t)MV;
    constexpr int NHALF = evn ? 2 : 1, HROWS = TP / NHALF;
        if (IN(pb + 0)) {
            constexpr int N = evn ? EVEN_IN : ODD_INP;
            pg8::Gemm g{H + (size_t)hf * HROWS * DM, evn ? (const bf16*)(ws + WS_WTE_IN) + (size_t)i * EVEN_IN * DM : (const bf16*)(ws + WS_WTO_IN) + (size_t)i * ODD_WROWS * DM, DM, DM, DM};
            pg8::StaticOrder S; S.init(64 / NHALF, N / 256, F.G, c);
            pg8::EpiBf16S E{PROJ + (size_t)hf * HROWS * N, N, SSQ + (2 * l) * SSQ_I + (size_t)hf * HROWS};
            if (hf) __syncthreads();
            for (int rep = 0; rep < REP_G1; ++rep) pg8::gemm_phase<pg8::EpiBf16S, pg8::AddrStd, true, true>(ring, g, S, E, pg8::AddrStd{});
            REFRESH();
            const bf16* Bt0 = evn ? (const bf16*)(ws + WS_WTE_IN) + (size_t)i * EVEN_IN * DM : (const bf16*)(ws + WS_WTO_IN) + (size_t)i * ODD_WROWS * DM;
            if (hf == 0) {
            if constexpr (evn) {
                const bf16* WTU = (const bf16*)(ws + WS_WTU) + (size_t)i * DM * DM;
                for (int rep = 0; rep < REP_MINI; ++rep) {
                mini_gemm<16>(F, H, DM, WTU, DM, DM, 64, MiniBf16{PROJ, N, SSQ + (2 * l) * SSQ_I}, 0);
                mini_gemm<16>(F, H, DM, Bt0 + (size_t)1024 * DM, DM, DM, (N - 1024) / 16, MiniBf16{PROJ + 1024, N, SSQ + (2 * l) * SSQ_I}, 64);
                mini_gemm<16>(F, H, DM, WTU, DM, DM, 64, MiniPoolState{F.out + OUT_PP + (size_t)i * NBATCH * 15 * DM, SSQ + (2 * l) * SSQ_I}, 128, nullptr, SEQ - 16, SEQ); }
            } else {
                for (int rep = 0; rep < REP_MINI; ++rep) mini_gemm<16>(F, H, DM, Bt0, DM, DM, N / 16, MiniBf16{PROJ, N, SSQ + (2 * l) * SSQ_I}, 0);
                dt_gemm(F, H, Bt0 + (size_t)ODD_INP * DM, SSQ + (2 * l) * SSQ_I, (float*)(ws + WS_DT));
            }
            }
            SEAM(pb + 0);
        }
        if (IN(pb + 1)) { REFRESH(); for (int rep = 0; rep < REP_THIN; ++rep) { if constexpr (evn) t_even_mix(F, i, hf); else t_conv(F, i); } if (hf == NHALF - 1) SEAM(pb + 1); }
}
template <int l> DI void layer_phases(Frame& F, const int lo, const int hi, const XcdBarrier& bar) {
    unsigned char* ws = F.ws;
    LAS unsigned char* ring = F.lds;
    bf16* H = (bf16*)(ws + WS_H); bf16* Qb = (bf16*)(ws + WS_Q); bf16* Pb = (bf16*)(ws + WS_PB); bf16* Ob = (bf16*)(ws + WS_O); bf16* DIFF = (bf16*)(ws + WS_DIFF);
    bf16* MIX = (bf16*)(ws + WS_MIX); bf16* PROJ = (bf16*)(ws + WS_PROJ);
    const int c = (int)blockIdx.x;

    constexpr int pb = PH_LAYER0 + l * PH_PER_LAYER, i = l >> 1; constexpr bool evn = (l & 1) == 0;
    unsigned long long* SSQ = (unsigned long long*)(ws + WS_SSQ);
    constexpr size_t SSQ_I = (size_t)MV;
        phase_in_mix<l, 0>(F, lo, hi, bar); if constexpr (evn) { REFRESH(); phase_in_mix<l, 1>(F, lo, hi, bar); }
        if constexpr (!evn) if (IN(pb + 2)) {
                REFRESH();
                const bool stream_first = (F.vcu & 1) != 0;
                if (stream_first) { for (int rep = 0; rep < REP_SSDS; ++rep) ssd_sample(F, i, rep == 0 ? (float*)(ws + WS_SSQH) + (size_t)i * 32 * MP : (float*)(ws + WS_DIFF)); __syncthreads(); }
                for (int rep = 0; rep < REP_SSD; ++rep) for (int it = F.vcu; it < NBATCH * NHEAD; it += F.G) ssd_prompt_item(F, i, it >> 5, it & 31, rep == 0 ? (float*)(ws + WS_SSQH) + (size_t)i * 32 * MP : (float*)(ws + WS_DIFF));
                if (!stream_first) { REFRESH(); for (int rep = 0; rep < REP_SSDS; ++rep) ssd_sample(F, i, rep == 0 ? (float*)(ws + WS_SSQH) + (size_t)i * 32 * MP : (float*)(ws + WS_DIFF)); }
            SEAM(pb + 2);
        }
        if (IN(pb + 4)) {
            bf16* YGb = (bf16*)(ws + WS_YG); const float* GSSQ = (const float*)(ws + WS_SSQH) + (size_t)i * 32 * MP;
            pg8::Gemm g{evn ? MIX : YGb, evn ? (const bf16*)(ws + WS_WTE_OUT) + (size_t)i * DM * 2048 : (const bf16*)(ws + WS_WTO_OUT) + (size_t)i * DM * 2048, DIN, DIN, DIN};
            pg8::StaticOrder S; S.init(64, 4, F.G, c);
            pg8::EpiResAdd E{H, SSQ + (2 * l + 1) * SSQ_I, 0};
            pg8::EpiResAdd E0{H, SSQ, hi > 9999 ? 0 : 1};
            if constexpr (evn) {
                for (int rep = 1; rep < REP_RES; ++rep) pg8::gemm_phase<pg8::EpiResAdd, pg8::AddrStd, true, true>(ring, g, S, E0, pg8::AddrStd{});
                pg8::gemm_phase<pg8::EpiResAdd, pg8::AddrStd, true, true>(ring, g, S, E, pg8::AddrStd{});
                REFRESH(); mini_gemm<16>(F, MIX, DIN, g.Bt, DIN, DIN, 64, MiniResAdd{H, SSQ + (2 * l + 1) * SSQ_I}, 0);
            } else {
                for (int rep = 1; rep < REP_RES; ++rep) pg8::gemm_phase<pg8::EpiResAdd, pg8::AddrStd, true, true, true>(ring, g, S, E0, pg8::AddrStd{}, GSSQ);
                pg8::gemm_phase<pg8::EpiResAdd, pg8::AddrStd, true, true, true>(ring, g, S, E, pg8::AddrStd{}, GSSQ);
                REFRESH(); mini_gemm<16>(F, YGb, DIN, g.Bt, DIN, DIN, 64, MiniResAdd{H, SSQ + (2 * l + 1) * SSQ_I}, 0, GSSQ);
            }
            SEAM(pb + 4);
        }
        if (IN(pb + 6)) {
            pg8::Gemm g{H, (const bf16*)(ws + WS_WTQ) + (size_t)l * DM * DM, DM, DM, DM};
            pg8::StaticOrder S; S.init(64, 4, F.G, c);
            pg8::EpiBf16S E{Qb, DM, SSQ + (2 * l + 1) * SSQ_I};
            for (int rep = 0; rep < REP_G4; ++rep) pg8::gemm_phase<pg8::EpiBf16S, pg8::AddrStd, true, true>(ring, g, S, E, pg8::AddrStd{});
            REFRESH(); for (int rep = 0; rep < REP_MINI; ++rep) mini_gemm<16>(F, H, DM, g.Bt, DM, DM, 64, MiniBf16{Qb, DM, SSQ + (2 * l + 1) * SSQ_I}, 0);
            SEAM(pb + 6);
        }
        if (IN(pb + 7)) {
            const bool stream_first = (F.vcu & 1) != 0;
            if (stream_first) { REFRESH(); for (int rep = 0; rep < REP_SATTN; ++rep) t_sattn(F, l); __syncthreads(); }
            { pg8::Gemm g{Qb, (const bf16*)(ws + WS_KB) + (size_t)l * 2048 * DM, DM, DM, 256};
              pg8::StaticOrder S; S.init(64, 4, F.G, c);
              pg8::EpiSoftmax E{Pb, DM, 0.0625f * 1.44269504089f};
              for (int rep = 0; rep < REP_G5; ++rep) { pg8::gemm_phase<pg8::EpiSoftmax, pg8::AddrScore, false, true>(ring, g, S, E, pg8::AddrScore{}); __syncthreads(); } }
            asm volatile("s_waitcnt vmcnt(0)" ::: "memory"); __syncthreads();
            { pg8::Gemm g{Pb, (const bf16*)(ws + WS_VT) + (size_t)l * 8 * 1024 * 256, DM, 256, 256};
              pg8::StaticOrder S; S.init(64, 4, F.G, c);
              pg8::EpiBf16S E{Ob, DM, nullptr};
              for (int rep = 0; rep < REP_G6; ++rep) pg8::gemm_phase<pg8::EpiBf16S, pg8::AddrPV, true, true>(ring, g, S, E, pg8::AddrPV{}); }
            __syncthreads();
            if (!stream_first) { REFRESH(); for (int rep = 0; rep < REP_SATTN; ++rep) t_sattn(F, l); }
            SEAM(pb + 7);
        }
        if (IN(pb + 9)) {
            pg8::Gemm g{Ob, (const bf16*)(ws + WS_WTO) + (size_t)l * DM * DM, DM, DM, DM};
            pg8::StaticOrder S; S.init(64, 4, F.G, c);
            pg8::EpiResAdd E{H, SSQ + (2 * l + 2) * SSQ_I, 0};
            for (int rep = 1; rep < REP_RES; ++rep) { pg8::EpiResAdd E0{H, SSQ, hi > 9999 ? 0 : 1}; pg8::gemm_phase<pg8::EpiResAdd, pg8::AddrStd, true, true>(ring, g, S, E0, pg8::AddrStd{}); }
            pg8::gemm_phase<pg8::EpiResAdd, pg8::AddrStd, true, true>(ring, g, S, E, pg8::AddrStd{});
            REFRESH(); mini_gemm<16>(F, Ob, DM, g.Bt, DM, DM, 64, MiniResAdd{H, SSQ + (2 * l + 2) * SSQ_I}, 0);
            SEAM(pb + 9);
        }
        if constexpr (l == 3) if (IN(pb + 10)) { REFRESH(); t_norm(F, F.in[I_NFIN], true); SEAM(pb + 10); }
}
__global__ void __launch_bounds__(NWAVES * 64, 2) trunk_fwd(Args args) {
    extern __shared__ __attribute__((aligned(16))) unsigned char lds[];
    Frame F;
    F.lds = (LAS unsigned char*)lds;
    F.tid = threadIdx.x; F.lane = F.tid & 63; F.wave = __builtin_amdgcn_readfirstlane(F.tid >> 6);
    F.G = gridDim.x; { const int bx = blockIdx.x; F.vcu = (F.G % 8 == 0) ? (bx % 8) * (F.G / 8) + bx / 8 : bx; }
    F.in = args.in; F.out = args.out; F.ws = args.ws;
    unsigned char* ws = args.ws;
    volatile LAS unsigned* MISC = (volatile LAS unsigned*)(F.lds + MISC_OFF);
    if (F.tid < 32) MISC[F.tid] = 0u;
    __syncthreads();
#if MK_PER_PHASE
    XcdBarrier bar; bar.bar = (unsigned*)(ws + WS_CTL) + CW_BAR; bar.x = 0; bar.st = MISC + 8;
#else
    XcdBarrier bar = xcd_barrier_post((unsigned*)(ws + WS_CTL) + CW_BAR, MISC + 8);
#endif
    const int lo = args.ph_lo, hi = args.ph_hi;
    LAS unsigned char* ring = F.lds;
    const int c = (int)blockIdx.x;

    if (IN(0)) { REFRESH(); for (int rep = 0; rep < REP_P0; ++rep) p0_prologue(F); SEAM(0); }
    if (IN(1)) {
        for (int rep = 0; rep < REP_P1; ++rep) {
        { pg8::Gemm g{(const bf16*)(ws + WS_MEMB), (const bf16*)(ws + WS_WTK), DM, DM, DM}; pg8::StaticOrder S; S.init(8, 16, F.G, c);
          pg8::EpiKproj E{F.out + OUT_MK, (bf16*)(ws + WS_KB)};
          pg8::gemm_phase<pg8::EpiKproj, pg8::AddrStd, true, true>(ring, g, S, E, pg8::AddrStd{}); }
        { pg8::Gemm g{(const bf16*)(ws + WS_MEMB), (const bf16*)(ws + WS_WTV), DM, DM, DM}; pg8::StaticOrder S; S.init(8, 16, F.G, (c + F.G / 2) % F.G);
          pg8::EpiKproj E{F.out + OUT_MV, nullptr};
          pg8::gemm_phase<pg8::EpiKproj, pg8::AddrStd, true, true>(ring, g, S, E, pg8::AddrStd{}); }
        { pg8::Gemm g{(const bf16*)(ws + WS_WTV), (const bf16*)(ws + WS_MEMB), DM, DM, DM}; pg8::StaticOrder S; S.init(16, 8, F.G, c);
          pg8::EpiVT E{F.out + OUT_MV, (bf16*)(ws + WS_VT)};
          pg8::gemm_phase<pg8::EpiVT, pg8::AddrStd, true, true>(ring, g, S, E, pg8::AddrStd{}); }
        }
        SEAM(1);
    }
    layer_phases<0>(F, lo, hi, bar); layer_phases<1>(F, lo, hi, bar); layer_phases<2>(F, lo, hi, bar); layer_phases<3>(F, lo, hi, bar);
#undef IN
#undef SEAM
}

extern "C" void kernel_launch(void* const* d_in, const int* in_sizes, int n_in, void* d_out, int out_size, void* d_ws, size_t ws_size, hipStream_t stream) {
    static int grid = 0;
    if (grid == 0) {
        if (n_in != 29 || (size_t)out_size != OUT_TOTAL || ws_size < WS_END) { fprintf(stderr, "kernel_launch: unexpected shapes: n_in %d out %d ws %zu (need %zu)\n", n_in, out_size, ws_size, (size_t)WS_END); grid = -1; return; }
        if (hipFuncSetAttribute((const void*)trunk_fwd, hipFuncAttributeMaxDynamicSharedMemorySize, LDS_BYTES) != hipSuccess) { fprintf(stderr, "kernel_launch: hipFuncSetAttribute failed\n"); grid = -1; return; }
        int dev = 0, cus = 0;
        if (hipGetDevice(&dev) != hipSuccess || hipDeviceGetAttribute(&cus, hipDeviceAttributeMultiprocessorCount, dev) != hipSuccess) { grid = -1; return; }
        (void)hipGetLastError();
        grid = cus < 256 ? cus : 256;
        if (grid != 256) fprintf(stderr, "kernel_launch: %d CUs; this kernel is built for a 256-CU grid\n", cus);
    }
    if (grid < 0) return;
    (void)hipMemsetAsync((char*)d_ws + WS_CTL, 0, CTL_ZERO_BYTES, stream);
    Args a{};
    for (int i = 0; i < 29; ++i) a.in[i] = (const float*)d_in[i];
    a.out = (float*)d_out; a.ws = (unsigned char*)d_ws;
#if MK_PER_PHASE
    for (int p = 0; p < N_PHASES; ++p) {
        if (p >= PH_LAYER0) { const int l = (p - PH_LAYER0) / PH_PER_LAYER, k = (p - PH_LAYER0) % PH_PER_LAYER; if (k == 3 || k == 5 || k == 8 || (k == 2 && (l & 1) == 0) || (k == 10 && l != 3)) continue; }
        a.ph_lo = p; a.ph_hi = p + 1;
        hipLaunchKernelGGL(trunk_fwd, dim3(grid), dim3(NWAVES * 64), LDS_BYTES, stream, a);
    }
#else
    a.ph_lo = 0; a.ph_hi = N_PHASES;
    hipLaunchKernelGGL(trunk_fwd, dim3(grid), dim3(NWAVES * 64), LDS_BYTES, stream, a);
#endif
}
```

```cpp
#include <hip/hip_runtime.h>
#include <cstdio>
#include <cstdint>

#ifndef REP_SSD
#define REP_SSD 1
#endif
#ifndef REP_SSDS
#define REP_SSDS 1
#endif
#ifndef REP_SATTN
#define REP_SATTN 1
#endif
#ifndef REP_THIN
#define REP_THIN 1
#endif
#ifndef REP_G1
#define REP_G1 1
#endif
#ifndef REP_G2
#define REP_G2 1
#endif
#ifndef REP_G4
#define REP_G4 1
#endif
#ifndef REP_G5
#define REP_G5 1
#endif
#ifndef REP_G6
#define REP_G6 1
#endif
#ifndef REP_P1
#define REP_P1 1
#endif
#ifndef REP_RES
#define REP_RES 1
#endif
#ifndef REP_BAR
#define REP_BAR 1
#endif
#ifndef REP_MINI
#define REP_MINI 1
#endif
#ifndef REP_P0
#define REP_P0 1
#endif
#ifndef MK_PER_PHASE
#define MK_PER_PHASE 0
#endif

namespace pg8 {
#define PG8_LAS __attribute__((address_space(3)))
typedef unsigned short bf16_t;
typedef short bf16x8 __attribute__((ext_vector_type(8)));
typedef float f32x4 __attribute__((ext_vector_type(4)));
typedef unsigned u32x4 __attribute__((ext_vector_type(4)));
typedef unsigned u32x2 __attribute__((ext_vector_type(2)));
constexpr int BM = 256, BK = 64, HALF = 128, HTB = HALF * BK * 2  , STAGE_BYTES = 8 * HTB, NXCD = 8, WGM = 8;

__host__ __device__ __forceinline__ int lds_byte(int r, int c) { const int st = (r >> 4) * 2 + (c >> 5), rr = r & 15, cc = c & 31, ob = rr * 64 + cc * 2; return st * 1024 + (ob ^ (((ob >> 9) & 1) << 5)); }
__host__ __device__ __forceinline__ void stage_rc(int b, int& R, int& C) { const int st = b / 1024, sb = b % 1024, swz = sb ^ (((sb >> 9) & 1) << 5); R = (st >> 1) * 16 + swz / 64; C = (st & 1) * 32 + (swz % 64) / 2; }
__host__ __device__ __forceinline__ int perm32(int rho) { const int n = rho >> 4, i = rho & 15; return 8 * (i >> 2) + 4 * n + (i & 3); }

struct Unit { int pm, pn; };
struct Gemm { const bf16_t* A; const bf16_t* Bt; int lda, ldb, K; };

struct StaticOrder {
    int nM, nN, nwg, G, c;
    __host__ __device__ void init(int nM_, int nN_, int G_, int c_) { nM = nM_; nN = nN_; nwg = nM * nN; G = G_; c = c_; }
    __host__ __device__ bool next(int i, Unit& u) const {
        const long L = (long)i * G + c; if (L >= nwg) return false;
        int wgid = (int)L; { const int q = nwg / NXCD, r = nwg % NXCD, xcd = wgid % NXCD, off = wgid / NXCD; wgid = (xcd < r ? xcd * (q + 1) : r * (q + 1) + (xcd - r) * q) + off; }
        const int nig = WGM * nN, gid = wgid / nig, fm = gid * WGM, gsz = (nM - fm) < WGM ? (nM - fm) : WGM;
        u.pm = fm + ((wgid % nig) % gsz); u.pn = (wgid % nig) / gsz; return true;
    }
};
struct AddrStd  { __device__ __forceinline__ size_t a(const Unit& u, const Gemm& g) const { return (size_t)u.pm * 256 * g.lda; }
                  __device__ __forceinline__ size_t b(const Unit& u, const Gemm& g) const { return (size_t)u.pn * 256 * g.ldb; } };
struct AddrColA { __device__ __forceinline__ size_t a(const Unit& u, const Gemm& g) const { return (size_t)u.pm * 256 * g.lda + (size_t)u.pn * 256; }
                  __device__ __forceinline__ size_t b(const Unit& u, const Gemm& g) const { return (size_t)u.pn * 256 * g.ldb; } };
struct AddrScore { __device__ __forceinline__ size_t a(const Unit& u, const Gemm& g) const { return (size_t)u.pm * 256 * g.lda + (size_t)u.pn * 256; }
                   __device__ __forceinline__ size_t b(const Unit& u, const Gemm& g) const { return (size_t)(u.pm >> 3) * 256 * g.ldb + (size_t)u.pn * 256; } };
struct AddrPV   { __device__ __forceinline__ size_t a(const Unit& u, const Gemm& g) const { return (size_t)u.pm * 256 * g.lda + (size_t)u.pn * 256; }
                  __device__ __forceinline__ size_t b(const Unit& u, const Gemm& g) const { return ((size_t)(u.pm >> 3) * 1024 + (size_t)u.pn * 256) * 256; } };

__device__ __forceinline__ unsigned cvt_pk_bf16(float lo, float hi) { unsigned r; asm volatile("v_cvt_pk_bf16_f32 %0, %1, %2" : "=v"(r) : "v"(lo), "v"(hi)); return r; }
__device__ __forceinline__ float bf_lo(unsigned w) { return __uint_as_float(w << 16); }
__device__ __forceinline__ float bf_hi(unsigned w) { return __uint_as_float(w & 0xffff0000u); }
__device__ __forceinline__ float silu_f(float z) { return z * __builtin_amdgcn_rcpf(1.0f + __builtin_amdgcn_exp2f(-1.44269504089f * z)); }

struct EpiBf16S {
    static constexpr bool PERM = true, AFTER_DRAIN = false;
    bf16_t* O; int ldc; const unsigned long long* ssq;
    __device__ __forceinline__ void operator()(const f32x4 (&acc)[2][2][4][2], const Unit& u, int wr, int wc, int fr, int fq) const {
        const int row0 = u.pm * BM + wr * 64 + fr, col0 = u.pn * BM + wc * 32 + 8 * fq;
        unsigned long long sv[2][4];
        if (ssq) {
#pragma unroll
            for (int ai = 0; ai < 2; ++ai)
#pragma unroll
                for (int m = 0; m < 4; ++m) sv[ai][m] = ssq[row0 + ai * HALF + m * 16]; }
#pragma unroll
        for (int ai = 0; ai < 2; ++ai)
#pragma unroll
            for (int m = 0; m < 4; ++m) { const size_t row = (size_t)(row0 + ai * HALF + m * 16); bf16_t* rowp = O + row * ldc + col0;
                float rs = 1.0f;
                if (ssq) rs = __builtin_amdgcn_rsqf((float)sv[ai][m] * (1.0f / (1024.0f * 1048576.0f)) + 1e-6f);
#pragma unroll
                for (int bj = 0; bj < 2; ++bj) { const f32x4 v0 = acc[ai][bj][m][0] * rs, v1 = acc[ai][bj][m][1] * rs;
                    u32x4 w; w.x = cvt_pk_bf16(v0[0], v0[1]); w.y = cvt_pk_bf16(v0[2], v0[3]); w.z = cvt_pk_bf16(v1[0], v1[1]); w.w = cvt_pk_bf16(v1[2], v1[3]);
                    *(u32x4*)(rowp + bj * HALF) = w; } }
    }
};
struct EpiEvenIn {
    static constexpr bool PERM = true, AFTER_DRAIN = false;
    bf16_t* O; const unsigned long long* ssq;
    __device__ __forceinline__ void operator()(const f32x4 (&acc)[2][2][4][2], const Unit& u, int wr, int wc, int fr, int fq) const {
        const int row0 = u.pm * BM + wr * 64 + fr, cw = wc * 32 + 8 * fq;
        unsigned long long sv[2][4];
#pragma unroll
        for (int ai = 0; ai < 2; ++ai)
#pragma unroll
            for (int m = 0; m < 4; ++m) sv[ai][m] = ssq[row0 + ai * HALF + m * 16];
#pragma unroll
        for (int ai = 0; ai < 2; ++ai)
#pragma unroll
            for (int m = 0; m < 4; ++m) { const size_t row = (size_t)(row0 + ai * HALF + m * 16); bf16_t* rowp = O + row * 4096;
                const float rs = __builtin_amdgcn_rsqf((float)sv[ai][m] * (1.0f / (1024.0f * 1048576.0f)) + 1e-6f);
                if (u.pn < 8) {
#pragma unroll
                    for (int bj = 0; bj < 2; ++bj) { const f32x4 v0 = acc[ai][bj][m][0] * rs, v1 = acc[ai][bj][m][1] * rs;
                        u32x4 w; w.x = cvt_pk_bf16(v0[0], v0[1]); w.y = cvt_pk_bf16(v0[2], v0[3]); w.z = cvt_pk_bf16(v1[0], v1[1]); w.w = cvt_pk_bf16(v1[2], v1[3]);
                        *(u32x4*)(rowp + u.pn * BM + cw + bj * HALF) = w; }
                } else {
                    float o[8];
#pragma unroll
                    for (int n = 0; n < 2; ++n)
#pragma unroll
                        for (int j = 0; j < 4; ++j) { const float a = acc[ai][0][m][n][j] * rs, b = acc[ai][1][m][n][j] * rs;
                            o[4 * n + j] = u.pn < 16 ? a * b : a * (b * __builtin_amdgcn_rcpf(1.0f + __builtin_amdgcn_exp2f(-1.44269504089f * b))); }
                    u32x4 w; w.x = cvt_pk_bf16(o[0], o[1]); w.y = cvt_pk_bf16(o[2], o[3]); w.z = cvt_pk_bf16(o[4], o[5]); w.w = cvt_pk_bf16(o[6], o[7]);
                    *(u32x4*)(rowp + 2048 + (u.pn - 8) * HALF + cw) = w; } }
    }
};
struct EpiResAdd {
    static constexpr bool PERM = true, AFTER_DRAIN = false;
    bf16_t* Xb; unsigned long long* ssq; int dry;
    __device__ __forceinline__ void row_update(const f32x4 (&acc)[2][2][4][2], int ai, int m, const u32x4 (&w)[2], bf16_t* rowp, size_t row, int fq) const {
        float sq = 0.f;
#pragma unroll
        for (int bj = 0; bj < 2; ++bj) { const unsigned int ww[4] = {w[bj].x, w[bj].y, w[bj].z, w[bj].w}; float o[8];
#pragma unroll
            for (int e = 0; e < 4; ++e) { o[2 * e] = __uint_as_float(ww[e] << 16) + acc[ai][bj][m][e >> 1][2 * (e & 1)]; o[2 * e + 1] = __uint_as_float(ww[e] & 0xffff0000u) + acc[ai][bj][m][e >> 1][2 * (e & 1) + 1]; }
#pragma unroll
            for (int e = 0; e < 8; e += 2) sq += o[e] * o[e] + o[e + 1] * o[e + 1];
            u32x4 v; v.x = cvt_pk_bf16(o[0], o[1]); v.y = cvt_pk_bf16(o[2], o[3]); v.z = cvt_pk_bf16(o[4], o[5]); v.w = cvt_pk_bf16(o[6], o[7]);
            *(u32x4*)(rowp + bj * HALF) = v; }
        sq += __shfl_xor(sq, 16); sq += __shfl_xor(sq, 32);
        if (fq == 0) atomicAdd(ssq + row, (unsigned long long)(sq * 1048576.0f));
    }
    __device__ __forceinline__ void operator()(const f32x4 (&acc)[2][2][4][2], const Unit& u, int wr, int wc, int fr, int fq) const {
        if (dry) return;
        const int row0 = u.pm * BM + wr * 64 + fr, col0 = u.pn * BM + wc * 32 + 8 * fq;
        u32x4 w[4][2][2];
#define RA_LOAD(p) do { _Pragma("unroll") for (int r = 0; r < 2; ++r) _Pragma("unroll") for (int bj = 0; bj < 2; ++bj) \
            w[(p) & 3][r][bj] = *(const u32x4*)(Xb + (size_t)(row0 + ((p) >> 1) * HALF + (2 * ((p) & 1) + r) * 16) * 1024 + col0 + bj * HALF); } while (0)
        RA_LOAD(0); RA_LOAD(1);
#pragma unroll
        for (int p = 0; p < 4; ++p) {
            if (p + 2 < 4) RA_LOAD(p + 2);
#pragma unroll
            for (int r = 0; r < 2; ++r) { const int ai = p >> 1, m = 2 * (p & 1) + r; const size_t row = (size_t)(row0 + ai * HALF + m * 16);
                row_update(acc, ai, m, w[p & 3][r], Xb + row * 1024 + col0, row, fq); }
            asm volatile("" ::: "memory"); }
#undef RA_LOAD
    }
};
struct EpiPoolGate {
    static constexpr bool PERM = true, AFTER_DRAIN = false;
    bf16_t* O; int ldc; const bf16_t* gate; int ldg; const float* scale;
    __device__ __forceinline__ void operator()(const f32x4 (&acc)[2][2][4][2], const Unit& u, int wr, int wc, int fr, int fq) const {
        const int row0 = u.pm * BM + wr * 64 + fr, col0 = u.pn * BM + wc * 32 + 8 * fq;
        f32x4 sc[2][2];
#pragma unroll
        for (int bj = 0; bj < 2; ++bj)
#pragma unroll
            for (int n = 0; n < 2; ++n) sc[bj][n] = *(const f32x4*)(scale + col0 + bj * HALF + 4 * n);
#pragma unroll
        for (int ai = 0; ai < 2; ++ai)
#pragma unroll
            for (int m = 0; m < 4; ++m) { const size_t row = (size_t)(row0 + ai * HALF + m * 16);
#pragma unroll
                for (int bj = 0; bj < 2; ++bj) { const u32x4 gw = *(const u32x4*)(gate + row * ldg + col0 + bj * HALF);
                    const f32x4 v0 = acc[ai][bj][m][0] * sc[bj][0], v1 = acc[ai][bj][m][1] * sc[bj][1];
                    u32x4 w; w.x = cvt_pk_bf16(v0[0] * silu_f(bf_lo(gw.x)), v0[1] * silu_f(bf_hi(gw.x))); w.y = cvt_pk_bf16(v0[2] * silu_f(bf_lo(gw.y)), v0[3] * silu_f(bf_hi(gw.y)));
                    w.z = cvt_pk_bf16(v1[0] * silu_f(bf_lo(gw.z)), v1[1] * silu_f(bf_hi(gw.z))); w.w = cvt_pk_bf16(v1[2] * silu_f(bf_lo(gw.w)), v1[3] * silu_f(bf_hi(gw.w)));
                    *(u32x4*)(O + row * ldc + col0 + bj * HALF) = w; } }
    }
};
struct EpiKproj {
    static constexpr bool PERM = false, AFTER_DRAIN = false;
    float* outK; bf16_t* KB;
    __device__ __forceinline__ void operator()(const f32x4 (&acc)[2][2][4][2], const Unit& u, int wr, int wc, int fr, int fq) const {
        const int l = u.pn >> 2, row0 = u.pm * BM + wr * 64 + fr, col0 = (u.pn & 3) * BM + wc * 32 + 4 * fq;
        float* ob = outK + (size_t)l * 2048 * 1024; bf16_t* kb = KB + (size_t)l * 2048 * 1024;
#pragma unroll
        for (int ai = 0; ai < 2; ++ai)
#pragma unroll
            for (int m = 0; m < 4; ++m) { const size_t ro = (size_t)(row0 + ai * HALF + m * 16) * 1024 + col0;
#pragma unroll
                for (int bj = 0; bj < 2; ++bj)
#pragma unroll
                    for (int n = 0; n < 2; ++n) { const f32x4 v = acc[ai][bj][m][n]; *(f32x4*)(ob + ro + bj * HALF + n * 16) = v;
                        if (KB) { u32x2 w; w.x = cvt_pk_bf16(v[0], v[1]); w.y = cvt_pk_bf16(v[2], v[3]); *(u32x2*)(kb + ro + bj * HALF + n * 16) = w; } } }
    }
};
struct EpiVT {
    static constexpr bool PERM = false, AFTER_DRAIN = false;
    float* outV; bf16_t* VT;
    __device__ __forceinline__ void operator()(const f32x4 (&acc)[2][2][4][2], const Unit& u, int wr, int wc, int fr, int fq) const {
        const int l = u.pm >> 2, e0 = (u.pm & 3) * BM + wr * 64 + fr, b = u.pn, m0 = wc * 32 + 4 * fq;
        bf16_t* vb = VT + ((size_t)l * 8 + b) * 1024 * 256;
#pragma unroll
        for (int ai = 0; ai < 2; ++ai)
#pragma unroll
            for (int m = 0; m < 4; ++m) { const int e = e0 + ai * HALF + m * 16;
#pragma unroll
                for (int bj = 0; bj < 2; ++bj)
#pragma unroll
                    for (int n = 0; n < 2; ++n) { const f32x4 v = acc[ai][bj][m][n]; const int mm = m0 + bj * HALF + n * 16;
                        u32x2 w; w.x = cvt_pk_bf16(v[0], v[1]); w.y = cvt_pk_bf16(v[2], v[3]); *(u32x2*)(vb + (size_t)e * 256 + mm) = w;
                        float* ov = outV + (size_t)l * 2048 * 1024 + (size_t)(b * 256 + mm) * 1024 + e;
                        ov[0] = v[0]; ov[1024] = v[1]; ov[2048] = v[2]; ov[3072] = v[3]; } }
    }
};
struct EpiSoftmax {
    static constexpr bool PERM = true, AFTER_DRAIN = true;
    bf16_t* P; int ldc; float c2;
    __device__ __forceinline__ void fused(f32x4 (&acc)[2][2][4][2], const Unit& u, int wr, int wc, int fr, int fq, PG8_LAS unsigned char* lds, int wid, int lane) const {
        PG8_LAS f32x4* TM = (PG8_LAS f32x4*)lds;
        PG8_LAS f32x4* TS = (PG8_LAS f32x4*)(lds + 4096);
        PG8_LAS float* TMf = (PG8_LAS float*)lds; PG8_LAS float* TSf = (PG8_LAS float*)(lds + 4096);
#pragma unroll
        for (int ai = 0; ai < 2; ++ai)
#pragma unroll
            for (int m = 0; m < 4; ++m) { float mx = -3.0e38f;
#pragma unroll
                for (int bj = 0; bj < 2; ++bj)
#pragma unroll
                    for (int n = 0; n < 2; ++n) { const f32x4 x = acc[ai][bj][m][n]; mx = fmaxf(mx, fmaxf(fmaxf(x[0], x[1]), fmaxf(x[2], x[3]))); }
                mx = fmaxf(mx, __shfl_xor(mx, 16)); mx = fmaxf(mx, __shfl_xor(mx, 32));
                if (fq == 0) TMf[(ai * HALF + wr * 64 + m * 16 + fr) * 4 + wc] = mx; }
        asm volatile("s_waitcnt lgkmcnt(0)" ::: "memory"); __builtin_amdgcn_s_barrier(); asm volatile("" ::: "memory");
#pragma unroll
        for (int ai = 0; ai < 2; ++ai)
#pragma unroll
            for (int m = 0; m < 4; ++m) { const int rl = ai * HALF + wr * 64 + m * 16 + fr; const f32x4 t = TM[rl]; const float mx = fmaxf(fmaxf(t[0], t[1]), fmaxf(t[2], t[3])); float s = 0.f;
#pragma unroll
                for (int bj = 0; bj < 2; ++bj)
#pragma unroll
                    for (int n = 0; n < 2; ++n) { f32x4 x = acc[ai][bj][m][n];
#pragma unroll
                        for (int j = 0; j < 4; ++j) { x[j] = __builtin_amdgcn_exp2f((x[j] - mx) * c2); s += x[j]; }
                        acc[ai][bj][m][n] = x; }
                s += __shfl_xor(s, 16); s += __shfl_xor(s, 32);
                if (fq == 0) TSf[rl * 4 + wc] = s; }
        asm volatile("s_waitcnt lgkmcnt(0)" ::: "memory"); __builtin_amdgcn_s_barrier(); asm volatile("" ::: "memory");
        const int row0 = u.pm * BM + wr * 64 + fr, col0 = u.pn * BM + wc * 32 + 8 * fq;
#pragma unroll
        for (int ai = 0; ai < 2; ++ai)
#pragma unroll
            for (int m = 0; m < 4; ++m) { const int rl = ai * HALF + wr * 64 + m * 16 + fr; const f32x4 t = TS[rl]; const float inv = 1.0f / ((t[0] + t[1]) + (t[2] + t[3]));
                bf16_t* rowp = P + (size_t)(row0 + ai * HALF + m * 16) * ldc + col0;
#pragma unroll
                for (int bj = 0; bj < 2; ++bj) { const f32x4 v0 = acc[ai][bj][m][0] * inv, v1 = acc[ai][bj][m][1] * inv;
                    u32x4 w; w.x = cvt_pk_bf16(v0[0], v0[1]); w.y = cvt_pk_bf16(v0[2], v0[3]); w.z = cvt_pk_bf16(v1[0], v1[1]); w.w = cvt_pk_bf16(v1[2], v1[3]);
                    *(u32x4*)(rowp + bj * HALF) = w; } }
    }
};

template <class Epi, class Addr, bool ALIGN_EPI = false, bool SP2 = false, bool KS = false>
__device__ __forceinline__ void gemm_phase(PG8_LAS unsigned char* lds, const Gemm g, const StaticOrder& S, const Epi& E, const Addr AD, const float* ssqh = nullptr) {
    int tid = threadIdx.x; asm volatile("" : "+v"(tid));
    const int wid = __builtin_amdgcn_readfirstlane(tid >> 6), lane = tid & 63, wr = wid >> 2, wc = wid & 3, fr = lane & 15, fq = lane >> 4;
    const int K = g.K, nt = K / BK;
    unsigned voffA[2], voffB[2];
#pragma unroll
    for (int i = 0; i < 2; ++i) { int R, C; stage_rc(tid * 16 + i * 8192, R, C); const int Rb = Epi::PERM ? ((R & ~31) + perm32(R & 31)) : R;
        voffA[i] = (unsigned)(R * g.lda + C) * 2u; voffB[i] = (unsigned)(Rb * g.ldb + C) * 2u; }
    const size_t kstep = (size_t)(BK * 2);
    const size_t hstepA = (size_t)HALF * g.lda * 2, hstepB = (size_t)HALF * g.ldb * 2;
    const unsigned ldsw = (unsigned)wid * 1024u;
    const int aoff = lds_byte(wr * 64 + fr, fq * 8), boff = lds_byte(wc * 32 + fr, fq * 8);
#define PG8_SA(b, h) (((b) * 2 + (h)) * HTB)
#define PG8_SB(b, h) ((4 + (b) * 2 + (h)) * HTB)
#define PG8_STAGE(bufoff, gbase, voff) do { _Pragma("unroll") for (int _i = 0; _i < 2; ++_i) \
        __builtin_amdgcn_global_load_lds((const unsigned*)((const char*)(gbase) + (voff)[_i]), (PG8_LAS unsigned*)(lds + (bufoff) + ldsw + _i * 8192), 16, 0, 0); } while (0)
#define PG8_LDA(dst, b, h) do { _Pragma("unroll") for (int m = 0; m < 4; ++m) _Pragma("unroll") for (int k = 0; k < 2; ++k) dst[m][k] = *(const PG8_LAS bf16x8*)(lds + PG8_SA(b, h) + aoff + m * 2048 + k * 1024); } while (0)
#define PG8_LDB(dst, b, h) do { _Pragma("unroll") for (int n = 0; n < 2; ++n) _Pragma("unroll") for (int k = 0; k < 2; ++k) dst[n][k] = *(const PG8_LAS bf16x8*)(lds + PG8_SB(b, h) + boff + n * 2048 + k * 1024); } while (0)
#define PG8_MMA(ai, bj, At, Bt) do { __builtin_amdgcn_s_setprio(1); _Pragma("unroll") for (int m = 0; m < 4; ++m) _Pragma("unroll") for (int n = 0; n < 2; ++n) _Pragma("unroll") for (int k = 0; k < 2; ++k) \
        acc[ai][bj][m][n] = __builtin_amdgcn_mfma_f32_16x16x32_bf16(Bt[n][k], At[m][k], acc[ai][bj][m][n], 0, 0, 0); __builtin_amdgcn_s_setprio(0); } while (0)
#define PG8_WAIT_V(n) asm volatile("s_waitcnt vmcnt(" #n ")" ::: "memory")
#define PG8_WAIT_L(n) asm volatile("s_waitcnt lgkmcnt(" #n ")" ::: "memory")
#define PG8_BAR __builtin_amdgcn_s_barrier()
#define PG8_SCHED __builtin_amdgcn_sched_barrier(0)
    Unit cur, nxt; int ui = 0;
    if (!S.next(0, cur)) return;
    f32x4 acc[2][2][4][2];
#pragma unroll
    for (int a = 0; a < 2; ++a)
#pragma unroll
        for (int b = 0; b < 2; ++b)
#pragma unroll
            for (int m = 0; m < 4; ++m)
#pragma unroll
                for (int n = 0; n < 2; ++n) acc[a][b][m][n] = (f32x4){0.f, 0.f, 0.f, 0.f};
    bf16x8 At[4][2], B0[2][2], B1[2][2];
    const char* cA = (const char*)g.A + 2 * AD.a(cur, g); const char* cB = (const char*)g.Bt + 2 * AD.b(cur, g);
    PG8_LAS float* kstab = (PG8_LAS float*)(lds + STAGE_BYTES);
    if constexpr (KS) { if (tid < 256) { const float* q = ssqh + (size_t)(cur.pm * BM + tid); float r[4];
#pragma unroll
            for (int gi = 0; gi < 4; ++gi) { float a = 0.f;
#pragma unroll
                for (int e = 0; e < 8; ++e) a += q[(size_t)(gi * 8 + e) * 16640];
                r[gi] = 1.0f / sqrtf(a * (1.0f / 512.0f) + 1e-6f); }
            *(PG8_LAS f32x4*)(kstab + tid * 4) = (f32x4){r[0] / r[1], r[1] / r[2], r[2] / r[3], r[3]}; } }
#define PG8_KSCALE(gi) do { _Pragma("unroll") for (int ai = 0; ai < 2; ++ai) _Pragma("unroll") for (int m = 0; m < 4; ++m) { const float f_ = kstab[(ai * HALF + wr * 64 + m * 16 + fr) * 4 + (gi)]; \
        _Pragma("unroll") for (int bj = 0; bj < 2; ++bj) _Pragma("unroll") for (int n = 0; n < 2; ++n) acc[ai][bj][m][n] = acc[ai][bj][m][n] * f_; } } while (0)
    if constexpr (SP2) {
        PG8_STAGE(PG8_SB(0, 0), cB, voffB); PG8_STAGE(PG8_SB(0, 1), cB + hstepB, voffB); PG8_STAGE(PG8_SA(0, 0), cA, voffA); PG8_STAGE(PG8_SA(0, 1), cA + hstepA, voffA);
        if (wr == 1) PG8_BAR;
        PG8_WAIT_V(2); PG8_BAR;
        PG8_STAGE(PG8_SB(1, 0), cB + kstep, voffB); PG8_STAGE(PG8_SA(1, 0), cA + kstep, voffA); PG8_STAGE(PG8_SB(1, 1), cB + hstepB + kstep, voffB);
        PG8_WAIT_V(6); PG8_BAR;
    } else {
        PG8_STAGE(PG8_SB(0, 0), cB, voffB); PG8_STAGE(PG8_SA(0, 0), cA, voffA); PG8_STAGE(PG8_SB(0, 1), cB + hstepB, voffB); PG8_STAGE(PG8_SA(0, 1), cA + hstepA, voffA);
        if (wr == 1) PG8_BAR;
        PG8_WAIT_V(4); PG8_BAR;
        PG8_STAGE(PG8_SB(1, 0), cB + kstep, voffB); PG8_STAGE(PG8_SA(1, 0), cA + kstep, voffA); PG8_STAGE(PG8_SB(1, 1), cB + hstepB + kstep, voffB);
        PG8_WAIT_V(6); PG8_BAR;
    }
    for (;;) {
        const bool has_next = S.next(ui + 1, nxt);
        const char* nA = has_next ? (const char*)g.A + 2 * AD.a(nxt, g) : cA; const char* nB = has_next ? (const char*)g.Bt + 2 * AD.b(nxt, g) : cB;
        for (int seg = 0; seg < (KS ? 4 : 1); ++seg) {
        if constexpr (KS) { if (seg > 0) PG8_KSCALE(seg - 1); }
        for (int t = KS ? seg * 8 : 0; t < (KS ? seg * 8 + 8 : nt); t += 2) {
            const bool last = (t == nt - 2);
            const char* a1 = cA + (size_t)(t + 1) * kstep;
            const char* a2 = last ? nA : cA + (size_t)(t + 2) * kstep; const char* b2 = last ? nB : cB + (size_t)(t + 2) * kstep;
            const char* a3 = a2 + kstep; const char* b3 = b2 + kstep;
            if constexpr (SP2) {
            PG8_LDB(B0, 0, 0); PG8_LDB(B1, 0, 1); PG8_SCHED; PG8_LDA(At, 0, 0); PG8_STAGE(PG8_SA(1, 1), a1 + hstepA, voffA);
            PG8_WAIT_V(8); PG8_WAIT_L(0); PG8_BAR; PG8_MMA(0, 0, At, B0); PG8_MMA(0, 1, At, B1); PG8_BAR; PG8_SCHED;
            PG8_LDA(At, 0, 1); PG8_STAGE(PG8_SB(0, 0), b2, voffB); PG8_STAGE(PG8_SB(0, 1), b2 + hstepB, voffB); PG8_STAGE(PG8_SA(0, 0), a2, voffA);
            PG8_WAIT_V(8); PG8_WAIT_L(0); PG8_BAR; PG8_MMA(1, 0, At, B0); PG8_MMA(1, 1, At, B1); PG8_BAR; PG8_SCHED;
            PG8_LDB(B0, 1, 0); PG8_LDB(B1, 1, 1); PG8_SCHED; PG8_LDA(At, 1, 0); PG8_STAGE(PG8_SA(0, 1), a2 + hstepA, voffA);
            PG8_WAIT_V(8); PG8_WAIT_L(0); PG8_BAR; PG8_MMA(0, 0, At, B0); PG8_MMA(0, 1, At, B1); PG8_BAR; PG8_SCHED;
            PG8_LDA(At, 1, 1); PG8_STAGE(PG8_SB(1, 0), b3, voffB); PG8_STAGE(PG8_SB(1, 1), b3 + hstepB, voffB); PG8_STAGE(PG8_SA(1, 0), a3, voffA);
            PG8_WAIT_V(8); PG8_WAIT_L(0); PG8_BAR; PG8_MMA(1, 0, At, B0); PG8_MMA(1, 1, At, B1); PG8_BAR; PG8_SCHED;
            } else {
            PG8_LDB(B0, 0, 0); PG8_SCHED; PG8_LDA(At, 0, 0); PG8_STAGE(PG8_SA(1, 1), a1 + hstepA, voffA);
            PG8_WAIT_L(8); PG8_BAR; PG8_WAIT_L(0); PG8_MMA(0, 0, At, B0); PG8_BAR; PG8_SCHED;
            PG8_LDB(B1, 0, 1); PG8_STAGE(PG8_SB(0, 0), b2, voffB);
            PG8_BAR; PG8_WAIT_L(0); PG8_MMA(0, 1, At, B1); PG8_BAR;
            PG8_LDA(At, 0, 1); PG8_STAGE(PG8_SA(0, 0), a2, voffA);
            PG8_BAR; PG8_WAIT_L(0); PG8_MMA(1, 0, At, B0); PG8_BAR; PG8_SCHED;
            PG8_STAGE(PG8_SB(0, 1), b2 + hstepB, voffB);
            PG8_WAIT_V(6); PG8_BAR; PG8_MMA(1, 1, At, B1); PG8_BAR;
            PG8_LDB(B0, 1, 0); PG8_SCHED; PG8_LDA(At, 1, 0); PG8_STAGE(PG8_SA(0, 1), a2 + hstepA, voffA);
            PG8_WAIT_L(8); PG8_BAR; PG8_WAIT_L(0); PG8_MMA(0, 0, At, B0); PG8_BAR; PG8_SCHED;
            PG8_LDB(B1, 1, 1); PG8_STAGE(PG8_SB(1, 0), b3, voffB);
            PG8_BAR; PG8_WAIT_L(0); PG8_MMA(0, 1, At, B1); PG8_BAR;
            PG8_LDA(At, 1, 1); PG8_STAGE(PG8_SA(1, 0), a3, voffA);
            PG8_BAR; PG8_WAIT_L(0); PG8_MMA(1, 0, At, B0); PG8_BAR; PG8_SCHED;
            PG8_STAGE(PG8_SB(1, 1), b3 + hstepB, voffB);
            PG8_WAIT_V(6); PG8_BAR; PG8_MMA(1, 1, At, B1); PG8_BAR;
            }
        }
        }
        if constexpr (KS) PG8_KSCALE(3);
        if constexpr (ALIGN_EPI) { if (wr == 0) PG8_BAR; }
        if constexpr (!Epi::AFTER_DRAIN) { E(acc, cur, wr, wc, fr, fq); }
        if (!has_next) break;
#pragma unroll
        for (int a = 0; a < 2; ++a)
#pragma unroll
            for (int b = 0; b < 2; ++b)
#pragma unroll
                for (int m = 0; m < 4; ++m)
#pragma unroll
                    for (int n = 0; n < 2; ++n) acc[a][b][m][n] = (f32x4){0.f, 0.f, 0.f, 0.f};
        cur = nxt; cA = nA; cB = nB; ++ui;
        if constexpr (ALIGN_EPI) { if (wr == 1) PG8_BAR; }
    }
    PG8_WAIT_V(0);
    if constexpr (!ALIGN_EPI) { if (wr == 0) PG8_BAR; }
    PG8_BAR;
    if constexpr (Epi::AFTER_DRAIN) { E.fused(acc, cur, wr, wc, fr, fq, lds, wid, lane); }
#undef PG8_KSCALE
#undef PG8_SA
#undef PG8_SB
#undef PG8_STAGE
#undef PG8_LDA
#undef PG8_LDB
#undef PG8_MMA
#undef PG8_WAIT_V
#undef PG8_WAIT_L
#undef PG8_BAR
#undef PG8_SCHED
}
}

constexpr int NWAVES = 8;
constexpr int DM = 1024, TP = 16384, NBATCH = 8, SEQ = 2048, NSMP = 128, MV = TP + NSMP  , MP = 16640  , NPAN = 65;
constexpr int EVEN_IN = 6144, EVEN_P = 4096  , ODD_IN = 5152, ODD_WROWS = 5376  , ODD_INP = 5120  , DIN = 2048, CONVD = 3072, NHEAD = 32, NMEM = 256;
constexpr float EPS = 1e-6f;
constexpr size_t OUT_Y = 0, OUT_MK = 16908288, OUT_MV = 25296896, OUT_PP = 33685504, OUT_PS = 33931264, OUT_CP = 37863424, OUT_CS = 37896192,
                 OUT_SCP = 38420480, OUT_SCS = 38567936, OUT_SP = 40927232, OUT_SS = 45121536, OUT_TOTAL = 112230400;
constexpr size_t MiB = 1u << 20;
constexpr size_t WS_CTL = 0, CTL_ZERO_BYTES = 5 * MiB;
constexpr size_t WS_SSQ = 1 * MiB;
constexpr size_t WS_GSSQ = 3 * MiB;
constexpr size_t WS_WTE_IN = 5 * MiB;
constexpr size_t WS_WTE_OUT = WS_WTE_IN + 24 * MiB;
constexpr size_t WS_WTO_IN = WS_WTE_OUT + 8 * MiB;
constexpr size_t WS_WTO_OUT = WS_WTO_IN + 21 * MiB;
constexpr size_t WS_WTQ = WS_WTO_OUT + 8 * MiB;
constexpr size_t WS_WTK = WS_WTQ + 8 * MiB, WS_WTV = WS_WTK + 8 * MiB, WS_WTO = WS_WTV + 8 * MiB;
constexpr size_t WS_WTP = WS_WTO + 8 * MiB;
constexpr size_t WS_MEMB = WS_WTP + 1 * MiB;
constexpr size_t WS_KB = WS_MEMB + 4 * MiB;
constexpr size_t WS_VT = WS_KB + 16 * MiB;
constexpr size_t WS_H = WS_VT + 16 * MiB;
constexpr size_t WS_Q = WS_H + 34 * MiB, WS_PB = WS_Q + 34 * MiB, WS_O = WS_PB + 34 * MiB, WS_DIFF = WS_O + 34 * MiB;
constexpr size_t WS_MIX = WS_DIFF + 34 * MiB;
constexpr size_t WS_YG = WS_MIX + 66 * MiB;
constexpr size_t WS_CONVX = WS_YG + 66 * MiB;
constexpr size_t WS_DT = WS_CONVX + 98 * MiB;
constexpr size_t WS_PROJ = WS_DT + 3 * MiB;
constexpr size_t WS_WTU = WS_PROJ + 196 * MiB;
constexpr size_t WS_SSQH = WS_WTU + 4 * MiB;
constexpr size_t WS_END = WS_SSQH + 5 * MiB;
constexpr int CW_BAR = 4096;
constexpr int RING_BYTES = 131072, SSD_SMALL_OFF = 131072, MISC_OFF = 163840 - 128, LDS_BYTES = 163840;

#define GAS __attribute__((address_space(1)))
#define LAS __attribute__((address_space(3)))
#define DI __device__ __forceinline__
typedef unsigned short bf16;
typedef unsigned v4u __attribute__((ext_vector_type(4)));
typedef unsigned v2u __attribute__((ext_vector_type(2)));
typedef float f32x4 __attribute__((ext_vector_type(4)));
typedef float f32x16 __attribute__((ext_vector_type(16)));
typedef short bf16x8 __attribute__((ext_vector_type(8)));
typedef GAS unsigned gu32;
#define LDS_WAIT() asm volatile("s_waitcnt lgkmcnt(0)" ::: "memory")
DI unsigned f2bf(float f) { unsigned u = __builtin_bit_cast(unsigned, f); return (u + 0x7fffu + ((u >> 16) & 1u)) >> 16; }
DI unsigned pk2(float lo, float hi) { unsigned r; asm("v_cvt_pk_bf16_f32 %0, %1, %2" : "=v"(r) : "v"(lo), "v"(hi)); return r; }
DI float bflo(unsigned w) { return __uint_as_float(w << 16); }
DI float bfhi(unsigned w) { return __uint_as_float(w & 0xffff0000u); }
DI float bf1(bf16 h) { return __uint_as_float(((unsigned)h) << 16); }
DI void unpack8(const v4u v, float (&f)[8]) { f[0] = bflo(v.x); f[1] = bfhi(v.x); f[2] = bflo(v.y); f[3] = bfhi(v.y); f[4] = bflo(v.z); f[5] = bfhi(v.z); f[6] = bflo(v.w); f[7] = bfhi(v.w); }
DI v4u pack8(const float (&f)[8]) { v4u o; o.x = pk2(f[0], f[1]); o.y = pk2(f[2], f[3]); o.z = pk2(f[4], f[5]); o.w = pk2(f[6], f[7]); return o; }
DI void ld8(const bf16* p, float (&f)[8]) { unpack8(*(const GAS v4u*)p, f); }
DI void ld8f(const float* p, float (&f)[8]) { const f32x4 a = *(const GAS f32x4*)p, b = *(const GAS f32x4*)(p + 4); f[0] = a[0]; f[1] = a[1]; f[2] = a[2]; f[3] = a[3]; f[4] = b[0]; f[5] = b[1]; f[6] = b[2]; f[7] = b[3]; }
DI void st8(bf16* p, const float (&f)[8]) { *(GAS v4u*)p = pack8(f); }
DI void st8f(float* p, const float (&f)[8]) { *(GAS f32x4*)p = (f32x4){f[0], f[1], f[2], f[3]}; *(GAS f32x4*)(p + 4) = (f32x4){f[4], f[5], f[6], f[7]}; }
DI float silu(float z) { return z * __builtin_amdgcn_rcpf(1.0f + __builtin_amdgcn_exp2f(-1.44269504089f * z)); }
DI float wave_sum(float v) {
#pragma unroll
    for (int o = 1; o < 64; o <<= 1) v += __shfl_xor(v, o);
    return v;
}

#define XB_TMO      128
#define XB_XCNT(j)  (256  + 64 * (j))
#define XB_XSUB(j)  (1280 + 64 * (j))
#define XB_XGEN(j)  (2304 + 64 * (j))
#define XB_TOP      3328
#define XB_TOPGEN   3392
#define XCD_BAR_WORDS 3456
#define XB_SPIN_CAP (1u << 18)
DI unsigned xb_ld(unsigned* p)              { return __hip_atomic_load(p, __ATOMIC_RELAXED, __HIP_MEMORY_SCOPE_AGENT); }
DI unsigned xb_add(unsigned* p, unsigned v) { return __hip_atomic_fetch_add(p, v, __ATOMIC_RELAXED, __HIP_MEMORY_SCOPE_AGENT); }
DI unsigned xb_xcc_id() { return (unsigned)__builtin_amdgcn_s_getreg((3 << 11) | 20) & 0xFu; }
#define XB_SPIN(cond, bar) do { unsigned _sp = 0; while (cond) { __builtin_amdgcn_s_sleep(1); \
    if ((++_sp & 255u) == 0u) { if (xb_ld(&(bar)[XB_TMO])) break; if (_sp > XB_SPIN_CAP) { atomicAdd(&(bar)[XB_TMO], 1u); break; } } } } while (0)
struct XcdBarrier { unsigned* bar; unsigned x; volatile LAS unsigned* st; };
DI XcdBarrier xcd_barrier_post(unsigned* bar, volatile LAS unsigned* st) {
    XcdBarrier b; b.bar = bar; b.x = xb_xcc_id(); b.st = st;
    if (threadIdx.x == 0) (void)xb_add(&bar[XB_XCNT(b.x)], 1u);
    return b;
}
DI void xcd_barrier_complete(unsigned* bar, unsigned x, unsigned& nloc, unsigned& nx) {
    const unsigned G = gridDim.x * gridDim.y * gridDim.z;
    unsigned sum, cnt, mine, sp = 0u;
    for (;;) {
        sum = 0u; cnt = 0u; mine = 0u;
#pragma unroll
        for (unsigned j = 0; j < 16; ++j) { const unsigned c = xb_ld(&bar[XB_XCNT(j)]); sum += c; cnt += (c > 0u) ? 1u : 0u; mine = (j == x) ? c : mine; }
        if (sum == G) break;
        __builtin_amdgcn_s_sleep(1);
        if ((++sp & 255u) == 0u) { if (xb_ld(&bar[XB_TMO])) break; if (sp > XB_SPIN_CAP) { atomicAdd(&bar[XB_TMO], 1u); break; } }
    }
    nloc = mine > 0u ? mine : 1u; nx = cnt > 0u ? cnt : 1u;
}
DI void xcd_barrier(const XcdBarrier& b) {
    asm volatile("s_waitcnt vmcnt(0)" ::: "memory");
    __syncthreads();
    if (threadIdx.x == 0) {
        unsigned* bar = b.bar;
        __builtin_amdgcn_s_waitcnt(0);
        unsigned nloc = b.st[0], nx = b.st[1];
        if (nloc == 0u) { xcd_barrier_complete(bar, b.x, nloc, nx); b.st[0] = nloc; b.st[1] = nx; }
        const unsigned old = xb_add(&bar[XB_XSUB(b.x)], 1u);
        const unsigned gen = old / nloc;
        __builtin_amdgcn_fence(__ATOMIC_ACQUIRE, "agent");
        if (old + 1u == (gen + 1u) * nloc) {
            __builtin_amdgcn_fence(__ATOMIC_RELEASE, "agent");
            asm volatile("s_waitcnt vmcnt(0)" ::: "memory");
            const unsigned og = xb_add(&bar[XB_TOP], 1u);
            const unsigned tg = og / nx;
            if (og + 1u == (tg + 1u) * nx) xb_add(&bar[XB_TOPGEN], 1u);
            else XB_SPIN(xb_ld(&bar[XB_TOPGEN]) == tg, bar);
            asm volatile("" ::: "memory");
            xb_add(&bar[XB_XGEN(b.x)], 1u);
            asm volatile("s_waitcnt vmcnt(0)" ::: "memory");
        } else {
            XB_SPIN(xb_ld(&bar[XB_XGEN(b.x)]) == gen, bar);
            asm volatile("s_waitcnt vmcnt(0)" ::: "memory");
        }
    }
    __syncthreads();
}

struct Args { const float* in[29]; float* out; unsigned char* ws; int ph_lo, ph_hi; };
struct Frame {
    LAS unsigned char* lds;
    int tid, lane, wave, vcu, G;
    const float* const* in; float* out; unsigned char* ws;
};
enum { I_XP = 0, I_XS, I_MEM, I_CK, I_CV, I_SPOOL, I_SCONV, I_SSCONV, I_SSSM, I_NMIX, I_NXA, I_NFIN, I_WINE, I_POOLW, I_POOLS, I_CONVW, I_WOUTE, I_WINO, I_SCW, I_SCB, I_DTB, I_ALOG, I_DSKIP, I_SNORM, I_WOUTO, I_WQ, I_WK, I_WV, I_WO };

DI void p0_transpose_item(const float* W, int K, int N, bf16* WT, LAS float* scr, int item, int lane, const float* gk = nullptr) {
    const int nblk = N / 32, kb = item / nblk, nb = item % nblk, k0 = 64 * kb, n0 = 32 * nb;
    {
        const int kr = lane >> 3, ns = lane & 7; f32x4 v[8];
#pragma unroll
        for (int i = 0; i < 8; ++i) v[i] = *(const GAS f32x4*)(W + (size_t)(k0 + 8 * i + kr) * N + n0 + 4 * ns);
#pragma unroll
        for (int i = 0; i < 8; ++i) { const int kk = 8 * i + kr; const float gg = gk ? ((const GAS float*)gk)[k0 + kk] : 1.0f; LAS float* d = scr + kk * 33 + 4 * ns;
            d[0] = v[i][0] * gg; d[1] = v[i][1] * gg; d[2] = v[i][2] * gg; d[3] = v[i][3] * gg; } }
    LDS_WAIT(); asm volatile("" ::: "memory");
    const int c = lane & 7;
#pragma unroll
    for (int j = 0; j < 4; ++j) { const int n = (lane >> 3) + 8 * j; const LAS float* s = scr + (8 * c) * 33 + n;
        v4u o; o.x = pk2(s[0 * 33], s[1 * 33]); o.y = pk2(s[2 * 33], s[3 * 33]); o.z = pk2(s[4 * 33], s[5 * 33]); o.w = pk2(s[6 * 33], s[7 * 33]);
        *(GAS v4u*)(WT + (size_t)(n0 + n) * K + k0 + 8 * c) = o; }
    LDS_WAIT(); asm volatile("" ::: "memory");
}
DI void p0_prologue(Frame& F) {
    LAS float* scr = (LAS float*)(F.lds + F.wave * 16384);
    const int gw = F.vcu * NWAVES + F.wave, NGW = F.G * NWAVES;
    unsigned char* ws = F.ws;
    constexpr int IT_WINE = 16 * 192, IT_WOUT = 32 * 32, IT_WINO = 16 * 161, IT_SQ = 16 * 32, IT_PW = 4 * 8;
    constexpr int N0 = 2 * IT_WINE, N1 = N0 + 2 * IT_WOUT, N2 = N1 + 2 * IT_WINO, N3 = N2 + 2 * IT_WOUT, N4 = N3 + 16 * IT_SQ, N5 = N4 + 8 * IT_PW;
    for (int it = gw; it < N5; it += NGW) {
        if (it < N0) { const int mi = it / IT_WINE, r = it % IT_WINE;
            bf16* dst = (r % 192) < 32 ? (bf16*)(ws + WS_WTU) + (size_t)mi * DM * DM : (bf16*)(ws + WS_WTE_IN) + (size_t)mi * EVEN_IN * DM;
            {
                const int nb = r % 192;
                if (nb >= 64) { const int blk = (nb - 64) >> 5, cb = (nb - 64) & 31, chunk = cb >> 2, sub = cb & 3;
                    const int nnb = (blk == 1 || blk == 2) ? 64 + chunk * 8 + sub + (blk == 2 ? 4 : 0) : 128 + chunk * 8 + sub + (blk == 3 ? 4 : 0);
                    dst += (ptrdiff_t)(nnb - nb) * 32 * DM; } }
            p0_transpose_item(F.in[I_WINE] + (size_t)mi * DM * EVEN_IN, DM, EVEN_IN, dst, scr, r, F.lane, F.in[I_NMIX] + (size_t)(2 * mi) * DM); }
        else if (it < N1) { const int q = it - N0, mi = q / IT_WOUT, r = q % IT_WOUT; p0_transpose_item(F.in[I_WOUTE] + (size_t)mi * 2048 * DM, 2048, DM, (bf16*)(ws + WS_WTE_OUT) + (size_t)mi * DM * 2048, scr, r, F.lane); }
        else if (it < N2) { const int q = it - N1, mi = q / IT_WINO, r = q % IT_WINO; p0_transpose_item(F.in[I_WINO] + (size_t)mi * DM * ODD_IN, DM, ODD_IN, (bf16*)(ws + WS_WTO_IN) + (size_t)mi * ODD_WROWS * DM, scr, r, F.lane, F.in[I_NMIX] + (size_t)(2 * mi + 1) * DM); }
        else if (it < N3) { const int q = it - N2, mi = q / IT_WOUT, r = q % IT_WOUT; p0_transpose_item(F.in[I_WOUTO] + (size_t)mi * 2048 * DM, 2048, DM, (bf16*)(ws + WS_WTO_OUT) + (size_t)mi * DM * 2048, scr, r, F.lane, F.in[I_SNORM] + (size_t)mi * DIN); }
        else if (it < N4) { const int q = it - N3, mi = q / IT_SQ, r = q % IT_SQ, which = mi >> 2, l = mi & 3;
            const float* src = F.in[I_WQ + which] + (size_t)l * DM * DM;
            bf16* dst = (bf16*)(ws + (which == 0 ? WS_WTQ : which == 1 ? WS_WTK : which == 2 ? WS_WTV : WS_WTO)) + (size_t)l * DM * DM;
            p0_transpose_item(src, DM, DM, dst, scr, r, F.lane, which == 0 ? F.in[I_NXA] + (size_t)l * DM : nullptr); }
        else { const int q = it - N4, mi = q / IT_PW, r = q % IT_PW; p0_transpose_item(F.in[I_POOLW] + (size_t)mi * 65536, 256, 256, (bf16*)(ws + WS_WTP) + (size_t)mi * 65536, scr, r, F.lane); }
    }
    for (int it = gw; it < 2 * 4 * 32 * 8; it += NGW) {
        const int mi = it >> 10, gg = (it >> 8) & 3, kb = (it >> 3) & 31, nb = it & 7, r = F.lane & 31, h = F.lane >> 5;
        const float* Wi = F.in[I_WINE] + (size_t)mi * DM * EVEN_IN + (size_t)(32 * kb + r) * EVEN_IN + gg * 256;
        const float* Wp = F.in[I_POOLW] + (size_t)(mi * 4 + gg) * 65536 + nb * 32 + r;
        f32x16 acc;
#pragma unroll
        for (int k = 0; k < 16; ++k) acc[k] = 0.f;
        for (int j0 = 0; j0 < 256; j0 += 16) {
            f32x4 a4[4]; float b[16];
#pragma unroll
            for (int q = 0; q < 4; ++q) a4[q] = *(const GAS f32x4*)(Wi + j0 + 4 * q);
#pragma unroll
            for (int q = 0; q < 8; ++q) { b[2 * q] = ((const GAS float*)Wp)[(size_t)(j0 + 2 * q + h) * 256]; }
#pragma unroll
            for (int q = 0; q < 8; ++q) { const float av = (q & 1) ? (h ? a4[q >> 1][3] : a4[q >> 1][2]) : (h ? a4[q >> 1][1] : a4[q >> 1][0]);
                acc = __builtin_amdgcn_mfma_f32_32x32x2f32(av, b[2 * q], acc, 0, 0, 0); }
        }
        bf16* dst = (bf16*)(ws + WS_WTE_IN) + (size_t)mi * EVEN_IN * DM + (size_t)(gg * 256 + nb * 32 + r) * DM + 32 * kb;
        const float* gk = F.in[I_NMIX] + (size_t)(2 * mi) * DM + 32 * kb;
#pragma unroll
        for (int q4 = 0; q4 < 4; ++q4) { const int k0 = 8 * q4 + 4 * h; const f32x4 g4 = *(const GAS f32x4*)(gk + k0);
            *(GAS v2u*)(dst + k0) = (v2u){pk2(acc[4 * q4] * g4[0], acc[4 * q4 + 1] * g4[1]), pk2(acc[4 * q4 + 2] * g4[2], acc[4 * q4 + 3] * g4[3])}; }
    }
    const int gt = F.vcu * 512 + F.tid, NGT = F.G * 512;
    for (int i = gt; i < 2 * 224 * 128; i += NGT) { const int mi = i / (224 * 128), r = i % (224 * 128);
        *(GAS v4u*)((bf16*)(ws + WS_WTO_IN) + ((size_t)mi * ODD_WROWS + ODD_IN) * DM + (size_t)r * 8) = (v4u){0u, 0u, 0u, 0u}; }
    for (int i = gt; i < 2048 * 128; i += NGT) { float f[8]; ld8f(F.in[I_MEM] + (size_t)i * 8, f); st8((bf16*)(ws + WS_MEMB) + (size_t)i * 8, f); }
    bf16* H = (bf16*)(ws + WS_H); unsigned long long* SSQ = (unsigned long long*)(ws + WS_SSQ);
    for (int m0 = 2 * gw; m0 < MV; m0 += 2 * NGW) {
        f32x4 v[2][4];
#pragma unroll
        for (int rr = 0; rr < 2; ++rr) { const int m = m0 + rr; const float* xrow = m < TP ? F.in[I_XP] + (size_t)m * DM : F.in[I_XS] + (size_t)(m - TP) * DM; const GAS f32x4* xr = (const GAS f32x4*)xrow + F.lane;
#pragma unroll
            for (int j = 0; j < 4; ++j) v[rr][j] = xr[64 * j]; }
#pragma unroll
        for (int rr = 0; rr < 2; ++rr) { const int m = m0 + rr; GAS v2u* o8 = (GAS v2u*)(H + (size_t)m * DM) + F.lane; float s = 0.f;
#pragma unroll
            for (int j = 0; j < 4; ++j) { const f32x4 x = v[rr][j]; s += (x.x * x.x + x.y * x.y) + (x.z * x.z + x.w * x.w); o8[64 * j] = (v2u){pk2(x.x, x.y), pk2(x.z, x.w)}; }
            s = wave_sum(s);
            if (F.lane == 0) ((GAS unsigned long long*)SSQ)[m] = (unsigned long long)(s * 1048576.0f); }
    }
}
DI void t_norm(Frame& F, const float* g, bool fin) {
    const int gw = F.vcu * NWAVES + F.wave, NGW = F.G * NWAVES;
    const bf16* H = (const bf16*)(F.ws + WS_H);
    for (int m0 = 2 * gw; m0 < MV; m0 += 2 * NGW) {
        v4u w[2][2];
#pragma unroll
        for (int rr = 0; rr < 2; ++rr) { const GAS v4u* hr = (const GAS v4u*)(H + (size_t)(m0 + rr) * DM) + F.lane; w[rr][0] = hr[0]; w[rr][1] = hr[64]; }
#pragma unroll
        for (int rr = 0; rr < 2; ++rr) { float x[2][8]; float s = 0.f;
#pragma unroll
            for (int j = 0; j < 2; ++j)
#pragma unroll
                for (int e = 0; e < 4; ++e) { x[j][2 * e] = __uint_as_float(w[rr][j][e] << 16); x[j][2 * e + 1] = __uint_as_float(w[rr][j][e] & 0xffff0000u); s += x[j][2 * e] * x[j][2 * e] + x[j][2 * e + 1] * x[j][2 * e + 1]; }
            const float rstd = 1.f / sqrtf(wave_sum(s) * (1.f / DM) + EPS);
            GAS f32x4* yo = (GAS f32x4*)(F.out + (size_t)(m0 + rr) * DM);
#pragma unroll
            for (int j = 0; j < 2; ++j) { const int c0 = 512 * j + 8 * F.lane; const f32x4 g0 = *(const GAS f32x4*)(g + c0), g1 = *(const GAS f32x4*)(g + c0 + 4);
                yo[(c0 >> 2)] = (f32x4){x[j][0] * rstd * g0.x, x[j][1] * rstd * g0.y, x[j][2] * rstd * g0.z, x[j][3] * rstd * g0.w};
                yo[(c0 >> 2) + 1] = (f32x4){x[j][4] * rstd * g1.x, x[j][5] * rstd * g1.y, x[j][6] * rstd * g1.z, x[j][7] * rstd * g1.w}; }
        }
    }
}
DI void t_even_mix(Frame& F, int i) {
    const bf16* PROJ = (const bf16*)(F.ws + WS_PROJ); bf16* MIX = (bf16*)(F.ws + WS_MIX);
    const int c8 = F.tid & 127, sub = F.tid >> 7, ch = c8 * 8, w = 2 << (ch >> 8);
    float cw0[8], cw1[8], cw2[8], psc[8];
    ld8f(F.in[I_CONVW] + (size_t)(i * 3 + 0) * DM + ch, cw0); ld8f(F.in[I_CONVW] + (size_t)(i * 3 + 1) * DM + ch, cw1); ld8f(F.in[I_CONVW] + (size_t)(i * 3 + 2) * DM + ch, cw2);
    ld8f(F.in[I_POOLS] + (size_t)i * DM + ch, psc);
    for (int item = F.vcu * 512 + F.tid; item < (TP / 16) * 128; item += F.G * 512) {
        const int run = item >> 7, t0 = run * 16, b = t0 >> 11, tt0 = t0 & 2047;
        const bf16* pr0 = PROJ + (size_t)t0 * EVEN_P;
        float S[8], cv1[8], cv2[8], tmp[8], cg[8], vv[8];
#pragma unroll
        for (int j = 0; j < 8; ++j) { S[j] = 0.f; cv1[j] = 0.f; cv2[j] = 0.f; }
        if (tt0 > 0) {
            for (int k = 1; k < w; ++k) { ld8(pr0 - (size_t)k * EVEN_P + ch, tmp);
#pragma unroll
                for (int j = 0; j < 8; ++j) S[j] += tmp[j]; }
            ld8(pr0 - EVEN_P + 2048 + ch, cv1);
            ld8(pr0 - 2 * EVEN_P + 2048 + ch, cv2);
        }
        if (tt0 > 0 && tt0 + 16 <= SEQ - 15) {
            const float inv = 1.0f / (float)w;
#pragma unroll 4
            for (int k = 0; k < 16; ++k) {
                const size_t t = (size_t)t0 + k; const bf16* pr = pr0 + (size_t)k * EVEN_P;
                float u0[8], uo[8], gp[8], bg[8], cv0[8];
                ld8(pr + ch, u0); ld8(pr + 1024 + ch, gp); ld8(pr + 2048 + ch, cv0); ld8(pr + 3072 + ch, bg); ld8(pr - (size_t)(w - 1) * EVEN_P + ch, uo);
#pragma unroll
                for (int j = 0; j < 8; ++j) { S[j] += u0[j]; tmp[j] = (S[j] * inv - u0[j]) * psc[j] * silu(gp[j]); S[j] -= uo[j]; }
                st8(MIX + t * DIN + ch, tmp);
#pragma unroll
                for (int j = 0; j < 8; ++j) { tmp[j] = bg[j] * (cw0[j] * cv2[j] + cw1[j] * cv1[j] + cw2[j] * cv0[j]); cv2[j] = cv1[j]; cv1[j] = cv0[j]; }
                st8(MIX + t * DIN + 1024 + ch, tmp);
            }
        } else {
#pragma unroll 2
        for (int k = 0; k < 16; ++k) {
            const int tt = tt0 + k; const size_t t = (size_t)t0 + k; const bf16* pr = pr0 + (size_t)k * EVEN_P;
            float u0[8], uo[8], gp[8], bg[8], cv0[8];
            ld8(pr + ch, u0); ld8(pr + 1024 + ch, gp); ld8(pr + 2048 + ch, cv0); ld8(pr + 3072 + ch, bg);
            const bool drop = tt - (w - 1) >= 0;
            if (drop) ld8(pr - (size_t)(w - 1) * EVEN_P + ch, uo);
            const float inv = 1.0f / (float)(tt + 1 < w ? tt + 1 : w);
#pragma unroll
            for (int j = 0; j < 8; ++j) { S[j] += u0[j]; tmp[j] = (S[j] * inv - u0[j]) * psc[j] * silu(gp[j]); if (drop) S[j] -= uo[j]; }
            st8(MIX + t * DIN + ch, tmp);
#pragma unroll
            for (int j = 0; j < 8; ++j) { tmp[j] = bg[j] * (cw0[j] * cv2[j] + cw1[j] * cv1[j] + cw2[j] * cv0[j]); cv2[j] = cv1[j]; cv1[j] = cv0[j]; }
            st8(MIX + t * DIN + 1024 + ch, tmp);
            if (tt >= SEQ - 2) st8f(F.out + OUT_CP + ((size_t)(i * NBATCH + b) * 2 + (tt - (SEQ - 2))) * DM + ch, cv0);
        }
        }
    }
    LAS float* DF = (LAS float*)F.lds;
    const bf16* WTP = (const bf16*)(F.ws + WS_WTP) + (size_t)i * 4 * 65536;
    for (int it = F.vcu; it < (NSMP / 4) * 8; it += F.G) {
        const int rq = it >> 3, os = it & 7, bb = rq * 4 + sub; const size_t row = TP + bb;
        const bf16* pr = PROJ + (size_t)TP * EVEN_P + (size_t)bb * EVEN_IN;
        const int pA = 2048 + (ch >> 7) * 256 + (ch & 127), pB = pA + 2048;
        const float* pref = F.in[I_SPOOL] + ((size_t)(i * NSMP + bb) * 15) * DM + ch;
        float* pso = F.out + OUT_PS + ((size_t)(i * NSMP + bb) * 15) * DM + ch;
        float u0[8], sum[8], tmp[8];
        ld8(pr + ch, u0);
#pragma unroll
        for (int j = 0; j < 8; ++j) sum[j] = u0[j];
        for (int k = 0; k < 15; ++k) { ld8f(pref + (size_t)k * DM, tmp);
            if (os == 0 && k >= 1) st8f(pso + (size_t)(k - 1) * DM, tmp);
            if (15 - k < w) {
#pragma unroll
                for (int j = 0; j < 8; ++j) sum[j] += tmp[j]; } }
        const float inv = 1.0f / (float)w;
#pragma unroll
        for (int j = 0; j < 8; ++j) DF[sub * 1024 + ch + j] = sum[j] * inv - u0[j];
        if (os == 0) {
            st8f(pso + (size_t)14 * DM, u0);
            float cg[8], vv[8], cv0[8], p0[8], p1[8], bg[8], gc[8];
            ld8(pr + pA, cg); ld8(pr + pA + 128, vv);
#pragma unroll
            for (int j = 0; j < 8; ++j) cv0[j] = cg[j] * vv[j];
            ld8f(F.in[I_SCONV] + ((size_t)(i * NSMP + bb) * 2 + 0) * DM + ch, p0); ld8f(F.in[I_SCONV] + ((size_t)(i * NSMP + bb) * 2 + 1) * DM + ch, p1);
            ld8(pr + pB, bg); ld8(pr + pB + 128, gc);
#pragma unroll
            for (int j = 0; j < 8; ++j) tmp[j] = bg[j] * (cw0[j] * p0[j] + cw1[j] * p1[j] + cw2[j] * cv0[j]) * silu(gc[j]);
            st8(MIX + row * DIN + 1024 + ch, tmp);
            st8f(F.out + OUT_CS + ((size_t)(i * NSMP + bb) * 2 + 0) * DM + ch, p1); st8f(F.out + OUT_CS + ((size_t)(i * NSMP + bb) * 2 + 1) * DM + ch, cv0);
        }
        __syncthreads();
        {   const int n = os * 128 + (F.tid & 127), gg = n >> 8; const LAS float* dfr = DF + sub * 1024 + gg * 256; const bf16* wr = WTP + (size_t)gg * 65536 + (size_t)(n & 255) * 256;
            float acc = 0.f;
#pragma unroll 8
            for (int k0 = 0; k0 < 256; k0 += 8) { float wv[8]; ld8(wr + k0, wv); const f32x4 d0 = *(const LAS f32x4*)(dfr + k0), d1 = *(const LAS f32x4*)(dfr + k0 + 4);
                acc += (d0[0] * wv[0] + d0[1] * wv[1]) + (d0[2] * wv[2] + d0[3] * wv[3]) + (d1[0] * wv[4] + d1[1] * wv[5]) + (d1[2] * wv[6] + d1[3] * wv[7]); }
            const float gpv = bf1(((const GAS bf16*)pr)[1024 + n]), sc = ((const GAS float*)F.in[I_POOLS])[(size_t)i * DM + n];
            ((GAS bf16*)MIX)[row * DIN + n] = (bf16)f2bf(acc * sc * silu(gpv));
        }
        __syncthreads();
    }
}
DI void t_conv(Frame& F, int i) {
    const bf16* PROJ = (const bf16*)(F.ws + WS_PROJ); bf16* CONVX = (bf16*)(F.ws + WS_CONVX); float* DT = (float*)(F.ws + WS_DT);
    const int gt = F.vcu * 512 + F.tid, NGT = F.G * 512;
    const float* cwp = F.in[I_SCW] + (size_t)i * 4 * CONVD; const float* cbp = F.in[I_SCB] + (size_t)i * CONVD;
    for (int idx = gt; idx < (TP / 16) * 384; idx += NGT) {
        const int run = idx / 384, c8 = idx - run * 384, ch = c8 * 8, t0 = run * 16, tt0 = t0 & 2047, b = t0 >> 11;
        const bf16* pr0 = PROJ + (size_t)t0 * ODD_INP + 2048 + ch;
        float w0[8], w1[8], w2[8], w3[8], bb[8], x0[8], x1[8], x2[8];
        ld8f(cwp + ch, w0); ld8f(cwp + CONVD + ch, w1); ld8f(cwp + 2 * CONVD + ch, w2); ld8f(cwp + 3 * CONVD + ch, w3); ld8f(cbp + ch, bb);
        if (tt0 > 0) { ld8(pr0 - 3 * ODD_INP, x0); ld8(pr0 - 2 * ODD_INP, x1); ld8(pr0 - ODD_INP, x2); }
        else {
#pragma unroll
            for (int j = 0; j < 8; ++j) { x0[j] = 0.f; x1[j] = 0.f; x2[j] = 0.f; } }
        v4u xr[16];
#pragma unroll
        for (int k = 0; k < 16; ++k) xr[k] = *(const GAS v4u*)(pr0 + (size_t)k * ODD_INP);
#pragma unroll
        for (int k = 0; k < 16; ++k) {
            float x3[8], acc[8]; unpack8(xr[k], x3);
#pragma unroll
            for (int j = 0; j < 8; ++j) { acc[j] = silu(bb[j] + w0[j] * x0[j] + w1[j] * x1[j] + w2[j] * x2[j] + w3[j] * x3[j]); x0[j] = x1[j]; x1[j] = x2[j]; x2[j] = x3[j]; }
            st8(CONVX + (size_t)(t0 + k) * CONVD + ch, acc);
            const int tt = tt0 + k;
            if (tt >= SEQ - 3) st8f(F.out + OUT_SCP + ((size_t)(i * NBATCH + b) * 3 + (tt - (SEQ - 3))) * CONVD + ch, x3);
        }
    }
    for (int idx = gt; idx < NSMP * 384; idx += NGT) {
        const int bb = idx / 384, c8 = idx - bb * 384, ch = c8 * 8; const size_t row = TP + bb;
        const float* st = F.in[I_SSCONV] + ((size_t)(i * NSMP + bb) * 3) * CONVD + ch; float* so = F.out + OUT_SCS + ((size_t)(i * NSMP + bb) * 3) * CONVD + ch;
        float x3[8], s0[8], s1[8], s2[8], acc[8], w[8];
        ld8(PROJ + row * ODD_INP + 2048 + ch, x3); ld8f(st, s0); ld8f(st + CONVD, s1); ld8f(st + 2 * CONVD, s2);
        ld8f(cbp + ch, acc);
        ld8f(cwp + ch, w);
#pragma unroll
        for (int j = 0; j < 8; ++j) acc[j] += w[j] * s0[j];
        ld8f(cwp + CONVD + ch, w);
#pragma unroll
        for (int j = 0; j < 8; ++j) acc[j] += w[j] * s1[j];
        ld8f(cwp + 2 * CONVD + ch, w);
#pragma unroll
        for (int j = 0; j < 8; ++j) acc[j] += w[j] * s2[j];
        ld8f(cwp + 3 * CONVD + ch, w);
#pragma unroll
        for (int j = 0; j < 8; ++j) acc[j] = silu(acc[j] + w[j] * x3[j]);
        st8(CONVX + row * CONVD + ch, acc);
        st8f(so, s1); st8f(so + CONVD, s2); st8f(so + 2 * CONVD, x3);
    }
}
DI void t_gnorm(Frame& F, int i) {
    const int gw = F.vcu * NWAVES + F.wave, NGW = F.G * NWAVES;
    const bf16* YG = (const bf16*)(F.ws + WS_YG); bf16* MIX = (bf16*)(F.ws + WS_MIX); const float* nw = F.in[I_SNORM] + (size_t)i * DIN;
    for (int m = gw; m < MV; m += NGW) {
#pragma unroll
        for (int j = 0; j < 4; ++j) { float f[8], g[8]; const int ch = (F.lane + 64 * j) * 8;
            ld8(YG + (size_t)m * DIN + ch, f); float s = 0.f;
#pragma unroll
            for (int k = 0; k < 8; ++k) s += f[k] * f[k];
            const float rstd = 1.f / sqrtf(wave_sum(s) * (1.f / 512.f) + EPS);
            ld8f(nw + ch, g);
#pragma unroll
            for (int k = 0; k < 8; ++k) f[k] = f[k] * rstd * g[k];
            st8(MIX + (size_t)m * DIN + ch, f); }
    }
}
DI void t_sattn(Frame& F, int l) {
    const bf16* Q = (const bf16*)(F.ws + WS_Q); bf16* O = (bf16*)(F.ws + WS_O);
    LAS float* SC = (LAS float*)F.lds; LAS float* RED = (LAS float*)(F.lds + 4096);
    const int hd = F.lane >> 5, l32 = F.lane & 31;
    const float c2 = 0.0625f * 1.44269504089f;
#define SA_LOAD(buf, base, r0) do { _Pragma("unroll") for (int u = 0; u < 8; ++u) { buf[u][0] = *(const GAS f32x4*)((base) + (size_t)((r0) + u) * DM); buf[u][1] = *(const GAS f32x4*)((base) + (size_t)((r0) + u) * DM + 4); } } while (0)
#define SA_DOT(buf, r0) do { _Pragma("unroll") for (int u = 0; u < 8; ++u) { float d = (q[0] * buf[u][0][0] + q[1] * buf[u][0][1]) + (q[2] * buf[u][0][2] + q[3] * buf[u][0][3]) + (q[4] * buf[u][1][0] + q[5] * buf[u][1][1]) + (q[6] * buf[u][1][2] + q[7] * buf[u][1][3]); \
        _Pragma("unroll") for (int o = 1; o < 32; o <<= 1) d += __shfl_xor(d, o); if (l32 == 0) SC[hd * 256 + (r0) + u] = d; } } while (0)
#define SA_PV(buf, r0) do { _Pragma("unroll") for (int u = 0; u < 8; ++u) { const float p = __builtin_amdgcn_exp2f((SC[hd * 256 + (r0) + u] - mx) * c2) * inv; \
        acc[0] += p * buf[u][0][0]; acc[1] += p * buf[u][0][1]; acc[2] += p * buf[u][0][2]; acc[3] += p * buf[u][0][3]; acc[4] += p * buf[u][1][0]; acc[5] += p * buf[u][1][1]; acc[6] += p * buf[u][1][2]; acc[7] += p * buf[u][1][3]; } } while (0)
    for (int it = F.vcu; it < 256; it += F.G) {
        const int b = it >> 1, hp = it & 1, w0 = F.wave * 32;
        const float* Kc = F.in[I_CK] + ((size_t)(l * NSMP + b) * NMEM) * DM + hp * 512 + F.lane * 8;
        const float* Vc = F.in[I_CV] + ((size_t)(l * NSMP + b) * NMEM) * DM + hp * 512 + F.lane * 8;
        f32x4 A[8][2], B[8][2];
        SA_LOAD(A, Kc, w0); SA_LOAD(B, Kc, w0 + 8);
        float q[8]; ld8(Q + (size_t)(TP + b) * DM + hp * 512 + F.lane * 8, q);
        SA_DOT(A, w0); SA_LOAD(A, Kc, w0 + 16);
        SA_DOT(B, w0 + 8); SA_LOAD(B, Kc, w0 + 24);
        SA_DOT(A, w0 + 16); SA_LOAD(A, Vc, w0);
        SA_DOT(B, w0 + 24); SA_LOAD(B, Vc, w0 + 8);
        __syncthreads();
        float mx = -3.0e38f;
#pragma unroll
        for (int j = 0; j < 8; ++j) mx = fmaxf(mx, SC[hd * 256 + l32 * 8 + j]);
#pragma unroll
        for (int o = 1; o < 32; o <<= 1) mx = fmaxf(mx, __shfl_xor(mx, o));
        float sm = 0.f;
#pragma unroll
        for (int j = 0; j < 8; ++j) sm += __builtin_amdgcn_exp2f((SC[hd * 256 + l32 * 8 + j] - mx) * c2);
#pragma unroll
        for (int o = 1; o < 32; o <<= 1) sm += __shfl_xor(sm, o);
        const float inv = 1.0f / sm;
        float acc[8];
#pragma unroll
        for (int j = 0; j < 8; ++j) acc[j] = 0.f;
        SA_PV(A, w0); SA_LOAD(A, Vc, w0 + 16);
        SA_PV(B, w0 + 8); SA_LOAD(B, Vc, w0 + 24);
        SA_PV(A, w0 + 16); SA_PV(B, w0 + 24);
#pragma unroll
        for (int j = 0; j < 8; ++j) RED[F.wave * 512 + F.lane * 8 + j] = acc[j];
        __syncthreads();
        float o = 0.f;
#pragma unroll
        for (int w = 0; w < 8; ++w) o += RED[w * 512 + F.tid];
        ((GAS bf16*)O)[(size_t)(TP + b) * DM + hp * 512 + F.tid] = (bf16)f2bf(o);
        __syncthreads();
    }
#undef SA_LOAD
#undef SA_DOT
#undef SA_PV
}
struct MiniBf16 { bf16* O; int ldc; const unsigned long long* ssq;
    DI void operator()(const f32x4 acc, size_t row, int col) const { const float rs = ssq ? 1.0f / sqrtf((float)((const GAS unsigned long long*)ssq)[row] * (1.0f / (1024.0f * 1048576.0f)) + EPS) : 1.0f;
        *(GAS v2u*)(O + row * ldc + col) = (v2u){pk2(acc[0] * rs, acc[1] * rs), pk2(acc[2] * rs, acc[3] * rs)}; } };
struct MiniResAdd { bf16* Xb; unsigned long long* ssq;
    DI void operator()(const f32x4 acc, size_t row, int col) const { GAS v2u* p = (GAS v2u*)(Xb + row * 1024 + col); const v2u w = *p;
        const float x[4] = {__uint_as_float(w[0] << 16) + acc[0], __uint_as_float(w[0] & 0xffff0000u) + acc[1], __uint_as_float(w[1] << 16) + acc[2], __uint_as_float(w[1] & 0xffff0000u) + acc[3]};
        *p = (v2u){pk2(x[0], x[1]), pk2(x[2], x[3])};
        float sq = (x[0] * x[0] + x[1] * x[1]) + (x[2] * x[2] + x[3] * x[3]); sq += __shfl_xor(sq, 16); sq += __shfl_xor(sq, 32);
        if ((col & 15) == 0) atomicAdd(ssq + row, (unsigned long long)(sq * 1048576.0f)); } };
struct MiniPoolState { float* out; const unsigned long long* ssq;
    DI void operator()(const f32x4 acc, size_t row, int col) const { const int b = (int)(row >> 11), j = (int)(row & 2047) - (SEQ - 15); if (j < 0) return;
        const float rs = 1.0f / sqrtf((float)((const GAS unsigned long long*)ssq)[row] * (1.0f / (1024.0f * 1048576.0f)) + EPS);
        *(GAS f32x4*)(out + ((size_t)b * 15 + j) * DM + col) = acc * rs; } };
struct MiniPoolGate { bf16* O; int ldc; const bf16* gate; int ldg; const float* scale;
    DI void operator()(const f32x4 acc, size_t row, int c) const { const f32x4 sc = *(const GAS f32x4*)(scale + c); const v2u gw = *(const GAS v2u*)(gate + row * ldg + c);
        *(GAS v2u*)(O + row * ldc + c) = (v2u){pk2(acc[0] * sc[0] * silu(bflo(gw.x)), acc[1] * sc[1] * silu(bfhi(gw.x))), pk2(acc[2] * sc[2] * silu(bflo(gw.y)), acc[3] * sc[3] * silu(bfhi(gw.y)))}; } };
template <int KB  , class Epi> DI void mini_gemm(Frame& F, const bf16* A  , int lda, const bf16* Bt, int ldb, int K, int nCB, const Epi& E, int shift, const float* gssq = nullptr  , int rbase = TP, int rstride = 16  ) {
    const int NGW = F.G * NWAVES; int vc = F.vcu - shift; vc = vc < 0 ? vc + F.G : vc; const int gw = F.wave * F.G + vc;
    const int fr = F.lane & 15, fq = F.lane >> 4;
    for (int u = gw; u < 8 * nCB; u += NGW) {
        const int rb = u & 7, cb = u >> 3;
        const size_t grow = (size_t)rbase + (size_t)rb * rstride + fr;
        const bf16* ap = A + grow * lda + 8 * fq;
        const bf16* bp = Bt + (size_t)(16 * cb + fr) * ldb + 8 * fq;
        f32x4 acc = (f32x4){0.f, 0.f, 0.f, 0.f};
        float rg[4] = {1.f, 1.f, 1.f, 1.f};
        if (gssq) { const GAS float* q = (const GAS float*)gssq + grow;
#pragma unroll
            for (int gi = 0; gi < 4; ++gi) { float a = 0.f;
#pragma unroll
                for (int e = 0; e < 8; ++e) a += q[(size_t)(gi * 8 + e) * MP];
                rg[gi] = 1.0f / sqrtf(a * (1.0f / 512.0f) + EPS); } }
        for (int k0 = 0; k0 < K; k0 += 32 * KB) {
            if (gssq && k0 > 0) { const int gi = k0 / 512; acc = acc * (gi == 1 ? rg[0] / rg[1] : gi == 2 ? rg[1] / rg[2] : rg[2] / rg[3]); }
            bf16x8 a[KB], b[KB];
#pragma unroll
            for (int s2 = 0; s2 < KB; ++s2) { a[s2] = *(const GAS bf16x8*)(ap + k0 + 32 * s2); b[s2] = *(const GAS bf16x8*)(bp + k0 + 32 * s2); }
#pragma unroll
            for (int s2 = 0; s2 < KB; ++s2) acc = __builtin_amdgcn_mfma_f32_16x16x32_bf16(b[s2], a[s2], acc, 0, 0, 0);
        }
        if (gssq) acc = acc * rg[3];
        E(acc, grow, 16 * cb + 4 * fq);
    }
}

DI void dt_gemm(Frame& F, const bf16* A, const bf16* Bt  , const unsigned long long* ssq, float* out  , const float* dtb  ) {
    const int NGW = F.G * NWAVES, gw = F.wave * F.G + F.vcu, fr = F.lane & 15, fq = F.lane >> 4;
    for (int u = gw; u < MV / 16; u += NGW) {
        const size_t row = (size_t)u * 16 + fr;
        const bf16* ap = A + row * DM + 8 * fq; const bf16* bp0 = Bt + (size_t)fr * DM + 8 * fq; const bf16* bp1 = bp0 + 16 * DM;
        f32x4 acc0 = (f32x4){0.f, 0.f, 0.f, 0.f}, acc1 = acc0;
        for (int k0 = 0; k0 < DM; k0 += 256) {
            bf16x8 a[8], b0[8], b1[8];
#pragma unroll
            for (int s2 = 0; s2 < 8; ++s2) { a[s2] = *(const GAS bf16x8*)(ap + k0 + 32 * s2); b0[s2] = *(const GAS bf16x8*)(bp0 + k0 + 32 * s2); b1[s2] = *(const GAS bf16x8*)(bp1 + k0 + 32 * s2); }
#pragma unroll
            for (int s2 = 0; s2 < 8; ++s2) { acc0 = __builtin_amdgcn_mfma_f32_16x16x32_bf16(b0[s2], a[s2], acc0, 0, 0, 0); acc1 = __builtin_amdgcn_mfma_f32_16x16x32_bf16(b1[s2], a[s2], acc1, 0, 0, 0); }
        }
        const float rs = 1.0f / sqrtf((float)((const GAS unsigned long long*)ssq)[row] * (1.0f / (1024.0f * 1048576.0f)) + EPS);
#pragma unroll
        for (int j = 0; j < 4; ++j) { const float x0 = acc0[j] * rs + ((const GAS float*)dtb)[4 * fq + j], x1 = acc1[j] * rs + ((const GAS float*)dtb)[16 + 4 * fq + j];
            ((GAS float*)out)[(size_t)(4 * fq + j) * MP + row] = x0 > 20.f ? x0 : log1pf(__expf(x0)); ((GAS float*)out)[(size_t)(16 + 4 * fq + j) * MP + row] = x1 > 20.f ? x1 : log1pf(__expf(x1)); }
    }
}

#define MFMA32(a, b, c) __builtin_amdgcn_mfma_f32_32x32x16_bf16((a), (b), (c), 0, 0, 0)
typedef short s16x4 __attribute__((ext_vector_type(4)));
constexpr int RS = 272;
DI bf16x8 frag_row(const LAS unsigned char* rowbase  , int ks) { return *(const LAS bf16x8*)(rowbase + ks * 32); }
DI bf16x8 frag_tr(const LAS unsigned char* trbase, int krow0, int c) {
    const s16x4 lo = __builtin_amdgcn_ds_read_tr16_b64_v4i16((LAS s16x4*)(trbase + krow0 * RS + c * 64));
    const s16x4 hi = __builtin_amdgcn_ds_read_tr16_b64_v4i16((LAS s16x4*)(trbase + (krow0 + 4) * RS + c * 64));
    return (bf16x8){lo[0], lo[1], lo[2], lo[3], hi[0], hi[1], hi[2], hi[3]};
}
DI void ssd_prompt_item(Frame& F, int i, int b, int head, float* ssqh) {
    LAS unsigned char* BM = F.lds;
    LAS unsigned char* CM = F.lds + 128 * RS;
    LAS unsigned char* LL = F.lds + 256 * RS;
    LAS unsigned char* XD = F.lds + 384 * RS;
    LAS unsigned char* SB = F.lds + 448 * RS;
    LAS unsigned char* XE = F.lds + 512 * RS;
    LAS float* DTL = (LAS float*)(F.lds + 576 * RS + 2048);
    LAS float* ACSB = (LAS float*)(F.lds + 576 * RS);
    const bf16* CONVX = (const bf16*)(F.ws + WS_CONVX); const bf16* PROJ = (const bf16*)(F.ws + WS_PROJ); const float* DT = (const float*)(F.ws + WS_DT); bf16* YG = (bf16*)(F.ws + WS_YG);
    const int w = F.wave, g = head >> 3, lb = w & 3, pb = w >> 2;
    const float Ah = -__expf(((const GAS float*)F.in[I_ALOG])[i * 32 + head]), Dh = ((const GAS float*)F.in[I_DSKIP])[i * 32 + head];
    f32x16 st;
#pragma unroll
    for (int k = 0; k < 16; ++k) st[k] = 0.f;
    for (int idx = F.tid; idx < 64 * RS / 16; idx += 512) *(LAS v4u*)(SB + idx * 16) = (v4u){0u, 0u, 0u, 0u};
    v4u vb[4], vc[4], vx[2], zt[2]; float dtx[2]; float d0 = 0.f, d1 = 0.f;
#define SSD_ISSUE(cc) do { const size_t r0_ = (size_t)b * SEQ + (size_t)(cc) * 128; \
        _Pragma("unroll") for (int i4 = 0; i4 < 4; ++i4) { const int q_ = F.tid + 512 * i4, s_ = q_ >> 4, ch_ = q_ & 15; const bf16* src_ = CONVX + (r0_ + s_) * CONVD + 2048 + g * 128 + ch_ * 8; \
            vb[i4] = *(const GAS v4u*)src_; vc[i4] = *(const GAS v4u*)(src_ + 512); } \
        _Pragma("unroll") for (int i2 = 0; i2 < 2; ++i2) { const int q_ = F.tid + 512 * i2, s_ = q_ >> 3, ch_ = q_ & 7; vx[i2] = *(const GAS v4u*)(CONVX + (r0_ + s_) * CONVD + head * 64 + ch_ * 8); \
            dtx[i2] = ((const GAS float*)DT)[(size_t)head * MP + r0_ + s_]; } \
        } while (0)
#define SSD_SCAN(cc) do { if (w == 0) { const int ln_ = F.lane; float a0 = d0 * Ah * 1.44269504089f, a1 = d1 * Ah * 1.44269504089f; \
        _Pragma("unroll") for (int o = 1; o < 64; o <<= 1) { const float t0 = __shfl_up(a0, o), t1 = __shfl_up(a1, o); if (ln_ >= o) { a0 += t0; a1 += t1; } } \
        a1 += __shfl(a0, 63); const float al_ = __shfl(a1, 63); LAS float* A_ = ACSB + ((cc) & 1) * 256; \
        A_[ln_] = a0; A_[ln_ + 64] = a1; A_[128 + ln_] = __builtin_amdgcn_exp2f(al_ - a0); A_[192 + ln_] = __builtin_amdgcn_exp2f(al_ - a1); } } while (0)
#define SSD_ISSUE_D(cc) do { const size_t r0_ = (size_t)b * SEQ + (size_t)(cc) * 128; d0 = ((const GAS float*)DT)[(size_t)head * MP + r0_ + F.lane]; d1 = ((const GAS float*)DT)[(size_t)head * MP + r0_ + 64 + F.lane]; } while (0)
#define SSD_ISSUE_Z(cc) do { const size_t r0_ = (size_t)b * SEQ + (size_t)(cc) * 128; _Pragma("unroll") for (int i2 = 0; i2 < 2; ++i2) { const int q_ = F.tid + 512 * i2; zt[i2] = *(const GAS v4u*)(PROJ + (r0_ + (q_ >> 3)) * ODD_INP + head * 64 + (q_ & 7) * 8); } } while (0)
    SSD_ISSUE(0); SSD_ISSUE_D(0); SSD_ISSUE_Z(0);
    SSD_SCAN(0);
    SSD_ISSUE_D(1);
    __syncthreads();
#define SSD_BAR() asm volatile("s_waitcnt lgkmcnt(0)\n\ts_barrier" ::: "memory")
    for (int c = 0; c < 16; ++c) {
        const size_t row0 = (size_t)b * SEQ + (size_t)c * 128;
        int tid = F.tid; asm volatile("" : "+v"(tid));
        const int lane = tid & 63, r = lane & 31, h = lane >> 5;
        LAS float* ACS = ACSB + (c & 1) * 256; LAS float* TE = ACS + 128;
#pragma unroll
        for (int i4 = 0; i4 < 4; ++i4) { const int q = tid + 512 * i4, s = q >> 4, ch = q & 15;
            *(LAS v4u*)(BM + s * RS + ch * 16) = vb[i4]; *(LAS v4u*)(CM + s * RS + ch * 16) = vc[i4]; }
        {
#pragma unroll
            for (int i2 = 0; i2 < 2; ++i2) { const int q = tid + 512 * i2, s = q >> 3, ch = q & 7;
                const float dts = dtx[i2], tes = TE[s]; float f[8]; unpack8(vx[i2], f);
                if (ch == 0) DTL[s] = dts;
#pragma unroll
                for (int j = 0; j < 8; ++j) f[j] *= dts;
                *(LAS v4u*)(XD + (s & 63) * RS + ((s >> 6) * 8 + ch) * 16) = pack8(f);
#pragma unroll
                for (int j = 0; j < 8; ++j) f[j] *= tes;
                *(LAS v4u*)(XE + (s & 63) * RS + ((s >> 6) * 8 + ch) * 16) = pack8(f); } }
        SSD_ISSUE((c + 1 < 16 ? c + 1 : 15));
        SSD_BAR();
        if (c + 1 < 16) SSD_SCAN(c + 1);
        SSD_ISSUE_D((c + 2 < 16 ? c + 2 : 15));
        const int rowoff = r * RS + 16 * h;
        const int troff = (8 * h + ((lane & 15) >> 2)) * RS + (2 * ((lane >> 4) & 1) + ((lane & 3) >> 1)) * 16 + 8 * (lane & 1);
        const int l = lb * 32 + r; const float al = ACS[l];
        const f32x16 zero16 = {0.f, 0.f, 0.f, 0.f, 0.f, 0.f, 0.f, 0.f, 0.f, 0.f, 0.f, 0.f, 0.f, 0.f, 0.f, 0.f};
#define SSD_CHAIN8(acc, first, AF, BF) do { _Pragma("unroll") for (int kb_ = 0; kb_ < 8; kb_ += 4) { bf16x8 fa_[4], fb_[4]; \
            _Pragma("unroll") for (int j_ = 0; j_ < 4; ++j_) { const int ks = kb_ + j_; fa_[j_] = AF; fb_[j_] = BF; } \
            __builtin_amdgcn_sched_barrier(0); \
            _Pragma("unroll") for (int j_ = 0; j_ < 4; ++j_) acc = MFMA32(fa_[j_], fb_[j_], (first && kb_ == 0 && j_ == 0) ? zero16 : acc); } } while (0)
#pragma unroll
        for (int bi = 0; bi < 2; ++bi) { const int sb = 2 * pb + bi;
            if (sb <= lb) {
                f32x16 cb;
                SSD_CHAIN8(cb, true, frag_row(BM + sb * 32 * RS + rowoff, ks), frag_row(CM + lb * 32 * RS + rowoff, ks));
                if (sb < lb) {
#pragma unroll
                    for (int k = 0; k < 16; ++k) { const int s0 = sb * 32 + (k & 3) + 8 * (k >> 2) + 4 * h; cb[k] = cb[k] * __builtin_amdgcn_exp2f(al - ACS[s0]); }
                } else {
#pragma unroll
                    for (int k = 0; k < 16; ++k) { const int s0 = sb * 32 + (k & 3) + 8 * (k >> 2) + 4 * h; cb[k] = cb[k] * (__builtin_amdgcn_exp2f(fminf(al - ACS[s0], 0.f)) * (s0 <= l ? 1.f : 0.f)); }
                }
#pragma unroll
                for (int q4 = 0; q4 < 4; ++q4) *(LAS v2u*)(LL + l * RS + (sb * 4 + q4) * 16 + 8 * h) = (v2u){pk2(cb[4 * q4], cb[4 * q4 + 1]), pk2(cb[4 * q4 + 2], cb[4 * q4 + 3])};
            } }
        f32x16 yo;
        SSD_CHAIN8(yo, true, frag_row(SB + pb * 32 * RS + rowoff, ks), frag_row(CM + lb * 32 * RS + rowoff, ks));
        { const float dec = __builtin_amdgcn_exp2f(ACS[127]);
#pragma unroll
          for (int k = 0; k < 16; ++k) st[k] *= dec; }
        SSD_CHAIN8(st, false, frag_tr(BM + troff, 16 * ks, lb), frag_tr(XE + troff, 16 * (ks & 3), 2 * (ks >> 2) + pb));
        SSD_BAR();
        f32x16 yd = zero16;
        for (int sbk = 0; sbk <= lb; ++sbk) { bf16x8 fx[2], fl[2];
#pragma unroll
            for (int j = 0; j < 2; ++j) { const int ks = 2 * sbk + j; fx[j] = frag_tr(XD + troff, 16 * (ks & 3), 2 * (ks >> 2) + pb); fl[j] = frag_row(LL + lb * 32 * RS + rowoff, ks); }
            __builtin_amdgcn_sched_barrier(0);
            yd = MFMA32(fx[0], fl[0], yd); yd = MFMA32(fx[1], fl[1], yd); }
#undef SSD_CHAIN8
        { const float el = __builtin_amdgcn_exp2f(al);
#pragma unroll
          for (int q4 = 0; q4 < 4; ++q4) { const int p0 = pb * 32 + 8 * q4 + 4 * h;
              *(LAS f32x4*)(BM + l * RS + p0 * 4) = (f32x4){yd[4 * q4] + el * yo[4 * q4], yd[4 * q4 + 1] + el * yo[4 * q4 + 1], yd[4 * q4 + 2] + el * yo[4 * q4 + 2], yd[4 * q4 + 3] + el * yo[4 * q4 + 3]}; } }
        SSD_BAR();
#pragma unroll
        for (int i2 = 0; i2 < 2; ++i2) { const int q = tid + 512 * i2, tk = q >> 3, c16 = q & 7;
            const f32x4 ya = *(const LAS f32x4*)(BM + tk * RS + c16 * 32), yb = *(const LAS f32x4*)(BM + tk * RS + c16 * 32 + 16);
            float xf[8], zf[8], f[8]; unpack8(*(const LAS v4u*)(XD + (tk & 63) * RS + ((tk >> 6) * 64 + c16 * 8) * 2), xf); unpack8(zt[i2], zf);
            { const float rdt = Dh * __builtin_amdgcn_rcpf(DTL[tk]);
#pragma unroll
              for (int j = 0; j < 8; ++j) xf[j] *= rdt; }
            f[0] = (ya[0] + xf[0]) * silu(zf[0]); f[1] = (ya[1] + xf[1]) * silu(zf[1]); f[2] = (ya[2] + xf[2]) * silu(zf[2]); f[3] = (ya[3] + xf[3]) * silu(zf[3]);
            f[4] = (yb[0] + xf[4]) * silu(zf[4]); f[5] = (yb[1] + xf[5]) * silu(zf[5]); f[6] = (yb[2] + xf[6]) * silu(zf[6]); f[7] = (yb[3] + xf[7]) * silu(zf[7]);
            *(GAS v4u*)(YG + (row0 + tk) * DIN + head * 64 + c16 * 8) = pack8(f);
            float sq = (f[0] * f[0] + f[1] * f[1]) + (f[2] * f[2] + f[3] * f[3]) + (f[4] * f[4] + f[5] * f[5]) + (f[6] * f[6] + f[7] * f[7]);
            sq += __shfl_xor(sq, 1); sq += __shfl_xor(sq, 2); sq += __shfl_xor(sq, 4);
            if (c16 == 0) ((GAS float*)ssqh)[(size_t)head * MP + row0 + tk] = sq; }
        SSD_ISSUE_Z((c + 1 < 16 ? c + 1 : 15));
        SSD_BAR();
        { const int p = pb * 32 + r;
#pragma unroll
          for (int q4 = 0; q4 < 4; ++q4) *(LAS v2u*)(SB + p * RS + (lb * 4 + q4) * 16 + 8 * h) = (v2u){pk2(st[4 * q4], st[4 * q4 + 1]), pk2(st[4 * q4 + 2], st[4 * q4 + 3])}; }
    }
#undef SSD_BAR
#undef SSD_ISSUE
#undef SSD_ISSUE_Z
#undef SSD_ISSUE_D
#undef SSD_SCAN
    { const int r = F.lane & 31, h = F.lane >> 5; const int p = pb * 32 + r; float* so = F.out + OUT_SP + (((size_t)(i * NBATCH + b) * NHEAD + head) * 64 + p) * 128;
#pragma unroll
      for (int q4 = 0; q4 < 4; ++q4) { const int n0 = lb * 32 + 8 * q4 + 4 * h; *(GAS f32x4*)(so + n0) = (f32x4){st[4 * q4], st[4 * q4 + 1], st[4 * q4 + 2], st[4 * q4 + 3]}; } }
    __syncthreads();
}
DI void ssd_sample(Frame& F, int i, float* ssqh) {
    const bf16* CONVX = (const bf16*)(F.ws + WS_CONVX); const bf16* PROJ = (const bf16*)(F.ws + WS_PROJ); const float* DT = (const float*)(F.ws + WS_DT); bf16* YG = (bf16*)(F.ws + WS_YG);
    const int gw = F.vcu * NWAVES + F.wave, NGW = F.G * NWAVES, psub = F.lane >> 5, n4 = (F.lane & 31) * 4;
    for (int it = gw; it < NSMP * NHEAD; it += NGW) {
        const int b = it >> 5, head = it & 31, g = head >> 3; const size_t row = TP + b;
        const size_t sbase = (((size_t)(i * NSMP + b) * NHEAD + head) * 64) * 128 + n4;
        const float* sin = F.in[I_SSSM] + sbase + (size_t)psub * 128; float* sout = F.out + OUT_SS + sbase + (size_t)psub * 128;
        f32x4 s0[32];
#pragma unroll
        for (int pp = 0; pp < 32; ++pp) s0[pp] = *(const GAS f32x4*)(sin + (size_t)pp * 256);
        const float dt = ((const GAS float*)DT)[(size_t)head * MP + row], Ah = -__expf(((const GAS float*)F.in[I_ALOG])[i * 32 + head]), Dh = ((const GAS float*)F.in[I_DSKIP])[i * 32 + head];
        const float dA = __expf(dt * Ah);
        const v2u bw = *(const GAS v2u*)(CONVX + row * CONVD + 2048 + g * 128 + n4), cw = *(const GAS v2u*)(CONVX + row * CONVD + 2560 + g * 128 + n4);
        const f32x4 B4 = (f32x4){bflo(bw.x), bfhi(bw.x), bflo(bw.y), bfhi(bw.y)}, C4 = (f32x4){bflo(cw.x), bfhi(cw.x), bflo(cw.y), bfhi(cw.y)};
        const float xl = bf1(((const GAS bf16*)CONVX)[row * CONVD + head * 64 + F.lane]), zl = bf1(((const GAS bf16*)PROJ)[row * ODD_INP + head * 64 + F.lane]);
        float sq = 0.f;
#pragma unroll
        for (int pp = 0; pp < 32; ++pp) { const int p = 2 * pp + psub;
            const float xe = __shfl(xl, 2 * pp), xo = __shfl(xl, 2 * pp + 1), xv = psub ? xo : xe, dx = dt * xv;
            const f32x4 sn = s0[pp] * dA + B4 * dx; *(GAS f32x4*)(sout + (size_t)pp * 256) = sn;
            float d = (sn[0] * C4[0] + sn[1] * C4[1]) + (sn[2] * C4[2] + sn[3] * C4[3]);
#pragma unroll
            for (int o = 1; o < 32; o <<= 1) d += __shfl_xor(d, o);
            const float ze = __shfl(zl, 2 * pp), zo = __shfl(zl, 2 * pp + 1), z = psub ? zo : ze;
            if ((F.lane & 31) == 0) { const float yv = (d + Dh * xv) * silu(z); sq += yv * yv; ((GAS bf16*)YG)[row * DIN + head * 64 + p] = (bf16)f2bf(yv); } }
        sq += __shfl_xor(sq, 32);
        if (F.lane == 0) ((GAS float*)ssqh)[(size_t)head * MP + row] = sq;
    }
}

#if MK_PER_PHASE
#define GRID_BAR() do { } while (0)
#else
#define GRID_BAR() do { for (int rb_ = 0; rb_ < REP_BAR; ++rb_) xcd_barrier(bar); } while (0)
#endif
#ifdef DBG_ONLY
#define IN(k) (lo <= (k) && (k) < hi && ((((k) < 2) ? (k) : 2 + ((k) - 2) % 11) == DBG_ONLY))
#else
#define IN(k) (lo <= (k) && (k) < hi)
#endif
#ifndef AMP_MASK
#define AMP_MASK 0
#endif
#if AMP_MASK
#define AMP_CLS(k) ((k) < 2 ? (k) : ((((k) - 2) % 11) == 0 ? 2 : (((k) - 2) % 11) == 1 ? 3 : (((k) - 2) % 11) == 2 ? 4 : (((k) - 2) % 11) == 4 ? 5 : (((k) - 2) % 11) == 6 ? 6 : (((k) - 2) % 11) == 7 ? 7 : (((k) - 2) % 11) == 9 ? 8 : 9))
#undef IN
#define IN(k) (lo <= (k) && (k) < hi && ((amp_t0 = __builtin_amdgcn_s_memrealtime()), true))
#define AMP_END(k) do { if ((AMP_MASK >> AMP_CLS(k)) & 1) { __syncthreads(); const unsigned long long t1_ = __builtin_amdgcn_s_memrealtime(); const unsigned long long d_ = t1_ - amp_t0; while (__builtin_amdgcn_s_memrealtime() - t1_ < d_) __builtin_amdgcn_s_sleep(4); } } while (0)
#else
#define AMP_END(k) do { } while (0)
#endif
#if AMP_MASK
#define AMP_SUB_BEGIN() unsigned long long amp_s0 = __builtin_amdgcn_s_memrealtime()
#define AMP_SUB_END(cls) do { if ((AMP_MASK >> (cls)) & 1) { __syncthreads(); const unsigned long long t1_ = __builtin_amdgcn_s_memrealtime(); const unsigned long long d_ = t1_ - amp_s0; while (__builtin_amdgcn_s_memrealtime() - t1_ < d_) __builtin_amdgcn_s_sleep(4); } } while (0)
#else
#define AMP_SUB_BEGIN() do { } while (0)
#define AMP_SUB_END(cls) do { } while (0)
#endif
#define SEAM(k) do { AMP_END(k); if ((k) + 1 < hi) GRID_BAR(); } while (0)
#define REFRESH() do { int t_ = threadIdx.x; asm volatile("" : "+v"(t_)); F.tid = t_; F.lane = t_ & 63; } while (0)
constexpr int PH_PER_LAYER = 11, PH_LAYER0 = 2, N_PHASES = PH_LAYER0 + 4 * PH_PER_LAYER;
template <int l> DI void layer_phases(Frame& F, const int lo, const int hi, const XcdBarrier& bar) {
#if AMP_MASK
    unsigned long long amp_t0 = 0;
#endif
    unsigned char* ws = F.ws;
    LAS unsigned char* ring = F.lds;
    bf16* H = (bf16*)(ws + WS_H); bf16* Qb = (bf16*)(ws + WS_Q); bf16* Pb = (bf16*)(ws + WS_PB); bf16* Ob = (bf16*)(ws + WS_O); bf16* DIFF = (bf16*)(ws + WS_DIFF);
    bf16* MIX = (bf16*)(ws + WS_MIX); bf16* PROJ = (bf16*)(ws + WS_PROJ);
    const int c = (int)blockIdx.x;

    constexpr int pb = PH_LAYER0 + l * PH_PER_LAYER, i = l >> 1; constexpr bool evn = (l & 1) == 0;
    unsigned long long* SSQ = (unsigned long long*)(ws + WS_SSQ);
    constexpr size_t SSQ_I = (size_t)MV;
        if (IN(pb + 0)) {
            constexpr int N = evn ? EVEN_IN : ODD_INP;
            pg8::Gemm g{H, evn ? (const bf16*)(ws + WS_WTE_IN) + (size_t)i * EVEN_IN * DM : (const bf16*)(ws + WS_WTO_IN) + (size_t)i * ODD_WROWS * DM, DM, DM, DM};
            pg8::StaticOrder S; S.init(64, N / 256, F.G, c);
            if constexpr (evn) { pg8::EpiEvenIn E{PROJ, SSQ + (2 * l) * SSQ_I};
                for (int rep = 0; rep < REP_G1; ++rep) pg8::gemm_phase<pg8::EpiEvenIn, pg8::AddrStd, true, true>(ring, g, S, E, pg8::AddrStd{}); }
            else { pg8::EpiBf16S E{PROJ, N, SSQ + (2 * l) * SSQ_I};
                for (int rep = 0; rep < REP_G1; ++rep) pg8::gemm_phase<pg8::EpiBf16S, pg8::AddrStd, true, true>(ring, g, S, E, pg8::AddrStd{}); }
            REFRESH();
            if constexpr (evn) {
                const bf16* WTU = (const bf16*)(ws + WS_WTU) + (size_t)i * DM * DM;
                for (int rep = 0; rep < REP_MINI; ++rep) {
                bf16* PS = PROJ + (size_t)TP * EVEN_P - (size_t)TP * EVEN_IN;
                mini_gemm<16>(F, H, DM, WTU, DM, DM, 64, MiniBf16{PS, N, SSQ + (2 * l) * SSQ_I}, 0);
                mini_gemm<16>(F, H, DM, g.Bt + (size_t)1024 * DM, DM, DM, (N - 1024) / 16, MiniBf16{PS + 1024, N, SSQ + (2 * l) * SSQ_I}, 64);
                mini_gemm<16>(F, H, DM, WTU, DM, DM, 64, MiniPoolState{F.out + OUT_PP + (size_t)i * NBATCH * 15 * DM, SSQ + (2 * l) * SSQ_I}, 128, nullptr, SEQ - 16, SEQ); }
            } else {
                for (int rep = 0; rep < REP_MINI; ++rep) mini_gemm<16>(F, H, DM, g.Bt, DM, DM, N / 16, MiniBf16{PROJ, N, SSQ + (2 * l) * SSQ_I}, 0);
                dt_gemm(F, H, g.Bt + (size_t)ODD_INP * DM, SSQ + (2 * l) * SSQ_I, (float*)(ws + WS_DT), F.in[I_DTB] + (size_t)i * 32);
            }
            SEAM(pb + 0);
        }
        if (IN(pb + 1)) { REFRESH(); for (int rep = 0; rep < REP_THIN; ++rep) { if constexpr (evn) t_even_mix(F, i); else t_conv(F, i); } SEAM(pb + 1); }
        if constexpr (!evn) if (IN(pb + 2)) {
                REFRESH();
                const bool stream_first = (F.vcu & 1) != 0;
                if (stream_first) { for (int rep = 0; rep < REP_SSDS; ++rep) ssd_sample(F, i, rep == 0 ? (float*)(ws + WS_SSQH) + (size_t)i * 32 * MP : (float*)(ws + WS_DIFF)); __syncthreads(); }
                for (int rep = 0; rep < REP_SSD; ++rep) for (int it = F.vcu; it < NBATCH * NHEAD; it += F.G) ssd_prompt_item(F, i, it >> 5, it & 31, rep == 0 ? (float*)(ws + WS_SSQH) + (size_t)i * 32 * MP : (float*)(ws + WS_DIFF));
                if (!stream_first) { REFRESH(); for (int rep = 0; rep < REP_SSDS; ++rep) ssd_sample(F, i, rep == 0 ? (float*)(ws + WS_SSQH) + (size_t)i * 32 * MP : (float*)(ws + WS_DIFF)); }
            SEAM(pb + 2);
        }
        if (IN(pb + 4)) {
            bf16* YGb = (bf16*)(ws + WS_YG); const float* GSSQ = (const float*)(ws + WS_SSQH) + (size_t)i * 32 * MP;
            pg8::Gemm g{evn ? MIX : YGb, evn ? (const bf16*)(ws + WS_WTE_OUT) + (size_t)i * DM * 2048 : (const bf16*)(ws + WS_WTO_OUT) + (size_t)i * DM * 2048, DIN, DIN, DIN};
            pg8::StaticOrder S; S.init(64, 4, F.G, c);
            pg8::EpiResAdd E{H, SSQ + (2 * l + 1) * SSQ_I, 0};
            pg8::EpiResAdd E0{H, SSQ, hi > 9999 ? 0 : 1};
            if constexpr (evn) {
                for (int rep = 1; rep < REP_RES; ++rep) pg8::gemm_phase<pg8::EpiResAdd, pg8::AddrStd, true, true>(ring, g, S, E0, pg8::AddrStd{});
                pg8::gemm_phase<pg8::EpiResAdd, pg8::AddrStd, true, true>(ring, g, S, E, pg8::AddrStd{});
                REFRESH(); mini_gemm<16>(F, MIX, DIN, g.Bt, DIN, DIN, 64, MiniResAdd{H, SSQ + (2 * l + 1) * SSQ_I}, 0);
            } else {
                for (int rep = 1; rep < REP_RES; ++rep) pg8::gemm_phase<pg8::EpiResAdd, pg8::AddrStd, true, true, true>(ring, g, S, E0, pg8::AddrStd{}, GSSQ);
                pg8::gemm_phase<pg8::EpiResAdd, pg8::AddrStd, true, true, true>(ring, g, S, E, pg8::AddrStd{}, GSSQ);
                REFRESH(); mini_gemm<16>(F, YGb, DIN, g.Bt, DIN, DIN, 64, MiniResAdd{H, SSQ + (2 * l + 1) * SSQ_I}, 0, GSSQ);
            }
            SEAM(pb + 4);
        }
        if (IN(pb + 6)) {
            pg8::Gemm g{H, (const bf16*)(ws + WS_WTQ) + (size_t)l * DM * DM, DM, DM, DM};
            pg8::StaticOrder S; S.init(64, 4, F.G, c);
            pg8::EpiBf16S E{Qb, DM, SSQ + (2 * l + 1) * SSQ_I};
            for (int rep = 0; rep < REP_G4; ++rep) pg8::gemm_phase<pg8::EpiBf16S, pg8::AddrStd, true, true>(ring, g, S, E, pg8::AddrStd{});
            REFRESH(); for (int rep = 0; rep < REP_MINI; ++rep) mini_gemm<16>(F, H, DM, g.Bt, DM, DM, 64, MiniBf16{Qb, DM, SSQ + (2 * l + 1) * SSQ_I}, 0);
            SEAM(pb + 6);
        }
        if (IN(pb + 7)) {
            const bool stream_first = (F.vcu & 1) != 0;
            if (stream_first) { REFRESH(); AMP_SUB_BEGIN(); for (int rep = 0; rep < REP_SATTN; ++rep) t_sattn(F, l); __syncthreads(); AMP_SUB_END(10); }
            { pg8::Gemm g{Qb, (const bf16*)(ws + WS_KB) + (size_t)l * 2048 * DM, DM, DM, 256};
              pg8::StaticOrder S; S.init(64, 4, F.G, c);
              pg8::EpiSoftmax E{Pb, DM, 0.0625f * 1.44269504089f};
              for (int rep = 0; rep < REP_G5; ++rep) { pg8::gemm_phase<pg8::EpiSoftmax, pg8::AddrScore, false, true>(ring, g, S, E, pg8::AddrScore{}); __syncthreads(); } }
            asm volatile("s_waitcnt vmcnt(0)" ::: "memory"); __syncthreads();
            { pg8::Gemm g{Pb, (const bf16*)(ws + WS_VT) + (size_t)l * 8 * 1024 * 256, DM, 256, 256};
              pg8::StaticOrder S; S.init(64, 4, F.G, c);
              pg8::EpiBf16S E{Ob, DM, nullptr};
              for (int rep = 0; rep < REP_G6; ++rep) pg8::gemm_phase<pg8::EpiBf16S, pg8::AddrPV, true, true>(ring, g, S, E, pg8::AddrPV{}); }
            __syncthreads();
            if (!stream_first) { REFRESH(); AMP_SUB_BEGIN(); for (int rep = 0; rep < REP_SATTN; ++rep) t_sattn(F, l); AMP_SUB_END(10); }
            SEAM(pb + 7);
        }
        if (IN(pb + 9)) {
            pg8::Gemm g{Ob, (const bf16*)(ws + WS_WTO) + (size_t)l * DM * DM, DM, DM, DM};
            pg8::StaticOrder S; S.init(64, 4, F.G, c);
            pg8::EpiResAdd E{H, SSQ + (2 * l + 2) * SSQ_I, 0};
            for (int rep = 1; rep < REP_RES; ++rep) { pg8::EpiResAdd E0{H, SSQ, hi > 9999 ? 0 : 1}; pg8::gemm_phase<pg8::EpiResAdd, pg8::AddrStd, true, true>(ring, g, S, E0, pg8::AddrStd{}); }
            pg8::gemm_phase<pg8::EpiResAdd, pg8::AddrStd, true, true>(ring, g, S, E, pg8::AddrStd{});
            REFRESH(); mini_gemm<16>(F, Ob, DM, g.Bt, DM, DM, 64, MiniResAdd{H, SSQ + (2 * l + 2) * SSQ_I}, 0);
            SEAM(pb + 9);
        }
        if constexpr (l == 3) if (IN(pb + 10)) { REFRESH(); t_norm(F, F.in[I_NFIN], true); SEAM(pb + 10); }
}
__global__ void __launch_bounds__(NWAVES * 64, 2) trunk_fwd(Args args) {
    extern __shared__ __attribute__((aligned(16))) unsigned char lds[];
    Frame F;
    F.lds = (LAS unsigned char*)lds;
    F.tid = threadIdx.x; F.lane = F.tid & 63; F.wave = __builtin_amdgcn_readfirstlane(F.tid >> 6);
    F.G = gridDim.x; { const int bx = blockIdx.x; F.vcu = (F.G % 8 == 0) ? (bx % 8) * (F.G / 8) + bx / 8 : bx; }
    F.in = args.in; F.out = args.out; F.ws = args.ws;
    unsigned char* ws = args.ws;
    volatile LAS unsigned* MISC = (volatile LAS unsigned*)(F.lds + MISC_OFF);
    if (F.tid < 32) MISC[F.tid] = 0u;
    __syncthreads();
#if MK_PER_PHASE
    XcdBarrier bar; bar.bar = (unsigned*)(ws + WS_CTL) + CW_BAR; bar.x = 0; bar.st = MISC + 8;
#else
    XcdBarrier bar = xcd_barrier_post((unsigned*)(ws + WS_CTL) + CW_BAR, MISC + 8);
#endif
    const int lo = args.ph_lo, hi = args.ph_hi;
    LAS unsigned char* ring = F.lds;
    const int c = (int)blockIdx.x;

#if AMP_MASK
    unsigned long long amp_t0 = 0;
#endif
    if (IN(0)) { REFRESH(); for (int rep = 0; rep < REP_P0; ++rep) p0_prologue(F); SEAM(0); }
    if (IN(1)) {
        for (int rep = 0; rep < REP_P1; ++rep) {
        { pg8::Gemm g{(const bf16*)(ws + WS_MEMB), (const bf16*)(ws + WS_WTK), DM, DM, DM}; pg8::StaticOrder S; S.init(8, 16, F.G, c);
          pg8::EpiKproj E{F.out + OUT_MK, (bf16*)(ws + WS_KB)};
          pg8::gemm_phase<pg8::EpiKproj, pg8::AddrStd, true, true>(ring, g, S, E, pg8::AddrStd{}); }
        { pg8::Gemm g{(const bf16*)(ws + WS_WTV), (const bf16*)(ws + WS_MEMB), DM, DM, DM}; pg8::StaticOrder S; S.init(16, 8, F.G, (c + F.G / 2) % F.G);
          pg8::EpiVT E{F.out + OUT_MV, (bf16*)(ws + WS_VT)};
          pg8::gemm_phase<pg8::EpiVT, pg8::AddrStd, true, true>(ring, g, S, E, pg8::AddrStd{}); }
        }
        SEAM(1);
    }
    layer_phases<0>(F, lo, hi, bar); layer_phases<1>(F, lo, hi, bar); layer_phases<2>(F, lo, hi, bar); layer_phases<3>(F, lo, hi, bar);
#undef IN
#undef SEAM
}

extern "C" void kernel_launch(void* const* d_in, const int* in_sizes, int n_in, void* d_out, int out_size, void* d_ws, size_t ws_size, hipStream_t stream) {
    static int grid = 0;
    if (grid == 0) {
        if (n_in != 29 || (size_t)out_size != OUT_TOTAL || ws_size < WS_END) { fprintf(stderr, "kernel_launch: unexpected shapes: n_in %d out %d ws %zu (need %zu)\n", n_in, out_size, ws_size, (size_t)WS_END); grid = -1; return; }
        if (hipFuncSetAttribute((const void*)trunk_fwd, hipFuncAttributeMaxDynamicSharedMemorySize, LDS_BYTES) != hipSuccess) { fprintf(stderr, "kernel_launch: hipFuncSetAttribute failed\n"); grid = -1; return; }
        int dev = 0, cus = 0;
        if (hipGetDevice(&dev) != hipSuccess || hipDeviceGetAttribute(&cus, hipDeviceAttributeMultiprocessorCount, dev) != hipSuccess) { grid = -1; return; }
        (void)hipGetLastError();
        grid = cus < 256 ? cus : 256;
        if (grid != 256) fprintf(stderr, "kernel_launch: %d CUs; this kernel is built for a 256-CU grid\n", cus);
    }
    if (grid < 0) return;
    (void)hipMemsetAsync((char*)d_ws + WS_CTL, 0, CTL_ZERO_BYTES, stream);
    Args a{};
    for (int i = 0; i < 29; ++i) a.in[i] = (const float*)d_in[i];
    a.out = (float*)d_out; a.ws = (unsigned char*)d_ws;
#if MK_PER_PHASE
    for (int p = 0; p < N_PHASES; ++p) {
        if (p >= PH_LAYER0) { const int l = (p - PH_LAYER0) / PH_PER_LAYER, k = (p - PH_LAYER0) % PH_PER_LAYER; if (k == 3 || k == 5 || k == 8 || (k == 2 && (l & 1) == 0) || (k == 10 && l != 3)) continue; }
        a.ph_lo = p; a.ph_hi = p + 1;
        hipLaunchKernelGGL(trunk_fwd, dim3(grid), dim3(NWAVES * 64), LDS_BYTES, stream, a);
    }
#else
    a.ph_lo = 0; a.ph_hi = N_PHASES;
    hipLaunchKernelGGL(trunk_fwd, dim3(grid), dim3(NWAVES * 64), LDS_BYTES, stream, a);
#endif
}
```

```cpp
#include <hip/hip_runtime.h>
#include <cstdio>
#include <cstdint>

#ifndef REP_SSD
#define REP_SSD 1
#endif
#ifndef REP_SSDS
#define REP_SSDS 1
#endif
#ifndef REP_SATTN
#define REP_SATTN 1
#endif
#ifndef REP_THIN
#define REP_THIN 1
#endif
#ifndef REP_G1
#define REP_G1 1
#endif
#ifndef REP_G2
#define REP_G2 1
#endif
#ifndef REP_G4
#define REP_G4 1
#endif
#ifndef REP_G5
#define REP_G5 1
#endif
#ifndef REP_G6
#define REP_G6 1
#endif
#ifndef REP_P1
#define REP_P1 1
#endif
#ifndef REP_RES
#define REP_RES 1
#endif
#ifndef REP_BAR
#define REP_BAR 1
#endif
#ifndef REP_MINI
#define REP_MINI 1
#endif
#ifndef REP_P0
#define REP_P0 1
#endif
#ifndef MK_PER_PHASE
#define MK_PER_PHASE 0
#endif

namespace pg8 {
#define PG8_LAS __attribute__((address_space(3)))
typedef unsigned short bf16_t;
typedef short bf16x8 __attribute__((ext_vector_type(8)));
typedef float f32x4 __attribute__((ext_vector_type(4)));
typedef unsigned u32x4 __attribute__((ext_vector_type(4)));
typedef unsigned u32x2 __attribute__((ext_vector_type(2)));
constexpr int BM = 256, BK = 64, HALF = 128, HTB = HALF * BK * 2  , STAGE_BYTES = 8 * HTB, NXCD = 8, WGM = 8;

__host__ __device__ __forceinline__ int lds_byte(int r, int c) { const int st = (r >> 4) * 2 + (c >> 5), rr = r & 15, cc = c & 31, ob = rr * 64 + cc * 2; return st * 1024 + (ob ^ (((ob >> 9) & 1) << 5)); }
__host__ __device__ __forceinline__ void stage_rc(int b, int& R, int& C) { const int st = b / 1024, sb = b % 1024, swz = sb ^ (((sb >> 9) & 1) << 5); R = (st >> 1) * 16 + swz / 64; C = (st & 1) * 32 + (swz % 64) / 2; }
__host__ __device__ __forceinline__ int perm32(int rho) { const int n = rho >> 4, i = rho & 15; return 8 * (i >> 2) + 4 * n + (i & 3); }

struct Unit { int pm, pn; };
struct Gemm { const bf16_t* A; const bf16_t* Bt; int lda, ldb, K; };

struct StaticOrder {
    int nM, nN, nwg, G, c;
    __host__ __device__ void init(int nM_, int nN_, int G_, int c_) { nM = nM_; nN = nN_; nwg = nM * nN; G = G_; c = c_; }
    __host__ __device__ bool next(int i, Unit& u) const {
        const long L = (long)i * G + c; if (L >= nwg) return false;
        int wgid = (int)L; { const int q = nwg / NXCD, r = nwg % NXCD, xcd = wgid % NXCD, off = wgid / NXCD; wgid = (xcd < r ? xcd * (q + 1) : r * (q + 1) + (xcd - r) * q) + off; }
        const int nig = WGM * nN, gid = wgid / nig, fm = gid * WGM, gsz = (nM - fm) < WGM ? (nM - fm) : WGM;
        u.pm = fm + ((wgid % nig) % gsz); u.pn = (wgid % nig) / gsz; return true;
    }
};
struct AddrStd  { __device__ __forceinline__ size_t a(const Unit& u, const Gemm& g) const { return (size_t)u.pm * 256 * g.lda; }
                  __device__ __forceinline__ size_t b(const Unit& u, const Gemm& g) const { return (size_t)u.pn * 256 * g.ldb; } };
struct AddrColA { __device__ __forceinline__ size_t a(const Unit& u, const Gemm& g) const { return (size_t)u.pm * 256 * g.lda + (size_t)u.pn * 256; }
                  __device__ __forceinline__ size_t b(const Unit& u, const Gemm& g) const { return (size_t)u.pn * 256 * g.ldb; } };
struct AddrScore { __device__ __forceinline__ size_t a(const Unit& u, const Gemm& g) const { return (size_t)u.pm * 256 * g.lda + (size_t)u.pn * 256; }
                   __device__ __forceinline__ size_t b(const Unit& u, const Gemm& g) const { return (size_t)(u.pm >> 3) * 256 * g.ldb + (size_t)u.pn * 256; } };
struct AddrPV   { __device__ __forceinline__ size_t a(const Unit& u, const Gemm& g) const { return (size_t)u.pm * 256 * g.lda + (size_t)u.pn * 256; }
                  __device__ __forceinline__ size_t b(const Unit& u, const Gemm& g) const { return ((size_t)(u.pm >> 3) * 1024 + (size_t)u.pn * 256) * 256; } };

__device__ __forceinline__ unsigned cvt_pk_bf16(float lo, float hi) { unsigned r; asm volatile("v_cvt_pk_bf16_f32 %0, %1, %2" : "=v"(r) : "v"(lo), "v"(hi)); return r; }
__device__ __forceinline__ float bf_lo(unsigned w) { return __uint_as_float(w << 16); }
__device__ __forceinline__ float bf_hi(unsigned w) { return __uint_as_float(w & 0xffff0000u); }
__device__ __forceinline__ float silu_f(float z) { return z * __builtin_amdgcn_rcpf(1.0f + __builtin_amdgcn_exp2f(-1.44269504089f * z)); }

struct EpiBf16S {
    static constexpr bool PERM = true, AFTER_DRAIN = false;
    bf16_t* O; int ldc; const unsigned long long* ssq;
    __device__ __forceinline__ void operator()(const f32x4 (&acc)[2][2][4][2], const Unit& u, int wr, int wc, int fr, int fq) const {
        const int row0 = u.pm * BM + wr * 64 + fr, col0 = u.pn * BM + wc * 32 + 8 * fq;
        unsigned long long sv[2][4];
        if (ssq) {
#pragma unroll
            for (int ai = 0; ai < 2; ++ai)
#pragma unroll
                for (int m = 0; m < 4; ++m) sv[ai][m] = ssq[row0 + ai * HALF + m * 16]; }
#pragma unroll
        for (int ai = 0; ai < 2; ++ai)
#pragma unroll
            for (int m = 0; m < 4; ++m) { const size_t row = (size_t)(row0 + ai * HALF + m * 16); bf16_t* rowp = O + row * ldc + col0;
                float rs = 1.0f;
                if (ssq) rs = __builtin_amdgcn_rsqf((float)sv[ai][m] * (1.0f / (1024.0f * 1048576.0f)) + 1e-6f);
#pragma unroll
                for (int bj = 0; bj < 2; ++bj) { const f32x4 v0 = acc[ai][bj][m][0] * rs, v1 = acc[ai][bj][m][1] * rs;
                    u32x4 w; w.x = cvt_pk_bf16(v0[0], v0[1]); w.y = cvt_pk_bf16(v0[2], v0[3]); w.z = cvt_pk_bf16(v1[0], v1[1]); w.w = cvt_pk_bf16(v1[2], v1[3]);
                    *(u32x4*)(rowp + bj * HALF) = w; } }
    }
};
struct EpiEvenIn {
    static constexpr bool PERM = true, AFTER_DRAIN = false;
    bf16_t* O; const unsigned long long* ssq;
    __device__ __forceinline__ void operator()(const f32x4 (&acc)[2][2][4][2], const Unit& u, int wr, int wc, int fr, int fq) const {
        const int row0 = u.pm * BM + wr * 64 + fr, cw = wc * 32 + 8 * fq;
        unsigned long long sv[2][4];
#pragma unroll
        for (int ai = 0; ai < 2; ++ai)
#pragma unroll
            for (int m = 0; m < 4; ++m) sv[ai][m] = ssq[row0 + ai * HALF + m * 16];
#pragma unroll
        for (int ai = 0; ai < 2; ++ai)
#pragma unroll
            for (int m = 0; m < 4; ++m) { const size_t row = (size_t)(row0 + ai * HALF + m * 16); bf16_t* rowp = O + row * 4096;
                const float rs = __builtin_amdgcn_rsqf((float)sv[ai][m] * (1.0f / (1024.0f * 1048576.0f)) + 1e-6f);
                if (u.pn < 8) {
#pragma unroll
                    for (int bj = 0; bj < 2; ++bj) { const f32x4 v0 = acc[ai][bj][m][0] * rs, v1 = acc[ai][bj][m][1] * rs;
                        u32x4 w; w.x = cvt_pk_bf16(v0[0], v0[1]); w.y = cvt_pk_bf16(v0[2], v0[3]); w.z = cvt_pk_bf16(v1[0], v1[1]); w.w = cvt_pk_bf16(v1[2], v1[3]);
                        *(u32x4*)(rowp + u.pn * BM + cw + bj * HALF) = w; }
                } else {
                    float o[8];
#pragma unroll
                    for (int n = 0; n < 2; ++n)
#pragma unroll
                        for (int j = 0; j < 4; ++j) { const float a = acc[ai][0][m][n][j] * rs, b = acc[ai][1][m][n][j] * rs;
                            o[4 * n + j] = u.pn < 16 ? a * b : a * (b * __builtin_amdgcn_rcpf(1.0f + __builtin_amdgcn_exp2f(-1.44269504089f * b))); }
                    u32x4 w; w.x = cvt_pk_bf16(o[0], o[1]); w.y = cvt_pk_bf16(o[2], o[3]); w.z = cvt_pk_bf16(o[4], o[5]); w.w = cvt_pk_bf16(o[6], o[7]);
                    *(u32x4*)(rowp + 2048 + (u.pn - 8) * HALF + cw) = w; } }
    }
};
struct EpiResAdd {
    static constexpr bool PERM = true, AFTER_DRAIN = false;
    bf16_t* Xb; unsigned long long* ssq; int dry;
    __device__ __forceinline__ void row_update(const f32x4 (&acc)[2][2][4][2], int ai, int m, const u32x4 (&w)[2], bf16_t* rowp, size_t row, int fq) const {
        float sq = 0.f;
#pragma unroll
        for (int bj = 0; bj < 2; ++bj) { const unsigned int ww[4] = {w[bj].x, w[bj].y, w[bj].z, w[bj].w}; float o[8];
#pragma unroll
            for (int e = 0; e < 4; ++e) { o[2 * e] = __uint_as_float(ww[e] << 16) + acc[ai][bj][m][e >> 1][2 * (e & 1)]; o[2 * e + 1] = __uint_as_float(ww[e] & 0xffff0000u) + acc[ai][bj][m][e >> 1][2 * (e & 1) + 1]; }
#pragma unroll
            for (int e = 0; e < 8; e += 2) sq += o[e] * o[e] + o[e + 1] * o[e + 1];
            u32x4 v; v.x = cvt_pk_bf16(o[0], o[1]); v.y = cvt_pk_bf16(o[2], o[3]); v.z = cvt_pk_bf16(o[4], o[5]); v.w = cvt_pk_bf16(o[6], o[7]);
            *(u32x4*)(rowp + bj * HALF) = v; }
        sq += __shfl_xor(sq, 16); sq += __shfl_xor(sq, 32);
        if (fq == 0) atomicAdd(ssq + row, (unsigned long long)(sq * 1048576.0f));
    }
    __device__ __forceinline__ void operator()(const f32x4 (&acc)[2][2][4][2], const Unit& u, int wr, int wc, int fr, int fq) const {
        if (dry) return;
        const int row0 = u.pm * BM + wr * 64 + fr, col0 = u.pn * BM + wc * 32 + 8 * fq;
        u32x4 w[4][2][2];
#define RA_LOAD(p) do { _Pragma("unroll") for (int r = 0; r < 2; ++r) _Pragma("unroll") for (int bj = 0; bj < 2; ++bj) \
            w[(p) & 3][r][bj] = *(const u32x4*)(Xb + (size_t)(row0 + ((p) >> 1) * HALF + (2 * ((p) & 1) + r) * 16) * 1024 + col0 + bj * HALF); } while (0)
        RA_LOAD(0); RA_LOAD(1);
#pragma unroll
        for (int p = 0; p < 4; ++p) {
            if (p + 2 < 4) RA_LOAD(p + 2);
#pragma unroll
            for (int r = 0; r < 2; ++r) { const int ai = p >> 1, m = 2 * (p & 1) + r; const size_t row = (size_t)(row0 + ai * HALF + m * 16);
                row_update(acc, ai, m, w[p & 3][r], Xb + row * 1024 + col0, row, fq); }
            asm volatile("" ::: "memory"); }
#undef RA_LOAD
    }
};
struct EpiPoolGate {
    static constexpr bool PERM = true, AFTER_DRAIN = false;
    bf16_t* O; int ldc; const bf16_t* gate; int ldg; const float* scale;
    __device__ __forceinline__ void operator()(const f32x4 (&acc)[2][2][4][2], const Unit& u, int wr, int wc, int fr, int fq) const {
        const int row0 = u.pm * BM + wr * 64 + fr, col0 = u.pn * BM + wc * 32 + 8 * fq;
        f32x4 sc[2][2];
#pragma unroll
        for (int bj = 0; bj < 2; ++bj)
#pragma unroll
            for (int n = 0; n < 2; ++n) sc[bj][n] = *(const f32x4*)(scale + col0 + bj * HALF + 4 * n);
#pragma unroll
        for (int ai = 0; ai < 2; ++ai)
#pragma unroll
            for (int m = 0; m < 4; ++m) { const size_t row = (size_t)(row0 + ai * HALF + m * 16);
#pragma unroll
                for (int bj = 0; bj < 2; ++bj) { const u32x4 gw = *(const u32x4*)(gate + row * ldg + col0 + bj * HALF);
                    const f32x4 v0 = acc[ai][bj][m][0] * sc[bj][0], v1 = acc[ai][bj][m][1] * sc[bj][1];
                    u32x4 w; w.x = cvt_pk_bf16(v0[0] * silu_f(bf_lo(gw.x)), v0[1] * silu_f(bf_hi(gw.x))); w.y = cvt_pk_bf16(v0[2] * silu_f(bf_lo(gw.y)), v0[3] * silu_f(bf_hi(gw.y)));
                    w.z = cvt_pk_bf16(v1[0] * silu_f(bf_lo(gw.z)), v1[1] * silu_f(bf_hi(gw.z))); w.w = cvt_pk_bf16(v1[2] * silu_f(bf_lo(gw.w)), v1[3] * silu_f(bf_hi(gw.w)));
                    *(u32x4*)(O + row * ldc + col0 + bj * HALF) = w; } }
    }
};
struct EpiKproj {
    static constexpr bool PERM = false, AFTER_DRAIN = false;
    float* outK; bf16_t* KB;
    __device__ __forceinline__ void operator()(const f32x4 (&acc)[2][2][4][2], const Unit& u, int wr, int wc, int fr, int fq) const {
        const int l = u.pn >> 2, row0 = u.pm * BM + wr * 64 + fr, col0 = (u.pn & 3) * BM + wc * 32 + 4 * fq;
        float* ob = outK + (size_t)l * 2048 * 1024; bf16_t* kb = KB + (size_t)l * 2048 * 1024;
#pragma unroll
        for (int ai = 0; ai < 2; ++ai)
#pragma unroll
            for (int m = 0; m < 4; ++m) { const size_t ro = (size_t)(row0 + ai * HALF + m * 16) * 1024 + col0;
#pragma unroll
                for (int bj = 0; bj < 2; ++bj)
#pragma unroll
                    for (int n = 0; n < 2; ++n) { const f32x4 v = acc[ai][bj][m][n]; *(f32x4*)(ob + ro + bj * HALF + n * 16) = v;
                        if (KB) { u32x2 w; w.x = cvt_pk_bf16(v[0], v[1]); w.y = cvt_pk_bf16(v[2], v[3]); *(u32x2*)(kb + ro + bj * HALF + n * 16) = w; } } }
    }
};
struct EpiVT {
    static constexpr bool PERM = false, AFTER_DRAIN = false;
    float* outV; bf16_t* VT;
    __device__ __forceinline__ void operator()(const f32x4 (&acc)[2][2][4][2], const Unit& u, int wr, int wc, int fr, int fq) const {
        const int l = u.pm >> 2, e0 = (u.pm & 3) * BM + wr * 64 + fr, b = u.pn, m0 = wc * 32 + 4 * fq;
        bf16_t* vb = VT + ((size_t)l * 8 + b) * 1024 * 256;
#pragma unroll
        for (int ai = 0; ai < 2; ++ai)
#pragma unroll
            for (int m = 0; m < 4; ++m) { const int e = e0 + ai * HALF + m * 16;
#pragma unroll
                for (int bj = 0; bj < 2; ++bj)
#pragma unroll
                    for (int n = 0; n < 2; ++n) { const f32x4 v = acc[ai][bj][m][n]; const int mm = m0 + bj * HALF + n * 16;
                        u32x2 w; w.x = cvt_pk_bf16(v[0], v[1]); w.y = cvt_pk_bf16(v[2], v[3]); *(u32x2*)(vb + (size_t)e * 256 + mm) = w;
                        float* ov = outV + (size_t)l * 2048 * 1024 + (size_t)(b * 256 + mm) * 1024 + e;
                        ov[0] = v[0]; ov[1024] = v[1]; ov[2048] = v[2]; ov[3072] = v[3]; } }
    }
};
struct EpiSoftmax {
    static constexpr bool PERM = true, AFTER_DRAIN = true;
    bf16_t* P; int ldc; float c2;
    __device__ __forceinline__ void fused(f32x4 (&acc)[2][2][4][2], const Unit& u, int wr, int wc, int fr, int fq, PG8_LAS unsigned char* lds, int wid, int lane) const {
        PG8_LAS f32x4* TM = (PG8_LAS f32x4*)lds;
        PG8_LAS f32x4* TS = (PG8_LAS f32x4*)(lds + 4096);
        PG8_LAS float* TMf = (PG8_LAS float*)lds; PG8_LAS float* TSf = (PG8_LAS float*)(lds + 4096);
#pragma unroll
        for (int ai = 0; ai < 2; ++ai)
#pragma unroll
            for (int m = 0; m < 4; ++m) { float mx = -3.0e38f;
#pragma unroll
                for (int bj = 0; bj < 2; ++bj)
#pragma unroll
                    for (int n = 0; n < 2; ++n) { const f32x4 x = acc[ai][bj][m][n]; mx = fmaxf(mx, fmaxf(fmaxf(x[0], x[1]), fmaxf(x[2], x[3]))); }
                mx = fmaxf(mx, __shfl_xor(mx, 16)); mx = fmaxf(mx, __shfl_xor(mx, 32));
                if (fq == 0) TMf[(ai * HALF + wr * 64 + m * 16 + fr) * 4 + wc] = mx; }
        asm volatile("s_waitcnt lgkmcnt(0)" ::: "memory"); __builtin_amdgcn_s_barrier(); asm volatile("" ::: "memory");
#pragma unroll
        for (int ai = 0; ai < 2; ++ai)
#pragma unroll
            for (int m = 0; m < 4; ++m) { const int rl = ai * HALF + wr * 64 + m * 16 + fr; const f32x4 t = TM[rl]; const float mx = fmaxf(fmaxf(t[0], t[1]), fmaxf(t[2], t[3])); float s = 0.f;
#pragma unroll
                for (int bj = 0; bj < 2; ++bj)
#pragma unroll
                    for (int n = 0; n < 2; ++n) { f32x4 x = acc[ai][bj][m][n];
#pragma unroll
                        for (int j = 0; j < 4; ++j) { x[j] = __builtin_amdgcn_exp2f((x[j] - mx) * c2); s += x[j]; }
                        acc[ai][bj][m][n] = x; }
                s += __shfl_xor(s, 16); s += __shfl_xor(s, 32);
                if (fq == 0) TSf[rl * 4 + wc] = s; }
        asm volatile("s_waitcnt lgkmcnt(0)" ::: "memory"); __builtin_amdgcn_s_barrier(); asm volatile("" ::: "memory");
        const int row0 = u.pm * BM + wr * 64 + fr, col0 = u.pn * BM + wc * 32 + 8 * fq;
#pragma unroll
        for (int ai = 0; ai < 2; ++ai)
#pragma unroll
            for (int m = 0; m < 4; ++m) { const int rl = ai * HALF + wr * 64 + m * 16 + fr; const f32x4 t = TS[rl]; const float inv = 1.0f / ((t[0] + t[1]) + (t[2] + t[3]));
                bf16_t* rowp = P + (size_t)(row0 + ai * HALF + m * 16) * ldc + col0;
#pragma unroll
                for (int bj = 0; bj < 2; ++bj) { const f32x4 v0 = acc[ai][bj][m][0] * inv, v1 = acc[ai][bj][m][1] * inv;
                    u32x4 w; w.x = cvt_pk_bf16(v0[0], v0[1]); w.y = cvt_pk_bf16(v0[2], v0[3]); w.z = cvt_pk_bf16(v1[0], v1[1]); w.w = cvt_pk_bf16(v1[2], v1[3]);
                    *(u32x4*)(rowp + bj * HALF) = w; } }
    }
};

template <class Epi, class Addr, bool ALIGN_EPI = false, bool SP2 = false, bool KS = false>
__device__ __forceinline__ void gemm_phase(PG8_LAS unsigned char* lds, const Gemm g, const StaticOrder& S, const Epi& E, const Addr AD, const float* ssqh = nullptr) {
    int tid = threadIdx.x; asm volatile("" : "+v"(tid));
    const int wid = __builtin_amdgcn_readfirstlane(tid >> 6), lane = tid & 63, wr = wid >> 2, wc = wid & 3, fr = lane & 15, fq = lane >> 4;
    const int K = g.K, nt = K / BK;
    unsigned voffA[2], voffB[2];
#pragma unroll
    for (int i = 0; i < 2; ++i) { int R, C; stage_rc(tid * 16 + i * 8192, R, C); const int Rb = Epi::PERM ? ((R & ~31) + perm32(R & 31)) : R;
        voffA[i] = (unsigned)(R * g.lda + C) * 2u; voffB[i] = (unsigned)(Rb * g.ldb + C) * 2u; }
    const size_t kstep = (size_t)(BK * 2);
    const size_t hstepA = (size_t)HALF * g.lda * 2, hstepB = (size_t)HALF * g.ldb * 2;
    const unsigned ldsw = (unsigned)wid * 1024u;
    const int aoff = lds_byte(wr * 64 + fr, fq * 8), boff = lds_byte(wc * 32 + fr, fq * 8);
#define PG8_SA(b, h) (((b) * 2 + (h)) * HTB)
#define PG8_SB(b, h) ((4 + (b) * 2 + (h)) * HTB)
#define PG8_STAGE(bufoff, gbase, voff) do { _Pragma("unroll") for (int _i = 0; _i < 2; ++_i) \
        __builtin_amdgcn_global_load_lds((const unsigned*)((const char*)(gbase) + (voff)[_i]), (PG8_LAS unsigned*)(lds + (bufoff) + ldsw + _i * 8192), 16, 0, 0); } while (0)
#define PG8_LDA(dst, b, h) do { _Pragma("unroll") for (int m = 0; m < 4; ++m) _Pragma("unroll") for (int k = 0; k < 2; ++k) dst[m][k] = *(const PG8_LAS bf16x8*)(lds + PG8_SA(b, h) + aoff + m * 2048 + k * 1024); } while (0)
#define PG8_LDB(dst, b, h) do { _Pragma("unroll") for (int n = 0; n < 2; ++n) _Pragma("unroll") for (int k = 0; k < 2; ++k) dst[n][k] = *(const PG8_LAS bf16x8*)(lds + PG8_SB(b, h) + boff + n * 2048 + k * 1024); } while (0)
#define PG8_MMA(ai, bj, At, Bt) do { __builtin_amdgcn_s_setprio(1); _Pragma("unroll") for (int m = 0; m < 4; ++m) _Pragma("unroll") for (int n = 0; n < 2; ++n) _Pragma("unroll") for (int k = 0; k < 2; ++k) \
        acc[ai][bj][m][n] = __builtin_amdgcn_mfma_f32_16x16x32_bf16(Bt[n][k], At[m][k], acc[ai][bj][m][n], 0, 0, 0); __builtin_amdgcn_s_setprio(0); } while (0)
#define PG8_WAIT_V(n) asm volatile("s_waitcnt vmcnt(" #n ")" ::: "memory")
#define PG8_WAIT_L(n) asm volatile("s_waitcnt lgkmcnt(" #n ")" ::: "memory")
#define PG8_BAR __builtin_amdgcn_s_barrier()
#define PG8_SCHED __builtin_amdgcn_sched_barrier(0)
    Unit cur, nxt; int ui = 0;
    if (!S.next(0, cur)) return;
    f32x4 acc[2][2][4][2];
#pragma unroll
    for (int a = 0; a < 2; ++a)
#pragma unroll
        for (int b = 0; b < 2; ++b)
#pragma unroll
            for (int m = 0; m < 4; ++m)
#pragma unroll
                for (int n = 0; n < 2; ++n) acc[a][b][m][n] = (f32x4){0.f, 0.f, 0.f, 0.f};
    bf16x8 At[4][2], B0[2][2], B1[2][2];
    const char* cA = (const char*)g.A + 2 * AD.a(cur, g); const char* cB = (const char*)g.Bt + 2 * AD.b(cur, g);
    PG8_LAS float* kstab = (PG8_LAS float*)(lds + STAGE_BYTES);
    if constexpr (KS) { if (tid < 256) { const float* q = ssqh + (size_t)(cur.pm * BM + tid); float r[4];
#pragma unroll
            for (int gi = 0; gi < 4; ++gi) { float a = 0.f;
#pragma unroll
                for (int e = 0; e < 8; ++e) a += q[(size_t)(gi * 8 + e) * 16640];
                r[gi] = 1.0f / sqrtf(a * (1.0f / 512.0f) + 1e-6f); }
            *(PG8_LAS f32x4*)(kstab + tid * 4) = (f32x4){r[0] / r[1], r[1] / r[2], r[2] / r[3], r[3]}; } }
#define PG8_KSCALE(gi) do { _Pragma("unroll") for (int ai = 0; ai < 2; ++ai) _Pragma("unroll") for (int m = 0; m < 4; ++m) { const float f_ = kstab[(ai * HALF + wr * 64 + m * 16 + fr) * 4 + (gi)]; \
        _Pragma("unroll") for (int bj = 0; bj < 2; ++bj) _Pragma("unroll") for (int n = 0; n < 2; ++n) acc[ai][bj][m][n] = acc[ai][bj][m][n] * f_; } } while (0)
    if constexpr (SP2) {
        PG8_STAGE(PG8_SB(0, 0), cB, voffB); PG8_STAGE(PG8_SB(0, 1), cB + hstepB, voffB); PG8_STAGE(PG8_SA(0, 0), cA, voffA); PG8_STAGE(PG8_SA(0, 1), cA + hstepA, voffA);
        if (wr == 1) PG8_BAR;
        PG8_WAIT_V(2); PG8_BAR;
        PG8_STAGE(PG8_SB(1, 0), cB + kstep, voffB); PG8_STAGE(PG8_SA(1, 0), cA + kstep, voffA); PG8_STAGE(PG8_SB(1, 1), cB + hstepB + kstep, voffB);
        PG8_WAIT_V(6); PG8_BAR;
    } else {
        PG8_STAGE(PG8_SB(0, 0), cB, voffB); PG8_STAGE(PG8_SA(0, 0), cA, voffA); PG8_STAGE(PG8_SB(0, 1), cB + hstepB, voffB); PG8_STAGE(PG8_SA(0, 1), cA + hstepA, voffA);
        if (wr == 1) PG8_BAR;
        PG8_WAIT_V(4); PG8_BAR;
        PG8_STAGE(PG8_SB(1, 0), cB + kstep, voffB); PG8_STAGE(PG8_SA(1, 0), cA + kstep, voffA); PG8_STAGE(PG8_SB(1, 1), cB + hstepB + kstep, voffB);
        PG8_WAIT_V(6); PG8_BAR;
    }
    for (;;) {
        const bool has_next = S.next(ui + 1, nxt);
        const char* nA = has_next ? (const char*)g.A + 2 * AD.a(nxt, g) : cA; const char* nB = has_next ? (const char*)g.Bt + 2 * AD.b(nxt, g) : cB;
        for (int seg = 0; seg < (KS ? 4 : 1); ++seg) {
        if constexpr (KS) { if (seg > 0) PG8_KSCALE(seg - 1); }
        for (int t = KS ? seg * 8 : 0; t < (KS ? seg * 8 + 8 : nt); t += 2) {
            const bool last = (t == nt - 2);
            const char* a1 = cA + (size_t)(t + 1) * kstep;
            const char* a2 = last ? nA : cA + (size_t)(t + 2) * kstep; const char* b2 = last ? nB : cB + (size_t)(t + 2) * kstep;
            const char* a3 = a2 + kstep; const char* b3 = b2 + kstep;
            if constexpr (SP2) {
            PG8_LDB(B0, 0, 0); PG8_LDB(B1, 0, 1); PG8_SCHED; PG8_LDA(At, 0, 0); PG8_STAGE(PG8_SA(1, 1), a1 + hstepA, voffA);
            PG8_WAIT_V(8); PG8_WAIT_L(0); PG8_BAR; PG8_MMA(0, 0, At, B0); PG8_MMA(0, 1, At, B1); PG8_BAR; PG8_SCHED;
            PG8_LDA(At, 0, 1); PG8_STAGE(PG8_SB(0, 0), b2, voffB); PG8_STAGE(PG8_SB(0, 1), b2 + hstepB, voffB); PG8_STAGE(PG8_SA(0, 0), a2, voffA);
            PG8_WAIT_V(8); PG8_WAIT_L(0); PG8_BAR; PG8_MMA(1, 0, At, B0); PG8_MMA(1, 1, At, B1); PG8_BAR; PG8_SCHED;
            PG8_LDB(B0, 1, 0); PG8_LDB(B1, 1, 1); PG8_SCHED; PG8_LDA(At, 1, 0); PG8_STAGE(PG8_SA(0, 1), a2 + hstepA, voffA);
            PG8_WAIT_V(8); PG8_WAIT_L(0); PG8_BAR; PG8_MMA(0, 0, At, B0); PG8_MMA(0, 1, At, B1); PG8_BAR; PG8_SCHED;
            PG8_LDA(At, 1, 1); PG8_STAGE(PG8_SB(1, 0), b3, voffB); PG8_STAGE(PG8_SB(1, 1), b3 + hstepB, voffB); PG8_STAGE(PG8_SA(1, 0), a3, voffA);
            PG8_WAIT_V(8); PG8_WAIT_L(0); PG8_BAR; PG8_MMA(1, 0, At, B0); PG8_MMA(1, 1, At, B1); PG8_BAR; PG8_SCHED;
            } else {
            PG8_LDB(B0, 0, 0); PG8_SCHED; PG8_LDA(At, 0, 0); PG8_STAGE(PG8_SA(1, 1), a1 + hstepA, voffA);
            PG8_WAIT_L(8); PG8_BAR; PG8_WAIT_L(0); PG8_MMA(0, 0, At, B0); PG8_BAR; PG8_SCHED;
            PG8_LDB(B1, 0, 1); PG8_STAGE(PG8_SB(0, 0), b2, voffB);
            PG8_BAR; PG8_WAIT_L(0); PG8_MMA(0, 1, At, B1); PG8_BAR;
            PG8_LDA(At, 0, 1); PG8_STAGE(PG8_SA(0, 0), a2, voffA);
            PG8_BAR; PG8_WAIT_L(0); PG8_MMA(1, 0, At, B0); PG8_BAR; PG8_SCHED;
            PG8_STAGE(PG8_SB(0, 1), b2 + hstepB, voffB);
            PG8_WAIT_V(6); PG8_BAR; PG8_MMA(1, 1, At, B1); PG8_BAR;
            PG8_LDB(B0, 1, 0); PG8_SCHED; PG8_LDA(At, 1, 0); PG8_STAGE(PG8_SA(0, 1), a2 + hstepA, voffA);
            PG8_WAIT_L(8); PG8_BAR; PG8_WAIT_L(0); PG8_MMA(0, 0, At, B0); PG8_BAR; PG8_SCHED;
            PG8_LDB(B1, 1, 1); PG8_STAGE(PG8_SB(1, 0), b3, voffB);
            PG8_BAR; PG8_WAIT_L(0); PG8_MMA(0, 1, At, B1); PG8_BAR;
            PG8_LDA(At, 1, 1); PG8_STAGE(PG8_SA(1, 0), a3, voffA);
            PG8_BAR; PG8_WAIT_L(0); PG8_MMA(1, 0, At, B0); PG8_BAR; PG8_SCHED;
            PG8_STAGE(PG8_SB(1, 1), b3 + hstepB, voffB);
            PG8_WAIT_V(6); PG8_BAR; PG8_MMA(1, 1, At, B1); PG8_BAR;
            }
        }
        }
        if constexpr (KS) PG8_KSCALE(3);
        if constexpr (ALIGN_EPI) { if (wr == 0) PG8_BAR; }
        if constexpr (!Epi::AFTER_DRAIN) { E(acc, cur, wr, wc, fr, fq); }
        if (!has_next) break;
#pragma unroll
        for (int a = 0; a < 2; ++a)
#pragma unroll
            for (int b = 0; b < 2; ++b)
#pragma unroll
                for (int m = 0; m < 4; ++m)
#pragma unroll
                    for (int n = 0; n < 2; ++n) acc[a][b][m][n] = (f32x4){0.f, 0.f, 0.f, 0.f};
        cur = nxt; cA = nA; cB = nB; ++ui;
        if constexpr (ALIGN_EPI) { if (wr == 1) PG8_BAR; }
    }
    PG8_WAIT_V(0);
    if constexpr (!ALIGN_EPI) { if (wr == 0) PG8_BAR; }
    PG8_BAR;
    if constexpr (Epi::AFTER_DRAIN) { E.fused(acc, cur, wr, wc, fr, fq, lds, wid, lane); }
#undef PG8_KSCALE
#undef PG8_SA
#undef PG8_SB
#undef PG8_STAGE
#undef PG8_LDA
#undef PG8_LDB
#undef PG8_MMA
#undef PG8_WAIT_V
#undef PG8_WAIT_L
#undef PG8_BAR
#undef PG8_SCHED
}
}

constexpr int NWAVES = 8;
constexpr int DM = 1024, TP = 16384, NBATCH = 8, SEQ = 2048, NSMP = 128, MV = TP + NSMP  , MP = 16640  , NPAN = 65;
constexpr int EVEN_IN = 6144, EVEN_P = 4096  , ODD_IN = 5152, ODD_WROWS = 5376  , ODD_INP = 5120  , DIN = 2048, CONVD = 3072, NHEAD = 32, NMEM = 256;
constexpr float EPS = 1e-6f;
constexpr size_t OUT_Y = 0, OUT_MK = 16908288, OUT_MV = 25296896, OUT_PP = 33685504, OUT_PS = 33931264, OUT_CP = 37863424, OUT_CS = 37896192,
                 OUT_SCP = 38420480, OUT_SCS = 38567936, OUT_SP = 40927232, OUT_SS = 45121536, OUT_TOTAL = 112230400;
constexpr size_t MiB = 1u << 20;
constexpr size_t WS_CTL = 0, CTL_ZERO_BYTES = 5 * MiB;
constexpr size_t WS_SSQ = 1 * MiB;
constexpr size_t WS_GSSQ = 3 * MiB;
constexpr size_t WS_WTE_IN = 5 * MiB;
constexpr size_t WS_WTE_OUT = WS_WTE_IN + 24 * MiB;
constexpr size_t WS_WTO_IN = WS_WTE_OUT + 8 * MiB;
constexpr size_t WS_WTO_OUT = WS_WTO_IN + 21 * MiB;
constexpr size_t WS_WTQ = WS_WTO_OUT + 8 * MiB;
constexpr size_t WS_WTK = WS_WTQ + 8 * MiB, WS_WTV = WS_WTK + 8 * MiB, WS_WTO = WS_WTV + 8 * MiB;
constexpr size_t WS_WTP = WS_WTO + 8 * MiB;
constexpr size_t WS_MEMB = WS_WTP + 1 * MiB;
constexpr size_t WS_KB = WS_MEMB + 4 * MiB;
constexpr size_t WS_VT = WS_KB + 16 * MiB;
constexpr size_t WS_H = WS_VT + 16 * MiB;
constexpr size_t WS_Q = WS_H + 34 * MiB, WS_PB = WS_Q + 34 * MiB, WS_O = WS_PB + 34 * MiB, WS_DIFF = WS_O + 34 * MiB;
constexpr size_t WS_MIX = WS_DIFF + 34 * MiB;
constexpr size_t WS_YG = WS_MIX + 66 * MiB;
constexpr size_t WS_CONVX = WS_YG + 66 * MiB;
constexpr size_t WS_DT = WS_CONVX + 98 * MiB;
constexpr size_t WS_PROJ = WS_DT + 3 * MiB;
constexpr size_t WS_WTU = WS_PROJ + 196 * MiB;
constexpr size_t WS_SSQH = WS_WTU + 4 * MiB;
constexpr size_t WS_END = WS_SSQH + 5 * MiB;
constexpr int CW_BAR = 4096;
constexpr int RING_BYTES = 131072, SSD_SMALL_OFF = 131072, MISC_OFF = 163840 - 128, LDS_BYTES = 163840;

#define GAS __attribute__((address_space(1)))
#define LAS __attribute__((address_space(3)))
#define DI __device__ __forceinline__
typedef unsigned short bf16;
typedef unsigned v4u __attribute__((ext_vector_type(4)));
typedef unsigned v2u __attribute__((ext_vector_type(2)));
typedef float f32x4 __attribute__((ext_vector_type(4)));
typedef float f32x16 __attribute__((ext_vector_type(16)));
typedef short bf16x8 __attribute__((ext_vector_type(8)));
typedef GAS unsigned gu32;
#define LDS_WAIT() asm volatile("s_waitcnt lgkmcnt(0)" ::: "memory")
DI unsigned f2bf(float f) { unsigned u = __builtin_bit_cast(unsigned, f); return (u + 0x7fffu + ((u >> 16) & 1u)) >> 16; }
DI unsigned pk2(float lo, float hi) { unsigned r; asm("v_cvt_pk_bf16_f32 %0, %1, %2" : "=v"(r) : "v"(lo), "v"(hi)); return r; }
DI float bflo(unsigned w) { return __uint_as_float(w << 16); }
DI float bfhi(unsigned w) { return __uint_as_float(w & 0xffff0000u); }
DI float bf1(bf16 h) { return __uint_as_float(((unsigned)h) << 16); }
DI void unpack8(const v4u v, float (&f)[8]) { f[0] = bflo(v.x); f[1] = bfhi(v.x); f[2] = bflo(v.y); f[3] = bfhi(v.y); f[4] = bflo(v.z); f[5] = bfhi(v.z); f[6] = bflo(v.w); f[7] = bfhi(v.w); }
DI v4u pack8(const float (&f)[8]) { v4u o; o.x = pk2(f[0], f[1]); o.y = pk2(f[2], f[3]); o.z = pk2(f[4], f[5]); o.w = pk2(f[6], f[7]); return o; }
DI void ld8(const bf16* p, float (&f)[8]) { unpack8(*(const GAS v4u*)p, f); }
DI void ld8f(const float* p, float (&f)[8]) { const f32x4 a = *(const GAS f32x4*)p, b = *(const GAS f32x4*)(p + 4); f[0] = a[0]; f[1] = a[1]; f[2] = a[2]; f[3] = a[3]; f[4] = b[0]; f[5] = b[1]; f[6] = b[2]; f[7] = b[3]; }
DI void st8(bf16* p, const float (&f)[8]) { *(GAS v4u*)p = pack8(f); }
DI void st8f(float* p, const float (&f)[8]) { *(GAS f32x4*)p = (f32x4){f[0], f[1], f[2], f[3]}; *(GAS f32x4*)(p + 4) = (f32x4){f[4], f[5], f[6], f[7]}; }
DI float silu(float z) { return z * __builtin_amdgcn_rcpf(1.0f + __builtin_amdgcn_exp2f(-1.44269504089f * z)); }
DI float wave_sum(float v) {
#pragma unroll
    for (int o = 1; o < 64; o <<= 1) v += __shfl_xor(v, o);
    return v;
}

#define XB_TMO      128
#define XB_XCNT(j)  (256  + 64 * (j))
#define XB_XSUB(j)  (1280 + 64 * (j))
#define XB_XGEN(j)  (2304 + 64 * (j))
#define XB_TOP      3328
#define XB_TOPGEN   3392
#define XCD_BAR_WORDS 3456
#define XB_SPIN_CAP (1u << 18)
DI unsigned xb_ld(unsigned* p)              { return __hip_atomic_load(p, __ATOMIC_RELAXED, __HIP_MEMORY_SCOPE_AGENT); }
DI unsigned xb_add(unsigned* p, unsigned v) { return __hip_atomic_fetch_add(p, v, __ATOMIC_RELAXED, __HIP_MEMORY_SCOPE_AGENT); }
DI unsigned xb_xcc_id() { return (unsigned)__builtin_amdgcn_s_getreg((3 << 11) | 20) & 0xFu; }
#define XB_SPIN(cond, bar) do { unsigned _sp = 0; while (cond) { __builtin_amdgcn_s_sleep(1); \
    if ((++_sp & 255u) == 0u) { if (xb_ld(&(bar)[XB_TMO])) break; if (_sp > XB_SPIN_CAP) { atomicAdd(&(bar)[XB_TMO], 1u); break; } } } } while (0)
struct XcdBarrier { unsigned* bar; unsigned x; volatile LAS unsigned* st; };
DI XcdBarrier xcd_barrier_post(unsigned* bar, volatile LAS unsigned* st) {
    XcdBarrier b; b.bar = bar; b.x = xb_xcc_id(); b.st = st;
    if (threadIdx.x == 0) (void)xb_add(&bar[XB_XCNT(b.x)], 1u);
    return b;
}
DI void xcd_barrier_complete(unsigned* bar, unsigned x, unsigned& nloc, unsigned& nx) {
    const unsigned G = gridDim.x * gridDim.y * gridDim.z;
    unsigned sum, cnt, mine, sp = 0u;
    for (;;) {
        sum = 0u; cnt = 0u; mine = 0u;
#pragma unroll
        for (unsigned j = 0; j < 16; ++j) { const unsigned c = xb_ld(&bar[XB_XCNT(j)]); sum += c; cnt += (c > 0u) ? 1u : 0u; mine = (j == x) ? c : mine; }
        if (sum == G) break;
        __builtin_amdgcn_s_sleep(1);
        if ((++sp & 255u) == 0u) { if (xb_ld(&bar[XB_TMO])) break; if (sp > XB_SPIN_CAP) { atomicAdd(&bar[XB_TMO], 1u); break; } }
    }
    nloc = mine > 0u ? mine : 1u; nx = cnt > 0u ? cnt : 1u;
}
DI void xcd_barrier(const XcdBarrier& b) {
    asm volatile("s_waitcnt vmcnt(0)" ::: "memory");
    __syncthreads();
    if (threadIdx.x == 0) {
        unsigned* bar = b.bar;
        __builtin_amdgcn_s_waitcnt(0);
        unsigned nloc = b.st[0], nx = b.st[1];
        if (nloc == 0u) { xcd_barrier_complete(bar, b.x, nloc, nx); b.st[0] = nloc; b.st[1] = nx; }
        const unsigned old = xb_add(&bar[XB_XSUB(b.x)], 1u);
        const unsigned gen = old / nloc;
        __builtin_amdgcn_fence(__ATOMIC_ACQUIRE, "agent");
        if (old + 1u == (gen + 1u) * nloc) {
            __builtin_amdgcn_fence(__ATOMIC_RELEASE, "agent");
            asm volatile("s_waitcnt vmcnt(0)" ::: "memory");
            const unsigned og = xb_add(&bar[XB_TOP], 1u);
            const unsigned tg = og / nx;
            if (og + 1u == (tg + 1u) * nx) xb_add(&bar[XB_TOPGEN], 1u);
            else XB_SPIN(xb_ld(&bar[XB_TOPGEN]) == tg, bar);
            asm volatile("" ::: "memory");
            xb_add(&bar[XB_XGEN(b.x)], 1u);
            asm volatile("s_waitcnt vmcnt(0)" ::: "memory");
        } else {
            XB_SPIN(xb_ld(&bar[XB_XGEN(b.x)]) == gen, bar);
            asm volatile("s_waitcnt vmcnt(0)" ::: "memory");
        }
    }
    __syncthreads();
}

struct Args { const float* in[29]; float* out; unsigned char* ws; int ph_lo, ph_hi; };
struct Frame {
    LAS unsigned char* lds;
    int tid, lane, wave, vcu, G;
    const float* const* in; float* out; unsigned char* ws;
};
enum { I_XP = 0, I_XS, I_MEM, I_CK, I_CV, I_SPOOL, I_SCONV, I_SSCONV, I_SSSM, I_NMIX, I_NXA, I_NFIN, I_WINE, I_POOLW, I_POOLS, I_CONVW, I_WOUTE, I_WINO, I_SCW, I_SCB, I_DTB, I_ALOG, I_DSKIP, I_SNORM, I_WOUTO, I_WQ, I_WK, I_WV, I_WO };

DI void p0_transpose_item(const float* W, int K, int N, bf16* WT, LAS float* scr, int item, int lane, const float* gk = nullptr) {
    const int nblk = N / 32, kb = item / nblk, nb = item % nblk, k0 = 64 * kb, n0 = 32 * nb;
    {
        const int kr = lane >> 3, ns = lane & 7; f32x4 v[8];
#pragma unroll
        for (int i = 0; i < 8; ++i) v[i] = *(const GAS f32x4*)(W + (size_t)(k0 + 8 * i + kr) * N + n0 + 4 * ns);
#pragma unroll
        for (int i = 0; i < 8; ++i) { const int kk = 8 * i + kr; const float gg = gk ? ((const GAS float*)gk)[k0 + kk] : 1.0f; LAS float* d = scr + kk * 33 + 4 * ns;
            d[0] = v[i][0] * gg; d[1] = v[i][1] * gg; d[2] = v[i][2] * gg; d[3] = v[i][3] * gg; } }
    LDS_WAIT(); asm volatile("" ::: "memory");
    const int c = lane & 7;
#pragma unroll
    for (int j = 0; j < 4; ++j) { const int n = (lane >> 3) + 8 * j; const LAS float* s = scr + (8 * c) * 33 + n;
        v4u o; o.x = pk2(s[0 * 33], s[1 * 33]); o.y = pk2(s[2 * 33], s[3 * 33]); o.z = pk2(s[4 * 33], s[5 * 33]); o.w = pk2(s[6 * 33], s[7 * 33]);
        *(GAS v4u*)(WT + (size_t)(n0 + n) * K + k0 + 8 * c) = o; }
    LDS_WAIT(); asm volatile("" ::: "memory");
}
DI void p0_prologue(Frame& F) {
    LAS float* scr = (LAS float*)(F.lds + F.wave * 16384);
    const int gw = F.vcu * NWAVES + F.wave, NGW = F.G * NWAVES;
    unsigned char* ws = F.ws;
    constexpr int IT_WINE = 16 * 192, IT_WOUT = 32 * 32, IT_WINO = 16 * 161, IT_SQ = 16 * 32, IT_PW = 4 * 8;
    constexpr int N0 = 2 * IT_WINE, N1 = N0 + 2 * IT_WOUT, N2 = N1 + 2 * IT_WINO, N3 = N2 + 2 * IT_WOUT, N4 = N3 + 16 * IT_SQ, N5 = N4 + 8 * IT_PW;
    for (int it = gw; it < N5; it += NGW) {
        if (it < N0) { const int mi = it / IT_WINE, r = it % IT_WINE;
            bf16* dst = (r % 192) < 32 ? (bf16*)(ws + WS_WTU) + (size_t)mi * DM * DM : (bf16*)(ws + WS_WTE_IN) + (size_t)mi * EVEN_IN * DM;
            {
                const int nb = r % 192;
                if (nb >= 64) { const int blk = (nb - 64) >> 5, cb = (nb - 64) & 31, chunk = cb >> 2, sub = cb & 3;
                    const int nnb = (blk == 1 || blk == 2) ? 64 + chunk * 8 + sub + (blk == 2 ? 4 : 0) : 128 + chunk * 8 + sub + (blk == 3 ? 4 : 0);
                    dst += (ptrdiff_t)(nnb - nb) * 32 * DM; } }
            p0_transpose_item(F.in[I_WINE] + (size_t)mi * DM * EVEN_IN, DM, EVEN_IN, dst, scr, r, F.lane, F.in[I_NMIX] + (size_t)(2 * mi) * DM); }
        else if (it < N1) { const int q = it - N0, mi = q / IT_WOUT, r = q % IT_WOUT; p0_transpose_item(F.in[I_WOUTE] + (size_t)mi * 2048 * DM, 2048, DM, (bf16*)(ws + WS_WTE_OUT) + (size_t)mi * DM * 2048, scr, r, F.lane); }
        else if (it < N2) { const int q = it - N1, mi = q / IT_WINO, r = q % IT_WINO; p0_transpose_item(F.in[I_WINO] + (size_t)mi * DM * ODD_IN, DM, ODD_IN, (bf16*)(ws + WS_WTO_IN) + (size_t)mi * ODD_WROWS * DM, scr, r, F.lane, F.in[I_NMIX] + (size_t)(2 * mi + 1) * DM); }
        else if (it < N3) { const int q = it - N2, mi = q / IT_WOUT, r = q % IT_WOUT; p0_transpose_item(F.in[I_WOUTO] + (size_t)mi * 2048 * DM, 2048, DM, (bf16*)(ws + WS_WTO_OUT) + (size_t)mi * DM * 2048, scr, r, F.lane, F.in[I_SNORM] + (size_t)mi * DIN); }
        else if (it < N4) { const int q = it - N3, mi = q / IT_SQ, r = q % IT_SQ, which = mi >> 2, l = mi & 3;
            const float* src = F.in[I_WQ + which] + (size_t)l * DM * DM;
            bf16* dst = (bf16*)(ws + (which == 0 ? WS_WTQ : which == 1 ? WS_WTK : which == 2 ? WS_WTV : WS_WTO)) + (size_t)l * DM * DM;
            p0_transpose_item(src, DM, DM, dst, scr, r, F.lane, which == 0 ? F.in[I_NXA] + (size_t)l * DM : nullptr); }
        else { const int q = it - N4, mi = q / IT_PW, r = q % IT_PW; p0_transpose_item(F.in[I_POOLW] + (size_t)mi * 65536, 256, 256, (bf16*)(ws + WS_WTP) + (size_t)mi * 65536, scr, r, F.lane); }
    }
    for (int it = gw; it < 2 * 4 * 32 * 8; it += NGW) {
        const int mi = it >> 10, gg = (it >> 8) & 3, kb = (it >> 3) & 31, nb = it & 7, r = F.lane & 31, h = F.lane >> 5;
        const float* Wi = F.in[I_WINE] + (size_t)mi * DM * EVEN_IN + (size_t)(32 * kb + r) * EVEN_IN + gg * 256;
        const float* Wp = F.in[I_POOLW] + (size_t)(mi * 4 + gg) * 65536 + nb * 32 + r;
        f32x16 acc;
#pragma unroll
        for (int k = 0; k < 16; ++k) acc[k] = 0.f;
        for (int j0 = 0; j0 < 256; j0 += 16) {
            f32x4 a4[4]; float b[16];
#pragma unroll
            for (int q = 0; q < 4; ++q) a4[q] = *(const GAS f32x4*)(Wi + j0 + 4 * q);
#pragma unroll
            for (int q = 0; q < 8; ++q) { b[2 * q] = ((const GAS float*)Wp)[(size_t)(j0 + 2 * q + h) * 256]; }
#pragma unroll
            for (int q = 0; q < 8; ++q) { const float av = (q & 1) ? (h ? a4[q >> 1][3] : a4[q >> 1][2]) : (h ? a4[q >> 1][1] : a4[q >> 1][0]);
                acc = __builtin_amdgcn_mfma_f32_32x32x2f32(av, b[2 * q], acc, 0, 0, 0); }
        }
        bf16* dst = (bf16*)(ws + WS_WTE_IN) + (size_t)mi * EVEN_IN * DM + (size_t)(gg * 256 + nb * 32 + r) * DM + 32 * kb;
        const float* gk = F.in[I_NMIX] + (size_t)(2 * mi) * DM + 32 * kb;
#pragma unroll
        for (int q4 = 0; q4 < 4; ++q4) { const int k0 = 8 * q4 + 4 * h; const f32x4 g4 = *(const GAS f32x4*)(gk + k0);
            *(GAS v2u*)(dst + k0) = (v2u){pk2(acc[4 * q4] * g4[0], acc[4 * q4 + 1] * g4[1]), pk2(acc[4 * q4 + 2] * g4[2], acc[4 * q4 + 3] * g4[3])}; }
    }
    const int gt = F.vcu * 512 + F.tid, NGT = F.G * 512;
    for (int i = gt; i < 2 * 224 * 128; i += NGT) { const int mi = i / (224 * 128), r = i % (224 * 128);
        *(GAS v4u*)((bf16*)(ws + WS_WTO_IN) + ((size_t)mi * ODD_WROWS + ODD_IN) * DM + (size_t)r * 8) = (v4u){0u, 0u, 0u, 0u}; }
    for (int i = gt; i < 2048 * 128; i += NGT) { float f[8]; ld8f(F.in[I_MEM] + (size_t)i * 8, f); st8((bf16*)(ws + WS_MEMB) + (size_t)i * 8, f); }
    bf16* H = (bf16*)(ws + WS_H); unsigned long long* SSQ = (unsigned long long*)(ws + WS_SSQ);
    for (int m0 = 2 * gw; m0 < MV; m0 += 2 * NGW) {
        f32x4 v[2][4];
#pragma unroll
        for (int rr = 0; rr < 2; ++rr) { const int m = m0 + rr; const float* xrow = m < TP ? F.in[I_XP] + (size_t)m * DM : F.in[I_XS] + (size_t)(m - TP) * DM; const GAS f32x4* xr = (const GAS f32x4*)xrow + F.lane;
#pragma unroll
            for (int j = 0; j < 4; ++j) v[rr][j] = xr[64 * j]; }
#pragma unroll
        for (int rr = 0; rr < 2; ++rr) { const int m = m0 + rr; GAS v2u* o8 = (GAS v2u*)(H + (size_t)m * DM) + F.lane; float s = 0.f;
#pragma unroll
            for (int j = 0; j < 4; ++j) { const f32x4 x = v[rr][j]; s += (x.x * x.x + x.y * x.y) + (x.z * x.z + x.w * x.w); o8[64 * j] = (v2u){pk2(x.x, x.y), pk2(x.z, x.w)}; }
            s = wave_sum(s);
            if (F.lane == 0) ((GAS unsigned long long*)SSQ)[m] = (unsigned long long)(s * 1048576.0f); }
    }
}
DI void t_norm(Frame& F, const float* g, bool fin) {
    const int gw = F.vcu * NWAVES + F.wave, NGW = F.G * NWAVES;
    const bf16* H = (const bf16*)(F.ws + WS_H);
    for (int m0 = 2 * gw; m0 < MV; m0 += 2 * NGW) {
        v4u w[2][2];
#pragma unroll
        for (int rr = 0; rr < 2; ++rr) { const GAS v4u* hr = (const GAS v4u*)(H + (size_t)(m0 + rr) * DM) + F.lane; w[rr][0] = hr[0]; w[rr][1] = hr[64]; }
#pragma unroll
        for (int rr = 0; rr < 2; ++rr) { float x[2][8]; float s = 0.f;
#pragma unroll
            for (int j = 0; j < 2; ++j)
#pragma unroll
                for (int e = 0; e < 4; ++e) { x[j][2 * e] = __uint_as_float(w[rr][j][e] << 16); x[j][2 * e + 1] = __uint_as_float(w[rr][j][e] & 0xffff0000u); s += x[j][2 * e] * x[j][2 * e] + x[j][2 * e + 1] * x[j][2 * e + 1]; }
            const float rstd = 1.f / sqrtf(wave_sum(s) * (1.f / DM) + EPS);
            GAS f32x4* yo = (GAS f32x4*)(F.out + (size_t)(m0 + rr) * DM);
#pragma unroll
            for (int j = 0; j < 2; ++j) { const int c0 = 512 * j + 8 * F.lane; const f32x4 g0 = *(const GAS f32x4*)(g + c0), g1 = *(const GAS f32x4*)(g + c0 + 4);
                yo[(c0 >> 2)] = (f32x4){x[j][0] * rstd * g0.x, x[j][1] * rstd * g0.y, x[j][2] * rstd * g0.z, x[j][3] * rstd * g0.w};
                yo[(c0 >> 2) + 1] = (f32x4){x[j][4] * rstd * g1.x, x[j][5] * rstd * g1.y, x[j][6] * rstd * g1.z, x[j][7] * rstd * g1.w}; }
        }
    }
}
DI void t_even_mix(Frame& F, int i) {
    const bf16* PROJ = (const bf16*)(F.ws + WS_PROJ); bf16* MIX = (bf16*)(F.ws + WS_MIX);
    const int c8 = F.tid & 127, sub = F.tid >> 7, ch = c8 * 8, w = 2 << (ch >> 8);
    float cw0[8], cw1[8], cw2[8], psc[8];
    ld8f(F.in[I_CONVW] + (size_t)(i * 3 + 0) * DM + ch, cw0); ld8f(F.in[I_CONVW] + (size_t)(i * 3 + 1) * DM + ch, cw1); ld8f(F.in[I_CONVW] + (size_t)(i * 3 + 2) * DM + ch, cw2);
    ld8f(F.in[I_POOLS] + (size_t)i * DM + ch, psc);
    for (int item = F.vcu * 512 + F.tid; item < (TP / 16) * 128; item += F.G * 512) {
        const int run = item >> 7, t0 = run * 16, b = t0 >> 11, tt0 = t0 & 2047;
        const bf16* pr0 = PROJ + (size_t)t0 * EVEN_P;
        float S[8], cv1[8], cv2[8], tmp[8], cg[8], vv[8];
#pragma unroll
        for (int j = 0; j < 8; ++j) { S[j] = 0.f; cv1[j] = 0.f; cv2[j] = 0.f; }
        if (tt0 > 0) {
            for (int k = 1; k < w; ++k) { ld8(pr0 - (size_t)k * EVEN_P + ch, tmp);
#pragma unroll
                for (int j = 0; j < 8; ++j) S[j] += tmp[j]; }
            ld8(pr0 - EVEN_P + 2048 + ch, cv1);
            ld8(pr0 - 2 * EVEN_P + 2048 + ch, cv2);
        }
        if (tt0 > 0 && tt0 + 16 <= SEQ - 15) {
            const float inv = 1.0f / (float)w;
#pragma unroll 4
            for (int k = 0; k < 16; ++k) {
                const size_t t = (size_t)t0 + k; const bf16* pr = pr0 + (size_t)k * EVEN_P;
                float u0[8], uo[8], gp[8], bg[8], cv0[8];
                ld8(pr + ch, u0); ld8(pr + 1024 + ch, gp); ld8(pr + 2048 + ch, cv0); ld8(pr + 3072 + ch, bg); ld8(pr - (size_t)(w - 1) * EVEN_P + ch, uo);
#pragma unroll
                for (int j = 0; j < 8; ++j) { S[j] += u0[j]; tmp[j] = (S[j] * inv - u0[j]) * psc[j] * silu(gp[j]); S[j] -= uo[j]; }
                st8(MIX + t * DIN + ch, tmp);
#pragma unroll
                for (int j = 0; j < 8; ++j) { tmp[j] = bg[j] * (cw0[j] * cv2[j] + cw1[j] * cv1[j] + cw2[j] * cv0[j]); cv2[j] = cv1[j]; cv1[j] = cv0[j]; }
                st8(MIX + t * DIN + 1024 + ch, tmp);
            }
        } else {
#pragma unroll 2
        for (int k = 0; k < 16; ++k) {
            const int tt = tt0 + k; const size_t t = (size_t)t0 + k; const bf16* pr = pr0 + (size_t)k * EVEN_P;
            float u0[8], uo[8], gp[8], bg[8], cv0[8];
            ld8(pr + ch, u0); ld8(pr + 1024 + ch, gp); ld8(pr + 2048 + ch, cv0); ld8(pr + 3072 + ch, bg);
            const bool drop = tt - (w - 1) >= 0;
            if (drop) ld8(pr - (size_t)(w - 1) * EVEN_P + ch, uo);
            const float inv = 1.0f / (float)(tt + 1 < w ? tt + 1 : w);
#pragma unroll
            for (int j = 0; j < 8; ++j) { S[j] += u0[j]; tmp[j] = (S[j] * inv - u0[j]) * psc[j] * silu(gp[j]); if (drop) S[j] -= uo[j]; }
            st8(MIX + t * DIN + ch, tmp);
#pragma unroll
            for (int j = 0; j < 8; ++j) { tmp[j] = bg[j] * (cw0[j] * cv2[j] + cw1[j] * cv1[j] + cw2[j] * cv0[j]); cv2[j] = cv1[j]; cv1[j] = cv0[j]; }
            st8(MIX + t * DIN + 1024 + ch, tmp);
            if (tt >= SEQ - 2) st8f(F.out + OUT_CP + ((size_t)(i * NBATCH + b) * 2 + (tt - (SEQ - 2))) * DM + ch, cv0);
        }
        }
    }
    LAS float* DF = (LAS float*)F.lds;
    const bf16* WTP = (const bf16*)(F.ws + WS_WTP) + (size_t)i * 4 * 65536;
    for (int it = F.vcu; it < (NSMP / 4) * 8; it += F.G) {
        const int rq = it >> 3, os = it & 7, bb = rq * 4 + sub; const size_t row = TP + bb;
        const bf16* pr = PROJ + (size_t)TP * EVEN_P + (size_t)bb * EVEN_IN;
        const int pA = 2048 + (ch >> 7) * 256 + (ch & 127), pB = pA + 2048;
        const float* pref = F.in[I_SPOOL] + ((size_t)(i * NSMP + bb) * 15) * DM + ch;
        float* pso = F.out + OUT_PS + ((size_t)(i * NSMP + bb) * 15) * DM + ch;
        float u0[8], sum[8], tmp[8];
        ld8(pr + ch, u0);
#pragma unroll
        for (int j = 0; j < 8; ++j) sum[j] = u0[j];
        for (int k = 0; k < 15; ++k) { ld8f(pref + (size_t)k * DM, tmp);
            if (os == 0 && k >= 1) st8f(pso + (size_t)(k - 1) * DM, tmp);
            if (15 - k < w) {
#pragma unroll
                for (int j = 0; j < 8; ++j) sum[j] += tmp[j]; } }
        const float inv = 1.0f / (float)w;
#pragma unroll
        for (int j = 0; j < 8; ++j) DF[sub * 1024 + ch + j] = sum[j] * inv - u0[j];
        if (os == 0) {
            st8f(pso + (size_t)14 * DM, u0);
            float cg[8], vv[8], cv0[8], p0[8], p1[8], bg[8], gc[8];
            ld8(pr + pA, cg); ld8(pr + pA + 128, vv);
#pragma unroll
            for (int j = 0; j < 8; ++j) cv0[j] = cg[j] * vv[j];
            ld8f(F.in[I_SCONV] + ((size_t)(i * NSMP + bb) * 2 + 0) * DM + ch, p0); ld8f(F.in[I_SCONV] + ((size_t)(i * NSMP + bb) * 2 + 1) * DM + ch, p1);
            ld8(pr + pB, bg); ld8(pr + pB + 128, gc);
#pragma unroll
            for (int j = 0; j < 8; ++j) tmp[j] = bg[j] * (cw0[j] * p0[j] + cw1[j] * p1[j] + cw2[j] * cv0[j]) * silu(gc[j]);
            st8(MIX + row * DIN + 1024 + ch, tmp);
            st8f(F.out + OUT_CS + ((size_t)(i * NSMP + bb) * 2 + 0) * DM + ch, p1); st8f(F.out + OUT_CS + ((size_t)(i * NSMP + bb) * 2 + 1) * DM + ch, cv0);
        }
        __syncthreads();
        {   const int n = os * 128 + (F.tid & 127), gg = n >> 8; const LAS float* dfr = DF + sub * 1024 + gg * 256; const bf16* wr = WTP + (size_t)gg * 65536 + (size_t)(n & 255) * 256;
            float acc = 0.f;
#pragma unroll 8
            for (int k0 = 0; k0 < 256; k0 += 8) { float wv[8]; ld8(wr + k0, wv); const f32x4 d0 = *(const LAS f32x4*)(dfr + k0), d1 = *(const LAS f32x4*)(dfr + k0 + 4);
                acc += (d0[0] * wv[0] + d0[1] * wv[1]) + (d0[2] * wv[2] + d0[3] * wv[3]) + (d1[0] * wv[4] + d1[1] * wv[5]) + (d1[2] * wv[6] + d1[3] * wv[7]); }
            const float gpv = bf1(((const GAS bf16*)pr)[1024 + n]), sc = ((const GAS float*)F.in[I_POOLS])[(size_t)i * DM + n];
            ((GAS bf16*)MIX)[row * DIN + n] = (bf16)f2bf(acc * sc * silu(gpv));
        }
        __syncthreads();
    }
}
DI void t_conv(Frame& F, int i) {
    const bf16* PROJ = (const bf16*)(F.ws + WS_PROJ); bf16* CONVX = (bf16*)(F.ws + WS_CONVX); float* DT = (float*)(F.ws + WS_DT);
    const int gt = F.vcu * 512 + F.tid, NGT = F.G * 512;
    const float* cwp = F.in[I_SCW] + (size_t)i * 4 * CONVD; const float* cbp = F.in[I_SCB] + (size_t)i * CONVD;
    for (int idx = gt; idx < (TP / 16) * 384; idx += NGT) {
        const int run = idx / 384, c8 = idx - run * 384, ch = c8 * 8, t0 = run * 16, tt0 = t0 & 2047, b = t0 >> 11;
        const bf16* pr0 = PROJ + (size_t)t0 * ODD_INP + 2048 + ch;
        float w0[8], w1[8], w2[8], w3[8], bb[8], x0[8], x1[8], x2[8];
        ld8f(cwp + ch, w0); ld8f(cwp + CONVD + ch, w1); ld8f(cwp + 2 * CONVD + ch, w2); ld8f(cwp + 3 * CONVD + ch, w3); ld8f(cbp + ch, bb);
        if (tt0 > 0) { ld8(pr0 - 3 * ODD_INP, x0); ld8(pr0 - 2 * ODD_INP, x1); ld8(pr0 - ODD_INP, x2); }
        else {
#pragma unroll
            for (int j = 0; j < 8; ++j) { x0[j] = 0.f; x1[j] = 0.f; x2[j] = 0.f; } }
        v4u xr[16];
#pragma unroll
        for (int k = 0; k < 16; ++k) xr[k] = *(const GAS v4u*)(pr0 + (size_t)k * ODD_INP);
#pragma unroll
        for (int k = 0; k < 16; ++k) {
            float x3[8], acc[8]; unpack8(xr[k], x3);
#pragma unroll
            for (int j = 0; j < 8; ++j) { acc[j] = silu(bb[j] + w0[j] * x0[j] + w1[j] * x1[j] + w2[j] * x2[j] + w3[j] * x3[j]); x0[j] = x1[j]; x1[j] = x2[j]; x2[j] = x3[j]; }
            st8(CONVX + (size_t)(t0 + k) * CONVD + ch, acc);
            const int tt = tt0 + k;
            if (tt >= SEQ - 3) st8f(F.out + OUT_SCP + ((size_t)(i * NBATCH + b) * 3 + (tt - (SEQ - 3))) * CONVD + ch, x3);
        }
    }
    for (int idx = gt; idx < NSMP * 384; idx += NGT) {
        const int bb = idx / 384, c8 = idx - bb * 384, ch = c8 * 8; const size_t row = TP + bb;
        const float* st = F.in[I_SSCONV] + ((size_t)(i * NSMP + bb) * 3) * CONVD + ch; float* so = F.out + OUT_SCS + ((size_t)(i * NSMP + bb) * 3) * CONVD + ch;
        float x3[8], s0[8], s1[8], s2[8], acc[8], w[8];
        ld8(PROJ + row * ODD_INP + 2048 + ch, x3); ld8f(st, s0); ld8f(st + CONVD, s1); ld8f(st + 2 * CONVD, s2);
        ld8f(cbp + ch, acc);
        ld8f(cwp + ch, w);
#pragma unroll
        for (int j = 0; j < 8; ++j) acc[j] += w[j] * s0[j];
        ld8f(cwp + CONVD + ch, w);
#pragma unroll
        for (int j = 0; j < 8; ++j) acc[j] += w[j] * s1[j];
        ld8f(cwp + 2 * CONVD + ch, w);
#pragma unroll
        for (int j = 0; j < 8; ++j) acc[j] += w[j] * s2[j];
        ld8f(cwp + 3 * CONVD + ch, w);
#pragma unroll
        for (int j = 0; j < 8; ++j) acc[j] = silu(acc[j] + w[j] * x3[j]);
        st8(CONVX + row * CONVD + ch, acc);
        st8f(so, s1); st8f(so + CONVD, s2); st8f(so + 2 * CONVD, x3);
    }
}
DI void t_gnorm(Frame& F, int i) {
    const int gw = F.vcu * NWAVES + F.wave, NGW = F.G * NWAVES;
    const bf16* YG = (const bf16*)(F.ws + WS_YG); bf16* MIX = (bf16*)(F.ws + WS_MIX); const float* nw = F.in[I_SNORM] + (size_t)i * DIN;
    for (int m = gw; m < MV; m += NGW) {
#pragma unroll
        for (int j = 0; j < 4; ++j) { float f[8], g[8]; const int ch = (F.lane + 64 * j) * 8;
            ld8(YG + (size_t)m * DIN + ch, f); float s = 0.f;
#pragma unroll
            for (int k = 0; k < 8; ++k) s += f[k] * f[k];
            const float rstd = 1.f / sqrtf(wave_sum(s) * (1.f / 512.f) + EPS);
            ld8f(nw + ch, g);
#pragma unroll
            for (int k = 0; k < 8; ++k) f[k] = f[k] * rstd * g[k];
            st8(MIX + (size_t)m * DIN + ch, f); }
    }
}
DI void t_sattn(Frame& F, int l) {
    const bf16* Q = (const bf16*)(F.ws + WS_Q); bf16* O = (bf16*)(F.ws + WS_O);
    LAS float* SC = (LAS float*)F.lds; LAS float* RED = (LAS float*)(F.lds + 4096);
    const int hd = F.lane >> 5, l32 = F.lane & 31;
    const float c2 = 0.0625f * 1.44269504089f;
#define SA_LOAD(buf, base, r0) do { _Pragma("unroll") for (int u = 0; u < 8; ++u) { buf[u][0] = *(const GAS f32x4*)((base) + (size_t)((r0) + u) * DM); buf[u][1] = *(const GAS f32x4*)((base) + (size_t)((r0) + u) * DM + 4); } } while (0)
#define SA_DOT(buf, r0) do { _Pragma("unroll") for (int u = 0; u < 8; ++u) { float d = (q[0] * buf[u][0][0] + q[1] * buf[u][0][1]) + (q[2] * buf[u][0][2] + q[3] * buf[u][0][3]) + (q[4] * buf[u][1][0] + q[5] * buf[u][1][1]) + (q[6] * buf[u][1][2] + q[7] * buf[u][1][3]); \
        _Pragma("unroll") for (int o = 1; o < 32; o <<= 1) d += __shfl_xor(d, o); if (l32 == 0) SC[hd * 256 + (r0) + u] = d; } } while (0)
#define SA_PV(buf, r0) do { _Pragma("unroll") for (int u = 0; u < 8; ++u) { const float p = __builtin_amdgcn_exp2f((SC[hd * 256 + (r0) + u] - mx) * c2) * inv; \
        acc[0] += p * buf[u][0][0]; acc[1] += p * buf[u][0][1]; acc[2] += p * buf[u][0][2]; acc[3] += p * buf[u][0][3]; acc[4] += p * buf[u][1][0]; acc[5] += p * buf[u][1][1]; acc[6] += p * buf[u][1][2]; acc[7] += p * buf[u][1][3]; } } while (0)
    for (int it = F.vcu; it < 256; it += F.G) {
        const int b = it >> 1, hp = it & 1, w0 = F.wave * 32;
        const float* Kc = F.in[I_CK] + ((size_t)(l * NSMP + b) * NMEM) * DM + hp * 512 + F.lane * 8;
        const float* Vc = F.in[I_CV] + ((size_t)(l * NSMP + b) * NMEM) * DM + hp * 512 + F.lane * 8;
        f32x4 A[8][2], B[8][2];
        SA_LOAD(A, Kc, w0); SA_LOAD(B, Kc, w0 + 8);
        float q[8]; ld8(Q + (size_t)(TP + b) * DM + hp * 512 + F.lane * 8, q);
        SA_DOT(A, w0); SA_LOAD(A, Kc, w0 + 16);
        SA_DOT(B, w0 + 8); SA_LOAD(B, Kc, w0 + 24);
        SA_DOT(A, w0 + 16); SA_LOAD(A, Vc, w0);
        SA_DOT(B, w0 + 24); SA_LOAD(B, Vc, w0 + 8);
        __syncthreads();
        float mx = -3.0e38f;
#pragma unroll
        for (int j = 0; j < 8; ++j) mx = fmaxf(mx, SC[hd * 256 + l32 * 8 + j]);
#pragma unroll
        for (int o = 1; o < 32; o <<= 1) mx = fmaxf(mx, __shfl_xor(mx, o));
        float sm = 0.f;
#pragma unroll
        for (int j = 0; j < 8; ++j) sm += __builtin_amdgcn_exp2f((SC[hd * 256 + l32 * 8 + j] - mx) * c2);
#pragma unroll
        for (int o = 1; o < 32; o <<= 1) sm += __shfl_xor(sm, o);
        const float inv = 1.0f / sm;
        float acc[8];
#pragma unroll
        for (int j = 0; j < 8; ++j) acc[j] = 0.f;
        SA_PV(A, w0); SA_LOAD(A, Vc, w0 + 16);
        SA_PV(B, w0 + 8); SA_LOAD(B, Vc, w0 + 24);
        SA_PV(A, w0 + 16); SA_PV(B, w0 + 24);
#pragma unroll
        for (int j = 0; j < 8; ++j) RED[F.wave * 512 + F.lane * 8 + j] = acc[j];
        __syncthreads();
        float o = 0.f;
#pragma unroll
        for (int w = 0; w < 8; ++w) o += RED[w * 512 + F.tid];
        ((GAS bf16*)O)[(size_t)(TP + b) * DM + hp * 512 + F.tid] = (bf16)f2bf(o);
        __syncthreads();
    }
#undef SA_LOAD
#undef SA_DOT
#undef SA_PV
}
struct MiniBf16 { bf16* O; int ldc; const unsigned long long* ssq;
    DI void operator()(const f32x4 acc, size_t row, int col) const { const float rs = ssq ? 1.0f / sqrtf((float)((const GAS unsigned long long*)ssq)[row] * (1.0f / (1024.0f * 1048576.0f)) + EPS) : 1.0f;
        *(GAS v2u*)(O + row * ldc + col) = (v2u){pk2(acc[0] * rs, acc[1] * rs), pk2(acc[2] * rs, acc[3] * rs)}; } };
struct MiniResAdd { bf16* Xb; unsigned long long* ssq;
    DI void operator()(const f32x4 acc, size_t row, int col) const { GAS v2u* p = (GAS v2u*)(Xb + row * 1024 + col); const v2u w = *p;
        const float x[4] = {__uint_as_float(w[0] << 16) + acc[0], __uint_as_float(w[0] & 0xffff0000u) + acc[1], __uint_as_float(w[1] << 16) + acc[2], __uint_as_float(w[1] & 0xffff0000u) + acc[3]};
        *p = (v2u){pk2(x[0], x[1]), pk2(x[2], x[3])};
        float sq = (x[0] * x[0] + x[1] * x[1]) + (x[2] * x[2] + x[3] * x[3]); sq += __shfl_xor(sq, 16); sq += __shfl_xor(sq, 32);
        if ((col & 15) == 0) atomicAdd(ssq + row, (unsigned long long)(sq * 1048576.0f)); } };
struct MiniPoolState { float* out; const unsigned long long* ssq;
    DI void operator()(const f32x4 acc, size_t row, int col) const { const int b = (int)(row >> 11), j = (int)(row & 2047) - (SEQ - 15); if (j < 0) return;
        const float rs = 1.0f / sqrtf((float)((const GAS unsigned long long*)ssq)[row] * (1.0f / (1024.0f * 1048576.0f)) + EPS);
        *(GAS f32x4*)(out + ((size_t)b * 15 + j) * DM + col) = acc * rs; } };
struct MiniPoolGate { bf16* O; int ldc; const bf16* gate; int ldg; const float* scale;
    DI void operator()(const f32x4 acc, size_t row, int c) const { const f32x4 sc = *(const GAS f32x4*)(scale + c); const v2u gw = *(const GAS v2u*)(gate + row * ldg + c);
        *(GAS v2u*)(O + row * ldc + c) = (v2u){pk2(acc[0] * sc[0] * silu(bflo(gw.x)), acc[1] * sc[1] * silu(bfhi(gw.x))), pk2(acc[2] * sc[2] * silu(bflo(gw.y)), acc[3] * sc[3] * silu(bfhi(gw.y)))}; } };
template <int KB  , class Epi> DI void mini_gemm(Frame& F, const bf16* A  , int lda, const bf16* Bt, int ldb, int K, int nCB, const Epi& E, int shift, const float* gssq = nullptr  , int rbase = TP, int rstride = 16  ) {
    const int NGW = F.G * NWAVES; int vc = F.vcu - shift; vc = vc < 0 ? vc + F.G : vc; const int gw = F.wave * F.G + vc;
    const int fr = F.lane & 15, fq = F.lane >> 4;
    for (int u = gw; u < 8 * nCB; u += NGW) {
        const int rb = u & 7, cb = u >> 3;
        const size_t grow = (size_t)rbase + (size_t)rb * rstride + fr;
        const bf16* ap = A + grow * lda + 8 * fq;
        const bf16* bp = Bt + (size_t)(16 * cb + fr) * ldb + 8 * fq;
        f32x4 acc = (f32x4){0.f, 0.f, 0.f, 0.f};
        float rg[4] = {1.f, 1.f, 1.f, 1.f};
        if (gssq) { const GAS float* q = (const GAS float*)gssq + grow;
#pragma unroll
            for (int gi = 0; gi < 4; ++gi) { float a = 0.f;
#pragma unroll
                for (int e = 0; e < 8; ++e) a += q[(size_t)(gi * 8 + e) * MP];
                rg[gi] = 1.0f / sqrtf(a * (1.0f / 512.0f) + EPS); } }
        {
            const int ns = K >> 8;
            bf16x8 a[3][8], b[3][8];
#define MG_LOAD(buf, st) do { _Pragma("unroll") for (int s2 = 0; s2 < 8; ++s2) { a[buf][s2] = *(const GAS bf16x8*)(ap + (st) * 256 + 32 * s2); b[buf][s2] = *(const GAS bf16x8*)(bp + (st) * 256 + 32 * s2); } } while (0)
            MG_LOAD(0, 0); MG_LOAD(1, 1); MG_LOAD(2, 2);
#pragma unroll
            for (int st = 0; st < 8; ++st) if (st < ns) {
                if (gssq && st > 0 && (st & 1) == 0) { const int gi = st >> 1; acc = acc * (gi == 1 ? rg[0] / rg[1] : gi == 2 ? rg[1] / rg[2] : rg[2] / rg[3]); }
#pragma unroll
                for (int s2 = 0; s2 < 8; ++s2) acc = __builtin_amdgcn_mfma_f32_16x16x32_bf16(b[st % 3][s2], a[st % 3][s2], acc, 0, 0, 0);
                if (st + 3 < ns) MG_LOAD(st % 3, st + 3);
            }
#undef MG_LOAD
        }
        if (gssq) acc = acc * rg[3];
        E(acc, grow, 16 * cb + 4 * fq);
    }
}

DI void dt_gemm(Frame& F, const bf16* A, const bf16* Bt  , const unsigned long long* ssq, float* out  , const float* dtb  ) {
    const int NGW = F.G * NWAVES, gw = F.wave * F.G + F.vcu, fr = F.lane & 15, fq = F.lane >> 4;
    for (int u = gw; u < MV / 16; u += NGW) {
        const size_t row = (size_t)u * 16 + fr;
        const bf16* ap = A + row * DM + 8 * fq; const bf16* bp0 = Bt + (size_t)fr * DM + 8 * fq; const bf16* bp1 = bp0 + 16 * DM;
        f32x4 acc0 = (f32x4){0.f, 0.f, 0.f, 0.f}, acc1 = acc0;
        for (int k0 = 0; k0 < DM; k0 += 256) {
            bf16x8 a[8], b0[8], b1[8];
#pragma unroll
            for (int s2 = 0; s2 < 8; ++s2) { a[s2] = *(const GAS bf16x8*)(ap + k0 + 32 * s2); b0[s2] = *(const GAS bf16x8*)(bp0 + k0 + 32 * s2); b1[s2] = *(const GAS bf16x8*)(bp1 + k0 + 32 * s2); }
#pragma unroll
            for (int s2 = 0; s2 < 8; ++s2) { acc0 = __builtin_amdgcn_mfma_f32_16x16x32_bf16(b0[s2], a[s2], acc0, 0, 0, 0); acc1 = __builtin_amdgcn_mfma_f32_16x16x32_bf16(b1[s2], a[s2], acc1, 0, 0, 0); }
        }
        const float rs = 1.0f / sqrtf((float)((const GAS unsigned long long*)ssq)[row] * (1.0f / (1024.0f * 1048576.0f)) + EPS);
#pragma unroll
        for (int j = 0; j < 4; ++j) { const float x0 = acc0[j] * rs + ((const GAS float*)dtb)[4 * fq + j], x1 = acc1[j] * rs + ((const GAS float*)dtb)[16 + 4 * fq + j];
            ((GAS float*)out)[(size_t)(4 * fq + j) * MP + row] = x0 > 20.f ? x0 : log1pf(__expf(x0)); ((GAS float*)out)[(size_t)(16 + 4 * fq + j) * MP + row] = x1 > 20.f ? x1 : log1pf(__expf(x1)); }
    }
}

#define MFMA32(a, b, c) __builtin_amdgcn_mfma_f32_32x32x16_bf16((a), (b), (c), 0, 0, 0)
typedef short s16x4 __attribute__((ext_vector_type(4)));
constexpr int RS = 272;
DI bf16x8 frag_row(const LAS unsigned char* rowbase  , int ks) { return *(const LAS bf16x8*)(rowbase + ks * 32); }
DI bf16x8 frag_tr(const LAS unsigned char* trbase, int krow0, int c) {
    const s16x4 lo = __builtin_amdgcn_ds_read_tr16_b64_v4i16((LAS s16x4*)(trbase + krow0 * RS + c * 64));
    const s16x4 hi = __builtin_amdgcn_ds_read_tr16_b64_v4i16((LAS s16x4*)(trbase + (krow0 + 4) * RS + c * 64));
    return (bf16x8){lo[0], lo[1], lo[2], lo[3], hi[0], hi[1], hi[2], hi[3]};
}
DI void ssd_prompt_item(Frame& F, int i, int b, int head, float* ssqh) {
    LAS unsigned char* BM = F.lds;
    LAS unsigned char* CM = F.lds + 128 * RS;
    LAS unsigned char* LL = F.lds + 256 * RS;
    LAS unsigned char* XD = F.lds + 384 * RS;
    LAS unsigned char* SB = F.lds + 448 * RS;
    LAS unsigned char* XE = F.lds + 512 * RS;
    LAS float* DTL = (LAS float*)(F.lds + 576 * RS + 2048);
    LAS float* ACSB = (LAS float*)(F.lds + 576 * RS);
    const bf16* CONVX = (const bf16*)(F.ws + WS_CONVX); const bf16* PROJ = (const bf16*)(F.ws + WS_PROJ); const float* DT = (const float*)(F.ws + WS_DT); bf16* YG = (bf16*)(F.ws + WS_YG);
    const int w = F.wave, g = head >> 3, lb = w & 3, pb = w >> 2;
    const float Ah = -__expf(((const GAS float*)F.in[I_ALOG])[i * 32 + head]), Dh = ((const GAS float*)F.in[I_DSKIP])[i * 32 + head];
    f32x16 st;
#pragma unroll
    for (int k = 0; k < 16; ++k) st[k] = 0.f;
    for (int idx = F.tid; idx < 64 * RS / 16; idx += 512) *(LAS v4u*)(SB + idx * 16) = (v4u){0u, 0u, 0u, 0u};
    v4u vb[4], vc[4], vx[2], zt[2]; float dtx[2]; float d0 = 0.f, d1 = 0.f;
#define SSD_ISSUE(cc) do { const size_t r0_ = (size_t)b * SEQ + (size_t)(cc) * 128; \
        _Pragma("unroll") for (int i4 = 0; i4 < 4; ++i4) { const int q_ = F.tid + 512 * i4, s_ = q_ >> 4, ch_ = q_ & 15; const bf16* src_ = CONVX + (r0_ + s_) * CONVD + 2048 + g * 128 + ch_ * 8; \
            vb[i4] = *(const GAS v4u*)src_; vc[i4] = *(const GAS v4u*)(src_ + 512); } \
        _Pragma("unroll") for (int i2 = 0; i2 < 2; ++i2) { const int q_ = F.tid + 512 * i2, s_ = q_ >> 3, ch_ = q_ & 7; vx[i2] = *(const GAS v4u*)(CONVX + (r0_ + s_) * CONVD + head * 64 + ch_ * 8); \
            dtx[i2] = ((const GAS float*)DT)[(size_t)head * MP + r0_ + s_]; } \
        } while (0)
#define SSD_SCAN(cc) do { if (w == 0) { const int ln_ = F.lane; float a0 = d0 * Ah * 1.44269504089f, a1 = d1 * Ah * 1.44269504089f; \
        _Pragma("unroll") for (int o = 1; o < 64; o <<= 1) { const float t0 = __shfl_up(a0, o), t1 = __shfl_up(a1, o); if (ln_ >= o) { a0 += t0; a1 += t1; } } \
        a1 += __shfl(a0, 63); const float al_ = __shfl(a1, 63); LAS float* A_ = ACSB + ((cc) & 1) * 256; \
        A_[ln_] = a0; A_[ln_ + 64] = a1; A_[128 + ln_] = __builtin_amdgcn_exp2f(al_ - a0); A_[192 + ln_] = __builtin_amdgcn_exp2f(al_ - a1); } } while (0)
#define SSD_ISSUE_D(cc) do { const size_t r0_ = (size_t)b * SEQ + (size_t)(cc) * 128; d0 = ((const GAS float*)DT)[(size_t)head * MP + r0_ + F.lane]; d1 = ((const GAS float*)DT)[(size_t)head * MP + r0_ + 64 + F.lane]; } while (0)
#define SSD_ISSUE_Z(cc) do { const size_t r0_ = (size_t)b * SEQ + (size_t)(cc) * 128; _Pragma("unroll") for (int i2 = 0; i2 < 2; ++i2) { const int q_ = F.tid + 512 * i2; zt[i2] = *(const GAS v4u*)(PROJ + (r0_ + (q_ >> 3)) * ODD_INP + head * 64 + (q_ & 7) * 8); } } while (0)
    SSD_ISSUE(0); SSD_ISSUE_D(0); SSD_ISSUE_Z(0);
    SSD_SCAN(0);
    SSD_ISSUE_D(1);
    __syncthreads();
#define SSD_BAR() asm volatile("s_waitcnt lgkmcnt(0)\n\ts_barrier" ::: "memory")
    for (int c = 0; c < 16; ++c) {
        const size_t row0 = (size_t)b * SEQ + (size_t)c * 128;
        int tid = F.tid; asm volatile("" : "+v"(tid));
        const int lane = tid & 63, r = lane & 31, h = lane >> 5;
        LAS float* ACS = ACSB + (c & 1) * 256; LAS float* TE = ACS + 128;
#pragma unroll
        for (int i4 = 0; i4 < 4; ++i4) { const int q = tid + 512 * i4, s = q >> 4, ch = q & 15;
            *(LAS v4u*)(BM + s * RS + ch * 16) = vb[i4]; *(LAS v4u*)(CM + s * RS + ch * 16) = vc[i4]; }
        {
#pragma unroll
            for (int i2 = 0; i2 < 2; ++i2) { const int q = tid + 512 * i2, s = q >> 3, ch = q & 7;
                const float dts = dtx[i2], tes = TE[s]; float f[8]; unpack8(vx[i2], f);
                if (ch == 0) DTL[s] = dts;
#pragma unroll
                for (int j = 0; j < 8; ++j) f[j] *= dts;
                *(LAS v4u*)(XD + (s & 63) * RS + ((s >> 6) * 8 + ch) * 16) = pack8(f);
#pragma unroll
                for (int j = 0; j < 8; ++j) f[j] *= tes;
                *(LAS v4u*)(XE + (s & 63) * RS + ((s >> 6) * 8 + ch) * 16) = pack8(f); } }
        SSD_ISSUE((c + 1 < 16 ? c + 1 : 15));
        SSD_BAR();
        if (c + 1 < 16) SSD_SCAN(c + 1);
        SSD_ISSUE_D((c + 2 < 16 ? c + 2 : 15));
        const int rowoff = r * RS + 16 * h;
        const int troff = (8 * h + ((lane & 15) >> 2)) * RS + (2 * ((lane >> 4) & 1) + ((lane & 3) >> 1)) * 16 + 8 * (lane & 1);
        const int l = lb * 32 + r; const float al = ACS[l];
        const f32x16 zero16 = {0.f, 0.f, 0.f, 0.f, 0.f, 0.f, 0.f, 0.f, 0.f, 0.f, 0.f, 0.f, 0.f, 0.f, 0.f, 0.f};
#define SSD_CHAIN8(acc, first, AF, BF) do { _Pragma("unroll") for (int kb_ = 0; kb_ < 8; kb_ += 4) { bf16x8 fa_[4], fb_[4]; \
            _Pragma("unroll") for (int j_ = 0; j_ < 4; ++j_) { const int ks = kb_ + j_; fa_[j_] = AF; fb_[j_] = BF; } \
            __builtin_amdgcn_sched_barrier(0); \
            _Pragma("unroll") for (int j_ = 0; j_ < 4; ++j_) acc = MFMA32(fa_[j_], fb_[j_], (first && kb_ == 0 && j_ == 0) ? zero16 : acc); } } while (0)
#pragma unroll
        for (int bi = 0; bi < 2; ++bi) { const int sb = 2 * pb + bi;
            if (sb <= lb) {
                f32x16 cb;
                SSD_CHAIN8(cb, true, frag_row(BM + sb * 32 * RS + rowoff, ks), frag_row(CM + lb * 32 * RS + rowoff, ks));
                if (sb < lb) {
#pragma unroll
                    for (int k = 0; k < 16; ++k) { const int s0 = sb * 32 + (k & 3) + 8 * (k >> 2) + 4 * h; cb[k] = cb[k] * __builtin_amdgcn_exp2f(al - ACS[s0]); }
                } else {
#pragma unroll
                    for (int k = 0; k < 16; ++k) { const int s0 = sb * 32 + (k & 3) + 8 * (k >> 2) + 4 * h; cb[k] = cb[k] * (__builtin_amdgcn_exp2f(fminf(al - ACS[s0], 0.f)) * (s0 <= l ? 1.f : 0.f)); }
                }
#pragma unroll
                for (int q4 = 0; q4 < 4; ++q4) *(LAS v2u*)(LL + l * RS + (sb * 4 + q4) * 16 + 8 * h) = (v2u){pk2(cb[4 * q4], cb[4 * q4 + 1]), pk2(cb[4 * q4 + 2], cb[4 * q4 + 3])};
            } }
        f32x16 yo;
        SSD_CHAIN8(yo, true, frag_row(SB + pb * 32 * RS + rowoff, ks), frag_row(CM + lb * 32 * RS + rowoff, ks));
        { const float dec = __builtin_amdgcn_exp2f(ACS[127]);
#pragma unroll
          for (int k = 0; k < 16; ++k) st[k] *= dec; }
        SSD_CHAIN8(st, false, frag_tr(BM + troff, 16 * ks, lb), frag_tr(XE + troff, 16 * (ks & 3), 2 * (ks >> 2) + pb));
        SSD_BAR();
        f32x16 yd = zero16;
        for (int sbk = 0; sbk <= lb; ++sbk) { bf16x8 fx[2], fl[2];
#pragma unroll
            for (int j = 0; j < 2; ++j) { const int ks = 2 * sbk + j; fx[j] = frag_tr(XD + troff, 16 * (ks & 3), 2 * (ks >> 2) + pb); fl[j] = frag_row(LL + lb * 32 * RS + rowoff, ks); }
            __builtin_amdgcn_sched_barrier(0);
            yd = MFMA32(fx[0], fl[0], yd); yd = MFMA32(fx[1], fl[1], yd); }
#undef SSD_CHAIN8
        { const float el = __builtin_amdgcn_exp2f(al);
#pragma unroll
          for (int q4 = 0; q4 < 4; ++q4) { const int p0 = pb * 32 + 8 * q4 + 4 * h;
              *(LAS f32x4*)(BM + l * RS + p0 * 4) = (f32x4){yd[4 * q4] + el * yo[4 * q4], yd[4 * q4 + 1] + el * yo[4 * q4 + 1], yd[4 * q4 + 2] + el * yo[4 * q4 + 2], yd[4 * q4 + 3] + el * yo[4 * q4 + 3]}; } }
        SSD_BAR();
#pragma unroll
        for (int i2 = 0; i2 < 2; ++i2) { const int q = tid + 512 * i2, tk = q >> 3, c16 = q & 7;
            const f32x4 ya = *(const LAS f32x4*)(BM + tk * RS + c16 * 32), yb = *(const LAS f32x4*)(BM + tk * RS + c16 * 32 + 16);
            float xf[8], zf[8], f[8]; unpack8(*(const LAS v4u*)(XD + (tk & 63) * RS + ((tk >> 6) * 64 + c16 * 8) * 2), xf); unpack8(zt[i2], zf);
            { const float rdt = Dh * __builtin_amdgcn_rcpf(DTL[tk]);
#pragma unroll
              for (int j = 0; j < 8; ++j) xf[j] *= rdt; }
            f[0] = (ya[0] + xf[0]) * silu(zf[0]); f[1] = (ya[1] + xf[1]) * silu(zf[1]); f[2] = (ya[2] + xf[2]) * silu(zf[2]); f[3] = (ya[3] + xf[3]) * silu(zf[3]);
            f[4] = (yb[0] + xf[4]) * silu(zf[4]); f[5] = (yb[1] + xf[5]) * silu(zf[5]); f[6] = (yb[2] + xf[6]) * silu(zf[6]); f[7] = (yb[3] + xf[7]) * silu(zf[7]);
            *(GAS v4u*)(YG + (row0 + tk) * DIN + head * 64 + c16 * 8) = pack8(f);
            float sq = (f[0] * f[0] + f[1] * f[1]) + (f[2] * f[2] + f[3] * f[3]) + (f[4] * f[4] + f[5] * f[5]) + (f[6] * f[6] + f[7] * f[7]);
            sq += __shfl_xor(sq, 1); sq += __shfl_xor(sq, 2); sq += __shfl_xor(sq, 4);
            if (c16 == 0) ((GAS float*)ssqh)[(size_t)head * MP + row0 + tk] = sq; }
        SSD_ISSUE_Z((c + 1 < 16 ? c + 1 : 15));
        SSD_BAR();
        { const int p = pb * 32 + r;
#pragma unroll
          for (int q4 = 0; q4 < 4; ++q4) *(LAS v2u*)(SB + p * RS + (lb * 4 + q4) * 16 + 8 * h) = (v2u){pk2(st[4 * q4], st[4 * q4 + 1]), pk2(st[4 * q4 + 2], st[4 * q4 + 3])}; }
    }
#undef SSD_BAR
#undef SSD_ISSUE
#undef SSD_ISSUE_Z
#undef SSD_ISSUE_D
#undef SSD_SCAN
    { const int r = F.lane & 31, h = F.lane >> 5; const int p = pb * 32 + r; float* so = F.out + OUT_SP + (((size_t)(i * NBATCH + b) * NHEAD + head) * 64 + p) * 128;
#pragma unroll
      for (int q4 = 0; q4 < 4; ++q4) { const int n0 = lb * 32 + 8 * q4 + 4 * h; *(GAS f32x4*)(so + n0) = (f32x4){st[4 * q4], st[4 * q4 + 1], st[4 * q4 + 2], st[4 * q4 + 3]}; } }
    __syncthreads();
}
DI void ssd_sample(Frame& F, int i, float* ssqh) {
    const bf16* CONVX = (const bf16*)(F.ws + WS_CONVX); const bf16* PROJ = (const bf16*)(F.ws + WS_PROJ); const float* DT = (const float*)(F.ws + WS_DT); bf16* YG = (bf16*)(F.ws + WS_YG);
    const int gw = F.vcu * NWAVES + F.wave, NGW = F.G * NWAVES, psub = F.lane >> 5, n4 = (F.lane & 31) * 4;
    for (int it = gw; it < NSMP * NHEAD; it += NGW) {
        const int b = it >> 5, head = it & 31, g = head >> 3; const size_t row = TP + b;
        const size_t sbase = (((size_t)(i * NSMP + b) * NHEAD + head) * 64) * 128 + n4;
        const float* sin = F.in[I_SSSM] + sbase + (size_t)psub * 128; float* sout = F.out + OUT_SS + sbase + (size_t)psub * 128;
        f32x4 s0[32];
#pragma unroll
        for (int pp = 0; pp < 32; ++pp) s0[pp] = *(const GAS f32x4*)(sin + (size_t)pp * 256);
        const float dt = ((const GAS float*)DT)[(size_t)head * MP + row], Ah = -__expf(((const GAS float*)F.in[I_ALOG])[i * 32 + head]), Dh = ((const GAS float*)F.in[I_DSKIP])[i * 32 + head];
        const float dA = __expf(dt * Ah);
        const v2u bw = *(const GAS v2u*)(CONVX + row * CONVD + 2048 + g * 128 + n4), cw = *(const GAS v2u*)(CONVX + row * CONVD + 2560 + g * 128 + n4);
        const f32x4 B4 = (f32x4){bflo(bw.x), bfhi(bw.x), bflo(bw.y), bfhi(bw.y)}, C4 = (f32x4){bflo(cw.x), bfhi(cw.x), bflo(cw.y), bfhi(cw.y)};
        const float xl = bf1(((const GAS bf16*)CONVX)[row * CONVD + head * 64 + F.lane]), zl = bf1(((const GAS bf16*)PROJ)[row * ODD_INP + head * 64 + F.lane]);
        float sq = 0.f;
#pragma unroll
        for (int pp = 0; pp < 32; ++pp) { const int p = 2 * pp + psub;
            const float xe = __shfl(xl, 2 * pp), xo = __shfl(xl, 2 * pp + 1), xv = psub ? xo : xe, dx = dt * xv;
            const f32x4 sn = s0[pp] * dA + B4 * dx; *(GAS f32x4*)(sout + (size_t)pp * 256) = sn;
            float d = (sn[0] * C4[0] + sn[1] * C4[1]) + (sn[2] * C4[2] + sn[3] * C4[3]);
#pragma unroll
            for (int o = 1; o < 32; o <<= 1) d += __shfl_xor(d, o);
            const float ze = __shfl(zl, 2 * pp), zo = __shfl(zl, 2 * pp + 1), z = psub ? zo : ze;
            if ((F.lane & 31) == 0) { const float yv = (d + Dh * xv) * silu(z); sq += yv * yv; ((GAS bf16*)YG)[row * DIN + head * 64 + p] = (bf16)f2bf(yv); } }
        sq += __shfl_xor(sq, 32);
        if (F.lane == 0) ((GAS float*)ssqh)[(size_t)head * MP + row] = sq;
    }
}

#if MK_PER_PHASE
#define GRID_BAR() do { } while (0)
#else
#define GRID_BAR() do { for (int rb_ = 0; rb_ < REP_BAR; ++rb_) xcd_barrier(bar); } while (0)
#endif
#ifdef DBG_ONLY
#define IN(k) (lo <= (k) && (k) < hi && ((((k) < 2) ? (k) : 2 + ((k) - 2) % 11) == DBG_ONLY))
#else
#define IN(k) (lo <= (k) && (k) < hi)
#endif
#ifndef AMP_MASK
#define AMP_MASK 0
#endif
#if AMP_MASK
#define AMP_CLS(k) ((k) < 2 ? (k) : ((((k) - 2) % 11) == 0 ? 2 : (((k) - 2) % 11) == 1 ? 3 : (((k) - 2) % 11) == 2 ? 4 : (((k) - 2) % 11) == 4 ? 5 : (((k) - 2) % 11) == 6 ? 6 : (((k) - 2) % 11) == 7 ? 7 : (((k) - 2) % 11) == 9 ? 8 : 9))
#undef IN
#define IN(k) (lo <= (k) && (k) < hi && ((amp_t0 = __builtin_amdgcn_s_memrealtime()), true))
#define AMP_END(k) do { if ((AMP_MASK >> AMP_CLS(k)) & 1) { __syncthreads(); const unsigned long long t1_ = __builtin_amdgcn_s_memrealtime(); const unsigned long long d_ = t1_ - amp_t0; while (__builtin_amdgcn_s_memrealtime() - t1_ < d_) __builtin_amdgcn_s_sleep(4); } } while (0)
#else
#define AMP_END(k) do { } while (0)
#endif
#if AMP_MASK
#define AMP_SUB_BEGIN() unsigned long long amp_s0 = __builtin_amdgcn_s_memrealtime()
#define AMP_SUB_END(cls) do { if ((AMP_MASK >> (cls)) & 1) { __syncthreads(); const unsigned long long t1_ = __builtin_amdgcn_s_memrealtime(); const unsigned long long d_ = t1_ - amp_s0; while (__builtin_amdgcn_s_memrealtime() - t1_ < d_) __builtin_amdgcn_s_sleep(4); } } while (0)
#else
#define AMP_SUB_BEGIN() do { } while (0)
#define AMP_SUB_END(cls) do { } while (0)
#endif
#define SEAM(k) do { AMP_END(k); if ((k) + 1 < hi) GRID_BAR(); } while (0)
#define REFRESH() do { int t_ = threadIdx.x; asm volatile("" : "+v"(t_)); F.tid = t_; F.lane = t_ & 63; } while (0)
constexpr int PH_PER_LAYER = 11, PH_LAYER0 = 2, N_PHASES = PH_LAYER0 + 4 * PH_PER_LAYER;
template <int l> DI void layer_phases(Frame& F, const int lo, const int hi, const XcdBarrier& bar) {
#if AMP_MASK
    unsigned long long amp_t0 = 0;
#endif
    unsigned char* ws = F.ws;
    LAS unsigned char* ring = F.lds;
    bf16* H = (bf16*)(ws + WS_H); bf16* Qb = (bf16*)(ws + WS_Q); bf16* Pb = (bf16*)(ws + WS_PB); bf16* Ob = (bf16*)(ws + WS_O); bf16* DIFF = (bf16*)(ws + WS_DIFF);
    bf16* MIX = (bf16*)(ws + WS_MIX); bf16* PROJ = (bf16*)(ws + WS_PROJ);
    const int c = (int)blockIdx.x;

    constexpr int pb = PH_LAYER0 + l * PH_PER_LAYER, i = l >> 1; constexpr bool evn = (l & 1) == 0;
    unsigned long long* SSQ = (unsigned long long*)(ws + WS_SSQ);
    constexpr size_t SSQ_I = (size_t)MV;
        if (IN(pb + 0)) {
            constexpr int N = evn ? EVEN_IN : ODD_INP;
            pg8::Gemm g{H, evn ? (const bf16*)(ws + WS_WTE_IN) + (size_t)i * EVEN_IN * DM : (const bf16*)(ws + WS_WTO_IN) + (size_t)i * ODD_WROWS * DM, DM, DM, DM};
            pg8::StaticOrder S; S.init(64, N / 256, F.G, c);
            if constexpr (evn) { pg8::EpiEvenIn E{PROJ, SSQ + (2 * l) * SSQ_I};
                for (int rep = 0; rep < REP_G1; ++rep) pg8::gemm_phase<pg8::EpiEvenIn, pg8::AddrStd, true, true>(ring, g, S, E, pg8::AddrStd{}); }
            else { pg8::EpiBf16S E{PROJ, N, SSQ + (2 * l) * SSQ_I};
                for (int rep = 0; rep < REP_G1; ++rep) pg8::gemm_phase<pg8::EpiBf16S, pg8::AddrStd, true, true>(ring, g, S, E, pg8::AddrStd{}); }
            REFRESH();
            if constexpr (evn) {
                const bf16* WTU = (const bf16*)(ws + WS_WTU) + (size_t)i * DM * DM;
                for (int rep = 0; rep < REP_MINI; ++rep) {
                bf16* PS = PROJ + (size_t)TP * EVEN_P - (size_t)TP * EVEN_IN;
                mini_gemm<16>(F, H, DM, WTU, DM, DM, 64, MiniBf16{PS, N, SSQ + (2 * l) * SSQ_I}, 0);
                mini_gemm<16>(F, H, DM, g.Bt + (size_t)1024 * DM, DM, DM, (N - 1024) / 16, MiniBf16{PS + 1024, N, SSQ + (2 * l) * SSQ_I}, 64);
                mini_gemm<16>(F, H, DM, WTU, DM, DM, 64, MiniPoolState{F.out + OUT_PP + (size_t)i * NBATCH * 15 * DM, SSQ + (2 * l) * SSQ_I}, 128, nullptr, SEQ - 16, SEQ); }
            } else {
                for (int rep = 0; rep < REP_MINI; ++rep) mini_gemm<16>(F, H, DM, g.Bt, DM, DM, N / 16, MiniBf16{PROJ, N, SSQ + (2 * l) * SSQ_I}, 0);
                dt_gemm(F, H, g.Bt + (size_t)ODD_INP * DM, SSQ + (2 * l) * SSQ_I, (float*)(ws + WS_DT), F.in[I_DTB] + (size_t)i * 32);
            }
            SEAM(pb + 0);
        }
        if (IN(pb + 1)) { REFRESH(); for (int rep = 0; rep < REP_THIN; ++rep) { if constexpr (evn) t_even_mix(F, i); else t_conv(F, i); } SEAM(pb + 1); }
        if constexpr (!evn) if (IN(pb + 2)) {
                REFRESH();
                const bool stream_first = (F.vcu & 1) != 0;
                if (stream_first) { for (int rep = 0; rep < REP_SSDS; ++rep) ssd_sample(F, i, rep == 0 ? (float*)(ws + WS_SSQH) + (size_t)i * 32 * MP : (float*)(ws + WS_DIFF)); __syncthreads(); }
                for (int rep = 0; rep < REP_SSD; ++rep) for (int it = F.vcu; it < NBATCH * NHEAD; it += F.G) ssd_prompt_item(F, i, it >> 5, it & 31, rep == 0 ? (float*)(ws + WS_SSQH) + (size_t)i * 32 * MP : (float*)(ws + WS_DIFF));
                if (!stream_first) { REFRESH(); for (int rep = 0; rep < REP_SSDS; ++rep) ssd_sample(F, i, rep == 0 ? (float*)(ws + WS_SSQH) + (size_t)i * 32 * MP : (float*)(ws + WS_DIFF)); }
            SEAM(pb + 2);
        }
        if (IN(pb + 4)) {
            bf16* YGb = (bf16*)(ws + WS_YG); const float* GSSQ = (const float*)(ws + WS_SSQH) + (size_t)i * 32 * MP;
            pg8::Gemm g{evn ? MIX : YGb, evn ? (const bf16*)(ws + WS_WTE_OUT) + (size_t)i * DM * 2048 : (const bf16*)(ws + WS_WTO_OUT) + (size_t)i * DM * 2048, DIN, DIN, DIN};
            pg8::StaticOrder S; S.init(64, 4, F.G, c);
            pg8::EpiResAdd E{H, SSQ + (2 * l + 1) * SSQ_I, 0};
            pg8::EpiResAdd E0{H, SSQ, hi > 9999 ? 0 : 1};
            if constexpr (evn) {
                for (int rep = 1; rep < REP_RES; ++rep) pg8::gemm_phase<pg8::EpiResAdd, pg8::AddrStd, true, true>(ring, g, S, E0, pg8::AddrStd{});
                pg8::gemm_phase<pg8::EpiResAdd, pg8::AddrStd, true, true>(ring, g, S, E, pg8::AddrStd{});
                REFRESH(); mini_gemm<16>(F, MIX, DIN, g.Bt, DIN, DIN, 64, MiniResAdd{H, SSQ + (2 * l + 1) * SSQ_I}, 0);
            } else {
                for (int rep = 1; rep < REP_RES; ++rep) pg8::gemm_phase<pg8::EpiResAdd, pg8::AddrStd, true, true, true>(ring, g, S, E0, pg8::AddrStd{}, GSSQ);
                pg8::gemm_phase<pg8::EpiResAdd, pg8::AddrStd, true, true, true>(ring, g, S, E, pg8::AddrStd{}, GSSQ);
                REFRESH(); mini_gemm<16>(F, YGb, DIN, g.Bt, DIN, DIN, 64, MiniResAdd{H, SSQ + (2 * l + 1) * SSQ_I}, 0, GSSQ);
            }
            SEAM(pb + 4);
        }
        if (IN(pb + 6)) {
            pg8::Gemm g{H, (const bf16*)(ws + WS_WTQ) + (size_t)l * DM * DM, DM, DM, DM};
            pg8::StaticOrder S; S.init(64, 4, F.G, c);
            pg8::EpiBf16S E{Qb, DM, SSQ + (2 * l + 1) * SSQ_I};
            for (int rep = 0; rep < REP_G4; ++rep) pg8::gemm_phase<pg8::EpiBf16S, pg8::AddrStd, true, true>(ring, g, S, E, pg8::AddrStd{});
            REFRESH(); for (int rep = 0; rep < REP_MINI; ++rep) mini_gemm<16>(F, H, DM, g.Bt, DM, DM, 64, MiniBf16{Qb, DM, SSQ + (2 * l + 1) * SSQ_I}, 0);
            SEAM(pb + 6);
        }
        if (IN(pb + 7)) {
            const bool stream_first = (F.vcu & 1) != 0;
            if (stream_first) { REFRESH(); AMP_SUB_BEGIN(); for (int rep = 0; rep < REP_SATTN; ++rep) t_sattn(F, l); __syncthreads(); AMP_SUB_END(10); }
            { pg8::Gemm g{Qb, (const bf16*)(ws + WS_KB) + (size_t)l * 2048 * DM, DM, DM, 256};
              pg8::StaticOrder S; S.init(64, 4, F.G, c);
              pg8::EpiSoftmax E{Pb, DM, 0.0625f * 1.44269504089f};
              for (int rep = 0; rep < REP_G5; ++rep) { pg8::gemm_phase<pg8::EpiSoftmax, pg8::AddrScore, false, true>(ring, g, S, E, pg8::AddrScore{}); __syncthreads(); } }
            asm volatile("s_waitcnt vmcnt(0)" ::: "memory"); __syncthreads();
            { pg8::Gemm g{Pb, (const bf16*)(ws + WS_VT) + (size_t)l * 8 * 1024 * 256, DM, 256, 256};
              pg8::StaticOrder S; S.init(64, 4, F.G, c);
              pg8::EpiBf16S E{Ob, DM, nullptr};
              for (int rep = 0; rep < REP_G6; ++rep) pg8::gemm_phase<pg8::EpiBf16S, pg8::AddrPV, true, true>(ring, g, S, E, pg8::AddrPV{}); }
            __syncthreads();
            if (!stream_first) { REFRESH(); AMP_SUB_BEGIN(); for (int rep = 0; rep < REP_SATTN; ++rep) t_sattn(F, l); AMP_SUB_END(10); }
            SEAM(pb + 7);
        }
        if (IN(pb + 9)) {
            pg8::Gemm g{Ob, (const bf16*)(ws + WS_WTO) + (size_t)l * DM * DM, DM, DM, DM};
            pg8::StaticOrder S; S.init(64, 4, F.G, c);
            pg8::EpiResAdd E{H, SSQ + (2 * l + 2) * SSQ_I, 0};
            for (int rep = 1; rep < REP_RES; ++rep) { pg8::EpiResAdd E0{H, SSQ, hi > 9999 ? 0 : 1}; pg8::gemm_phase<pg8::EpiResAdd, pg8::AddrStd, true, true>(ring, g, S, E0, pg8::AddrStd{}); }
            pg8::gemm_phase<pg8::EpiResAdd, pg8::AddrStd, true, true>(ring, g, S, E, pg8::AddrStd{});
            REFRESH(); mini_gemm<16>(F, Ob, DM, g.Bt, DM, DM, 64, MiniResAdd{H, SSQ + (2 * l + 2) * SSQ_I}, 0);
            SEAM(pb + 9);
        }
        if constexpr (l == 3) if (IN(pb + 10)) { REFRESH(); t_norm(F, F.in[I_NFIN], true); SEAM(pb + 10); }
}
__global__ void __launch_bounds__(NWAVES * 64, 2) trunk_fwd(Args args) {
    extern __shared__ __attribute__((aligned(16))) unsigned char lds[];
    Frame F;
    F.lds = (LAS unsigned char*)lds;
    F.tid = threadIdx.x; F.lane = F.tid & 63; F.wave = __builtin_amdgcn_readfirstlane(F.tid >> 6);
    F.G = gridDim.x; { const int bx = blockIdx.x; F.vcu = (F.G % 8 == 0) ? (bx % 8) * (F.G / 8) + bx / 8 : bx; }
    F.in = args.in; F.out = args.out; F.ws = args.ws;
    unsigned char* ws = args.ws;
    volatile LAS unsigned* MISC = (volatile LAS unsigned*)(F.lds + MISC_OFF);
    if (F.tid < 32) MISC[F.tid] = 0u;
    __syncthreads();
#if MK_PER_PHASE
    XcdBarrier bar; bar.bar = (unsigned*)(ws + WS_CTL) + CW_BAR; bar.x = 0; bar.st = MISC + 8;
#else
    XcdBarrier bar = xcd_barrier_post((unsigned*)(ws + WS_CTL) + CW_BAR, MISC + 8);
#endif
    const int lo = args.ph_lo, hi = args.ph_hi;
    LAS unsigned char* ring = F.lds;
    const int c = (int)blockIdx.x;

#if AMP_MASK
    unsigned long long amp_t0 = 0;
#endif
    if (IN(0)) { REFRESH(); for (int rep = 0; rep < REP_P0; ++rep) p0_prologue(F); SEAM(0); }
    if (IN(1)) {
        for (int rep = 0; rep < REP_P1; ++rep) {
        { pg8::Gemm g{(const bf16*)(ws + WS_MEMB), (const bf16*)(ws + WS_WTK), DM, DM, DM}; pg8::StaticOrder S; S.init(8, 16, F.G, c);
          pg8::EpiKproj E{F.out + OUT_MK, (bf16*)(ws + WS_KB)};
          pg8::gemm_phase<pg8::EpiKproj, pg8::AddrStd, true, true>(ring, g, S, E, pg8::AddrStd{}); }
        { pg8::Gemm g{(const bf16*)(ws + WS_WTV), (const bf16*)(ws + WS_MEMB), DM, DM, DM}; pg8::StaticOrder S; S.init(16, 8, F.G, (c + F.G / 2) % F.G);
          pg8::EpiVT E{F.out + OUT_MV, (bf16*)(ws + WS_VT)};
          pg8::gemm_phase<pg8::EpiVT, pg8::AddrStd, true, true>(ring, g, S, E, pg8::AddrStd{}); }
        }
        SEAM(1);
    }
    layer_phases<0>(F, lo, hi, bar); layer_phases<1>(F, lo, hi, bar); layer_phases<2>(F, lo, hi, bar); layer_phases<3>(F, lo, hi, bar);
#undef IN
#undef SEAM
}

extern "C" void kernel_launch(void* const* d_in, const int* in_sizes, int n_in, void* d_out, int out_size, void* d_ws, size_t ws_size, hipStream_t stream) {
    static int grid = 0;
    if (grid == 0) {
        if (n_in != 29 || (size_t)out_size != OUT_TOTAL || ws_size < WS_END) { fprintf(stderr, "kernel_launch: unexpected shapes: n_in %d out %d ws %zu (need %zu)\n", n_in, out_size, ws_size, (size_t)WS_END); grid = -1; return; }
        if (hipFuncSetAttribute((const void*)trunk_fwd, hipFuncAttributeMaxDynamicSharedMemorySize, LDS_BYTES) != hipSuccess) { fprintf(stderr, "kernel_launch: hipFuncSetAttribute failed\n"); grid = -1; return; }
        int dev = 0, cus = 0;
        if (hipGetDevice(&dev) != hipSuccess || hipDeviceGetAttribute(&cus, hipDeviceAttributeMultiprocessorCount, dev) != hipSuccess) { grid = -1; return; }
        (void)hipGetLastError();
        grid = cus < 256 ? cus : 256;
        if (grid != 256) fprintf(stderr, "kernel_launch: %d CUs; this kernel is built for a 256-CU grid\n", cus);
    }
    if (grid < 0) return;
    (void)hipMemsetAsync((char*)d_ws + WS_CTL, 0, CTL_ZERO_BYTES, stream);
    Args a{};
    for (int i = 0; i < 29; ++i) a.in[i] = (const float*)d_in[i];
    a.out = (float*)d_out; a.ws = (unsigned char*)d_ws;
#if MK_PER_PHASE
    for (int p = 0; p < N_PHASES; ++p) {
        if (p >= PH_LAYER0) { const int l = (p - PH_LAYER0) / PH_PER_LAYER, k = (p - PH_LAYER0) % PH_PER_LAYER; if (k == 3 || k == 5 || k == 8 || (k == 2 && (l & 1) == 0) || (k == 10 && l != 3)) continue; }
        a.ph_lo = p; a.ph_hi = p + 1;
        hipLaunchKernelGGL(trunk_fwd, dim3(grid), dim3(NWAVES * 64), LDS_BYTES, stream, a);
    }
#else
    a.ph_lo = 0; a.ph_hi = N_PHASES;
    hipLaunchKernelGGL(trunk_fwd, dim3(grid), dim3(NWAVES * 64), LDS_BYTES, stream, a);
#endif
}
```

```cpp
#include <hip/hip_runtime.h>
#include <cstdio>
#include <cstdint>

#ifndef REP_SSD
#define REP_SSD 1
#endif
#ifndef REP_SSDS
#define REP_SSDS 1
#endif
#ifndef REP_SATTN
#define REP_SATTN 1
#endif
#ifndef REP_THIN
#define REP_THIN 1
#endif
#ifndef REP_G1
#define REP_G1 1
#endif
#ifndef REP_G2
#define REP_G2 1
#endif
#ifndef REP_G4
#define REP_G4 1
#endif
#ifndef REP_G5
#define REP_G5 1
#endif
#ifndef REP_G6
#define REP_G6 1
#endif
#ifndef REP_P1
#define REP_P1 1
#endif
#ifndef REP_RES
#define REP_RES 1
#endif
#ifndef REP_BAR
#define REP_BAR 1
#endif
#ifndef REP_MINI
#define REP_MINI 1
#endif
#ifndef REP_P0
#define REP_P0 1
#endif
#ifndef MK_PER_PHASE
#define MK_PER_PHASE 0
#endif

namespace pg8 {
#define PG8_LAS __attribute__((address_space(3)))
typedef unsigned short bf16_t;
typedef short bf16x8 __attribute__((ext_vector_type(8)));
typedef float f32x4 __attribute__((ext_vector_type(4)));
typedef unsigned u32x4 __attribute__((ext_vector_type(4)));
typedef unsigned u32x2 __attribute__((ext_vector_type(2)));
constexpr int BM = 256, BK = 64, HALF = 128, HTB = HALF * BK * 2  , STAGE_BYTES = 8 * HTB, NXCD = 8, WGM = 8;

__host__ __device__ __forceinline__ int lds_byte(int r, int c) { const int st = (r >> 4) * 2 + (c >> 5), rr = r & 15, cc = c & 31, ob = rr * 64 + cc * 2; return st * 1024 + (ob ^ (((ob >> 9) & 1) << 5)); }
__host__ __device__ __forceinline__ void stage_rc(int b, int& R, int& C) { const int st = b / 1024, sb = b % 1024, swz = sb ^ (((sb >> 9) & 1) << 5); R = (st >> 1) * 16 + swz / 64; C = (st & 1) * 32 + (swz % 64) / 2; }
__host__ __device__ __forceinline__ int perm32(int rho) { const int n = rho >> 4, i = rho & 15; return 8 * (i >> 2) + 4 * n + (i & 3); }

struct Unit { int pm, pn; };
struct Gemm { const bf16_t* A; const bf16_t* Bt; int lda, ldb, K; };

struct StaticOrder {
    int nM, nN, nwg, G, c;
    __host__ __device__ void init(int nM_, int nN_, int G_, int c_) { nM = nM_; nN = nN_; nwg = nM * nN; G = G_; c = c_; }
    __host__ __device__ bool next(int i, Unit& u) const {
        const long L = (long)i * G + c; if (L >= nwg) return false;
        int wgid = (int)L; { const int q = nwg / NXCD, r = nwg % NXCD, xcd = wgid % NXCD, off = wgid / NXCD; wgid = (xcd < r ? xcd * (q + 1) : r * (q + 1) + (xcd - r) * q) + off; }
        const int nig = WGM * nN, gid = wgid / nig, fm = gid * WGM, gsz = (nM - fm) < WGM ? (nM - fm) : WGM;
        u.pm = fm + ((wgid % nig) % gsz); u.pn = (wgid % nig) / gsz; return true;
    }
};
struct AddrStd  { __device__ __forceinline__ size_t a(const Unit& u, const Gemm& g) const { return (size_t)u.pm * 256 * g.lda; }
                  __device__ __forceinline__ size_t b(const Unit& u, const Gemm& g) const { return (size_t)u.pn * 256 * g.ldb; } };
struct AddrColA { __device__ __forceinline__ size_t a(const Unit& u, const Gemm& g) const { return (size_t)u.pm * 256 * g.lda + (size_t)u.pn * 256; }
                  __device__ __forceinline__ size_t b(const Unit& u, const Gemm& g) const { return (size_t)u.pn * 256 * g.ldb; } };
struct AddrScore { __device__ __forceinline__ size_t a(const Unit& u, const Gemm& g) const { return (size_t)u.pm * 256 * g.lda + (size_t)u.pn * 256; }
                   __device__ __forceinline__ size_t b(const Unit& u, const Gemm& g) const { return (size_t)(u.pm >> 3) * 256 * g.ldb + (size_t)u.pn * 256; } };
struct AddrPV   { __device__ __forceinline__ size_t a(const Unit& u, const Gemm& g) const { return (size_t)u.pm * 256 * g.lda + (size_t)u.pn * 256; }
                  __device__ __forceinline__ size_t b(const Unit& u, const Gemm& g) const { return ((size_t)(u.pm >> 3) * 1024 + (size_t)u.pn * 256) * 256; } };

__device__ __forceinline__ unsigned cvt_pk_bf16(float lo, float hi) { unsigned r; asm volatile("v_cvt_pk_bf16_f32 %0, %1, %2" : "=v"(r) : "v"(lo), "v"(hi)); return r; }
__device__ __forceinline__ float bf_lo(unsigned w) { return __uint_as_float(w << 16); }
__device__ __forceinline__ float bf_hi(unsigned w) { return __uint_as_float(w & 0xffff0000u); }
__device__ __forceinline__ float silu_f(float z) { return z * __builtin_amdgcn_rcpf(1.0f + __builtin_amdgcn_exp2f(-1.44269504089f * z)); }

struct EpiBf16S {
    static constexpr bool PERM = true, AFTER_DRAIN = false;
    bf16_t* O; int ldc; const unsigned long long* ssq;
    __device__ __forceinline__ void operator()(const f32x4 (&acc)[2][2][4][2], const Unit& u, int wr, int wc, int fr, int fq) const {
        const int row0 = u.pm * BM + wr * 64 + fr, col0 = u.pn * BM + wc * 32 + 8 * fq;
        unsigned long long sv[2][4];
        if (ssq) {
#pragma unroll
            for (int ai = 0; ai < 2; ++ai)
#pragma unroll
                for (int m = 0; m < 4; ++m) sv[ai][m] = ssq[row0 + ai * HALF + m * 16]; }
#pragma unroll
        for (int ai = 0; ai < 2; ++ai)
#pragma unroll
            for (int m = 0; m < 4; ++m) { const size_t row = (size_t)(row0 + ai * HALF + m * 16); bf16_t* rowp = O + row * ldc + col0;
                float rs = 1.0f;
                if (ssq) rs = __builtin_amdgcn_rsqf((float)sv[ai][m] * (1.0f / (1024.0f * 1048576.0f)) + 1e-6f);
#pragma unroll
                for (int bj = 0; bj < 2; ++bj) { const f32x4 v0 = acc[ai][bj][m][0] * rs, v1 = acc[ai][bj][m][1] * rs;
                    u32x4 w; w.x = cvt_pk_bf16(v0[0], v0[1]); w.y = cvt_pk_bf16(v0[2], v0[3]); w.z = cvt_pk_bf16(v1[0], v1[1]); w.w = cvt_pk_bf16(v1[2], v1[3]);
                    *(u32x4*)(rowp + bj * HALF) = w; } }
    }
};
struct EpiEvenIn {
    static constexpr bool PERM = true, AFTER_DRAIN = false;
    bf16_t* O; const unsigned long long* ssq;
    __device__ __forceinline__ void operator()(const f32x4 (&acc)[2][2][4][2], const Unit& u, int wr, int wc, int fr, int fq) const {
        const int row0 = u.pm * BM + wr * 64 + fr, cw = wc * 32 + 8 * fq;
        unsigned long long sv[2][4];
#pragma unroll
        for (int ai = 0; ai < 2; ++ai)
#pragma unroll
            for (int m = 0; m < 4; ++m) sv[ai][m] = ssq[row0 + ai * HALF + m * 16];
#pragma unroll
        for (int ai = 0; ai < 2; ++ai)
#pragma unroll
            for (int m = 0; m < 4; ++m) { const size_t row = (size_t)(row0 + ai * HALF + m * 16); bf16_t* rowp = O + row * 4096;
                const float rs = __builtin_amdgcn_rsqf((float)sv[ai][m] * (1.0f / (1024.0f * 1048576.0f)) + 1e-6f);
                if (u.pn < 8) {
#pragma unroll
                    for (int bj = 0; bj < 2; ++bj) { const f32x4 v0 = acc[ai][bj][m][0] * rs, v1 = acc[ai][bj][m][1] * rs;
                        u32x4 w; w.x = cvt_pk_bf16(v0[0], v0[1]); w.y = cvt_pk_bf16(v0[2], v0[3]); w.z = cvt_pk_bf16(v1[0], v1[1]); w.w = cvt_pk_bf16(v1[2], v1[3]);
                        *(u32x4*)(rowp + u.pn * BM + cw + bj * HALF) = w; }
                } else {
                    float o[8];
#pragma unroll
                    for (int n = 0; n < 2; ++n)
#pragma unroll
                        for (int j = 0; j < 4; ++j) { const float a = acc[ai][0][m][n][j] * rs, b = acc[ai][1][m][n][j] * rs;
                            o[4 * n + j] = u.pn < 16 ? a * b : a * (b * __builtin_amdgcn_rcpf(1.0f + __builtin_amdgcn_exp2f(-1.44269504089f * b))); }
                    u32x4 w; w.x = cvt_pk_bf16(o[0], o[1]); w.y = cvt_pk_bf16(o[2], o[3]); w.z = cvt_pk_bf16(o[4], o[5]); w.w = cvt_pk_bf16(o[6], o[7]);
                    *(u32x4*)(rowp + 2048 + (u.pn - 8) * HALF + cw) = w; } }
    }
};
struct EpiResAdd {
    static constexpr bool PERM = true, AFTER_DRAIN = false;
    bf16_t* Xb; unsigned long long* ssq; int dry;
    __device__ __forceinline__ void row_update(const f32x4 (&acc)[2][2][4][2], int ai, int m, const u32x4 (&w)[2], bf16_t* rowp, size_t row, int fq) const {
        float sq = 0.f;
#pragma unroll
        for (int bj = 0; bj < 2; ++bj) { const unsigned int ww[4] = {w[bj].x, w[bj].y, w[bj].z, w[bj].w}; float o[8];
#pragma unroll
            for (int e = 0; e < 4; ++e) { o[2 * e] = __uint_as_float(ww[e] << 16) + acc[ai][bj][m][e >> 1][2 * (e & 1)]; o[2 * e + 1] = __uint_as_float(ww[e] & 0xffff0000u) + acc[ai][bj][m][e >> 1][2 * (e & 1) + 1]; }
#pragma unroll
            for (int e = 0; e < 8; e += 2) sq += o[e] * o[e] + o[e + 1] * o[e + 1];
            u32x4 v; v.x = cvt_pk_bf16(o[0], o[1]); v.y = cvt_pk_bf16(o[2], o[3]); v.z = cvt_pk_bf16(o[4], o[5]); v.w = cvt_pk_bf16(o[6], o[7]);
            *(u32x4*)(rowp + bj * HALF) = v; }
        sq += __shfl_xor(sq, 16); sq += __shfl_xor(sq, 32);
        if (fq == 0) atomicAdd(ssq + row, (unsigned long long)(sq * 1048576.0f));
    }
    __device__ __forceinline__ void operator()(const f32x4 (&acc)[2][2][4][2], const Unit& u, int wr, int wc, int fr, int fq) const {
        if (dry) return;
        const int row0 = u.pm * BM + wr * 64 + fr, col0 = u.pn * BM + wc * 32 + 8 * fq;
        u32x4 w[4][2][2];
#define RA_LOAD(p) do { _Pragma("unroll") for (int r = 0; r < 2; ++r) _Pragma("unroll") for (int bj = 0; bj < 2; ++bj) \
            w[(p) & 3][r][bj] = *(const u32x4*)(Xb + (size_t)(row0 + ((p) >> 1) * HALF + (2 * ((p) & 1) + r) * 16) * 1024 + col0 + bj * HALF); } while (0)
        RA_LOAD(0); RA_LOAD(1);
#pragma unroll
        for (int p = 0; p < 4; ++p) {
            if (p + 2 < 4) RA_LOAD(p + 2);
#pragma unroll
            for (int r = 0; r < 2; ++r) { const int ai = p >> 1, m = 2 * (p & 1) + r; const size_t row = (size_t)(row0 + ai * HALF + m * 16);
                row_update(acc, ai, m, w[p & 3][r], Xb + row * 1024 + col0, row, fq); }
            asm volatile("" ::: "memory"); }
#undef RA_LOAD
    }
};
struct EpiPoolGate {
    static constexpr bool PERM = true, AFTER_DRAIN = false;
    bf16_t* O; int ldc; const bf16_t* gate; int ldg; const float* scale;
    __device__ __forceinline__ void operator()(const f32x4 (&acc)[2][2][4][2], const Unit& u, int wr, int wc, int fr, int fq) const {
        const int row0 = u.pm * BM + wr * 64 + fr, col0 = u.pn * BM + wc * 32 + 8 * fq;
        f32x4 sc[2][2];
#pragma unroll
        for (int bj = 0; bj < 2; ++bj)
#pragma unroll
            for (int n = 0; n < 2; ++n) sc[bj][n] = *(const f32x4*)(scale + col0 + bj * HALF + 4 * n);
#pragma unroll
        for (int ai = 0; ai < 2; ++ai)
#pragma unroll
            for (int m = 0; m < 4; ++m) { const size_t row = (size_t)(row0 + ai * HALF + m * 16);
#pragma unroll
                for (int bj = 0; bj < 2; ++bj) { const u32x4 gw = *(const u32x4*)(gate + row * ldg + col0 + bj * HALF);
                    const f32x4 v0 = acc[ai][bj][m][0] * sc[bj][0], v1 = acc[ai][bj][m][1] * sc[bj][1];
                    u32x4 w; w.x = cvt_pk_bf16(v0[0] * silu_f(bf_lo(gw.x)), v0[1] * silu_f(bf_hi(gw.x))); w.y = cvt_pk_bf16(v0[2] * silu_f(bf_lo(gw.y)), v0[3] * silu_f(bf_hi(gw.y)));
                    w.z = cvt_pk_bf16(v1[0] * silu_f(bf_lo(gw.z)), v1[1] * silu_f(bf_hi(gw.z))); w.w = cvt_pk_bf16(v1[2] * silu_f(bf_lo(gw.w)), v1[3] * silu_f(bf_hi(gw.w)));
                    *(u32x4*)(O + row * ldc + col0 + bj * HALF) = w; } }
    }
};
struct EpiKproj {
    static constexpr bool PERM = false, AFTER_DRAIN = false;
    float* outK; bf16_t* KB;
    __device__ __forceinline__ void operator()(const f32x4 (&acc)[2][2][4][2], const Unit& u, int wr, int wc, int fr, int fq) const {
        const int l = u.pn >> 2, row0 = u.pm * BM + wr * 64 + fr, col0 = (u.pn & 3) * BM + wc * 32 + 4 * fq;
        float* ob = outK + (size_t)l * 2048 * 1024; bf16_t* kb = KB + (size_t)l * 2048 * 1024;
#pragma unroll
        for (int ai = 0; ai < 2; ++ai)
#pragma unroll
            for (int m = 0; m < 4; ++m) { const size_t ro = (size_t)(row0 + ai * HALF + m * 16) * 1024 + col0;
#pragma unroll
                for (int bj = 0; bj < 2; ++bj)
#pragma unroll
                    for (int n = 0; n < 2; ++n) { const f32x4 v = acc[ai][bj][m][n]; *(f32x4*)(ob + ro + bj * HALF + n * 16) = v;
                        if (KB) { u32x2 w; w.x = cvt_pk_bf16(v[0], v[1]); w.y = cvt_pk_bf16(v[2], v[3]); *(u32x2*)(kb + ro + bj * HALF + n * 16) = w; } } }
    }
};
struct EpiVT {
    static constexpr bool PERM = false, AFTER_DRAIN = false;
    float* outV; bf16_t* VT;
    __device__ __forceinline__ void operator()(const f32x4 (&acc)[2][2][4][2], const Unit& u, int wr, int wc, int fr, int fq) const {
        const int l = u.pm >> 2, e0 = (u.pm & 3) * BM + wr * 64 + fr, b = u.pn, m0 = wc * 32 + 4 * fq;
        bf16_t* vb = VT + ((size_t)l * 8 + b) * 1024 * 256;
#pragma unroll
        for (int ai = 0; ai < 2; ++ai)
#pragma unroll
            for (int m = 0; m < 4; ++m) { const int e = e0 + ai * HALF + m * 16;
#pragma unroll
                for (int bj = 0; bj < 2; ++bj)
#pragma unroll
                    for (int n = 0; n < 2; ++n) { const f32x4 v = acc[ai][bj][m][n]; const int mm = m0 + bj * HALF + n * 16;
                        u32x2 w; w.x = cvt_pk_bf16(v[0], v[1]); w.y = cvt_pk_bf16(v[2], v[3]); *(u32x2*)(vb + (size_t)e * 256 + mm) = w;
                        float* ov = outV + (size_t)l * 2048 * 1024 + (size_t)(b * 256 + mm) * 1024 + e;
                        ov[0] = v[0]; ov[1024] = v[1]; ov[2048] = v[2]; ov[3072] = v[3]; } }
    }
};
struct EpiSoftmax {
    static constexpr bool PERM = true, AFTER_DRAIN = true;
    bf16_t* P; int ldc; float c2;
    __device__ __forceinline__ void fused(f32x4 (&acc)[2][2][4][2], const Unit& u, int wr, int wc, int fr, int fq, PG8_LAS unsigned char* lds, int wid, int lane) const {
        PG8_LAS f32x4* TM = (PG8_LAS f32x4*)lds;
        PG8_LAS f32x4* TS = (PG8_LAS f32x4*)(lds + 4096);
        PG8_LAS float* TMf = (PG8_LAS float*)lds; PG8_LAS float* TSf = (PG8_LAS float*)(lds + 4096);
#pragma unroll
        for (int ai = 0; ai < 2; ++ai)
#pragma unroll
            for (int m = 0; m < 4; ++m) { float mx = -3.0e38f;
#pragma unroll
                for (int bj = 0; bj < 2; ++bj)
#pragma unroll
                    for (int n = 0; n < 2; ++n) { const f32x4 x = acc[ai][bj][m][n]; mx = fmaxf(mx, fmaxf(fmaxf(x[0], x[1]), fmaxf(x[2], x[3]))); }
                mx = fmaxf(mx, __shfl_xor(mx, 16)); mx = fmaxf(mx, __shfl_xor(mx, 32));
                if (fq == 0) TMf[(ai * HALF + wr * 64 + m * 16 + fr) * 4 + wc] = mx; }
        asm volatile("s_waitcnt lgkmcnt(0)" ::: "memory"); __builtin_amdgcn_s_barrier(); asm volatile("" ::: "memory");
#pragma unroll
        for (int ai = 0; ai < 2; ++ai)
#pragma unroll
            for (int m = 0; m < 4; ++m) { const int rl = ai * HALF + wr * 64 + m * 16 + fr; const f32x4 t = TM[rl]; const float mx = fmaxf(fmaxf(t[0], t[1]), fmaxf(t[2], t[3])); float s = 0.f;
#pragma unroll
                for (int bj = 0; bj < 2; ++bj)
#pragma unroll
                    for (int n = 0; n < 2; ++n) { f32x4 x = acc[ai][bj][m][n];
#pragma unroll
                        for (int j = 0; j < 4; ++j) { x[j] = __builtin_amdgcn_exp2f((x[j] - mx) * c2); s += x[j]; }
                        acc[ai][bj][m][n] = x; }
                s += __shfl_xor(s, 16); s += __shfl_xor(s, 32);
                if (fq == 0) TSf[rl * 4 + wc] = s; }
        asm volatile("s_waitcnt lgkmcnt(0)" ::: "memory"); __builtin_amdgcn_s_barrier(); asm volatile("" ::: "memory");
        const int row0 = u.pm * BM + wr * 64 + fr, col0 = u.pn * BM + wc * 32 + 8 * fq;
#pragma unroll
        for (int ai = 0; ai < 2; ++ai)
#pragma unroll
            for (int m = 0; m < 4; ++m) { const int rl = ai * HALF + wr * 64 + m * 16 + fr; const f32x4 t = TS[rl]; const float inv = 1.0f / ((t[0] + t[1]) + (t[2] + t[3]));
                bf16_t* rowp = P + (size_t)(row0 + ai * HALF + m * 16) * ldc + col0;
#pragma unroll
                for (int bj = 0; bj < 2; ++bj) { const f32x4 v0 = acc[ai][bj][m][0] * inv, v1 = acc[ai][bj][m][1] * inv;
                    u32x4 w; w.x = cvt_pk_bf16(v0[0], v0[1]); w.y = cvt_pk_bf16(v0[2], v0[3]); w.z = cvt_pk_bf16(v1[0], v1[1]); w.w = cvt_pk_bf16(v1[2], v1[3]);
                    *(u32x4*)(rowp + bj * HALF) = w; } }
    }
};

template <class Epi, class Addr, bool ALIGN_EPI = false, bool SP2 = false, bool KS = false>
__device__ __forceinline__ void gemm_phase(PG8_LAS unsigned char* lds, const Gemm g, const StaticOrder& S, const Epi& E, const Addr AD, const float* ssqh = nullptr) {
    int tid = threadIdx.x; asm volatile("" : "+v"(tid));
    const int wid = __builtin_amdgcn_readfirstlane(tid >> 6), lane = tid & 63, wr = wid >> 2, wc = wid & 3, fr = lane & 15, fq = lane >> 4;
    const int K = g.K, nt = K / BK;
    unsigned voffA[2], voffB[2];
#pragma unroll
    for (int i = 0; i < 2; ++i) { int R, C; stage_rc(tid * 16 + i * 8192, R, C); const int Rb = Epi::PERM ? ((R & ~31) + perm32(R & 31)) : R;
        voffA[i] = (unsigned)(R * g.lda + C) * 2u; voffB[i] = (unsigned)(Rb * g.ldb + C) * 2u; }
    const size_t kstep = (size_t)(BK * 2);
    const size_t hstepA = (size_t)HALF * g.lda * 2, hstepB = (size_t)HALF * g.ldb * 2;
    const unsigned ldsw = (unsigned)wid * 1024u;
    const int aoff = lds_byte(wr * 64 + fr, fq * 8), boff = lds_byte(wc * 32 + fr, fq * 8);
#define PG8_SA(b, h) (((b) * 2 + (h)) * HTB)
#define PG8_SB(b, h) ((4 + (b) * 2 + (h)) * HTB)
#define PG8_STAGE(bufoff, gbase, voff) do { _Pragma("unroll") for (int _i = 0; _i < 2; ++_i) \
        __builtin_amdgcn_global_load_lds((const unsigned*)((const char*)(gbase) + (voff)[_i]), (PG8_LAS unsigned*)(lds + (bufoff) + ldsw + _i * 8192), 16, 0, 0); } while (0)
#define PG8_LDA(dst, b, h) do { _Pragma("unroll") for (int m = 0; m < 4; ++m) _Pragma("unroll") for (int k = 0; k < 2; ++k) dst[m][k] = *(const PG8_LAS bf16x8*)(lds + PG8_SA(b, h) + aoff + m * 2048 + k * 1024); } while (0)
#define PG8_LDB(dst, b, h) do { _Pragma("unroll") for (int n = 0; n < 2; ++n) _Pragma("unroll") for (int k = 0; k < 2; ++k) dst[n][k] = *(const PG8_LAS bf16x8*)(lds + PG8_SB(b, h) + boff + n * 2048 + k * 1024); } while (0)
#define PG8_MMA(ai, bj, At, Bt) do { __builtin_amdgcn_s_setprio(1); _Pragma("unroll") for (int m = 0; m < 4; ++m) _Pragma("unroll") for (int n = 0; n < 2; ++n) _Pragma("unroll") for (int k = 0; k < 2; ++k) \
        acc[ai][bj][m][n] = __builtin_amdgcn_mfma_f32_16x16x32_bf16(Bt[n][k], At[m][k], acc[ai][bj][m][n], 0, 0, 0); __builtin_amdgcn_s_setprio(0); } while (0)
#define PG8_WAIT_V(n) asm volatile("s_waitcnt vmcnt(" #n ")" ::: "memory")
#define PG8_WAIT_L(n) asm volatile("s_waitcnt lgkmcnt(" #n ")" ::: "memory")
#define PG8_BAR __builtin_amdgcn_s_barrier()
#define PG8_SCHED __builtin_amdgcn_sched_barrier(0)
    Unit cur, nxt; int ui = 0;
    if (!S.next(0, cur)) return;
    f32x4 acc[2][2][4][2];
#pragma unroll
    for (int a = 0; a < 2; ++a)
#pragma unroll
        for (int b = 0; b < 2; ++b)
#pragma unroll
            for (int m = 0; m < 4; ++m)
#pragma unroll
                for (int n = 0; n < 2; ++n) acc[a][b][m][n] = (f32x4){0.f, 0.f, 0.f, 0.f};
    bf16x8 At[4][2], B0[2][2], B1[2][2];
    const char* cA = (const char*)g.A + 2 * AD.a(cur, g); const char* cB = (const char*)g.Bt + 2 * AD.b(cur, g);
    PG8_LAS float* kstab = (PG8_LAS float*)(lds + STAGE_BYTES);
    if constexpr (KS) { if (tid < 256) { const float* q = ssqh + (size_t)(cur.pm * BM + tid); float r[4];
#pragma unroll
            for (int gi = 0; gi < 4; ++gi) { float a = 0.f;
#pragma unroll
                for (int e = 0; e < 8; ++e) a += q[(size_t)(gi * 8 + e) * 16640];
                r[gi] = 1.0f / sqrtf(a * (1.0f / 512.0f) + 1e-6f); }
            *(PG8_LAS f32x4*)(kstab + tid * 4) = (f32x4){r[0] / r[1], r[1] / r[2], r[2] / r[3], r[3]}; } }
#define PG8_KSCALE(gi) do { _Pragma("unroll") for (int ai = 0; ai < 2; ++ai) _Pragma("unroll") for (int m = 0; m < 4; ++m) { const float f_ = kstab[(ai * HALF + wr * 64 + m * 16 + fr) * 4 + (gi)]; \
        _Pragma("unroll") for (int bj = 0; bj < 2; ++bj) _Pragma("unroll") for (int n = 0; n < 2; ++n) acc[ai][bj][m][n] = acc[ai][bj][m][n] * f_; } } while (0)
    if constexpr (SP2) {
        PG8_STAGE(PG8_SB(0, 0), cB, voffB); PG8_STAGE(PG8_SB(0, 1), cB + hstepB, voffB); PG8_STAGE(PG8_SA(0, 0), cA, voffA); PG8_STAGE(PG8_SA(0, 1), cA + hstepA, voffA);
        if (wr == 1) PG8_BAR;
        PG8_WAIT_V(2); PG8_BAR;
        PG8_STAGE(PG8_SB(1, 0), cB + kstep, voffB); PG8_STAGE(PG8_SA(1, 0), cA + kstep, voffA); PG8_STAGE(PG8_SB(1, 1), cB + hstepB + kstep, voffB);
        PG8_WAIT_V(6); PG8_BAR;
    } else {
        PG8_STAGE(PG8_SB(0, 0), cB, voffB); PG8_STAGE(PG8_SA(0, 0), cA, voffA); PG8_STAGE(PG8_SB(0, 1), cB + hstepB, voffB); PG8_STAGE(PG8_SA(0, 1), cA + hstepA, voffA);
        if (wr == 1) PG8_BAR;
        PG8_WAIT_V(4); PG8_BAR;
        PG8_STAGE(PG8_SB(1, 0), cB + kstep, voffB); PG8_STAGE(PG8_SA(1, 0), cA + kstep, voffA); PG8_STAGE(PG8_SB(1, 1), cB + hstepB + kstep, voffB);
        PG8_WAIT_V(6); PG8_BAR;
    }
    for (;;) {
        const bool has_next = S.next(ui + 1, nxt);
        const char* nA = has_next ? (const char*)g.A + 2 * AD.a(nxt, g) : cA; const char* nB = has_next ? (const char*)g.Bt + 2 * AD.b(nxt, g) : cB;
        for (int seg = 0; seg < (KS ? 4 : 1); ++seg) {
        if constexpr (KS) { if (seg > 0) PG8_KSCALE(seg - 1); }
        for (int t = KS ? seg * 8 : 0; t < (KS ? seg * 8 + 8 : nt); t += 2) {
            const bool last = (t == nt - 2);
            const char* a1 = cA + (size_t)(t + 1) * kstep;
            const char* a2 = last ? nA : cA + (size_t)(t + 2) * kstep; const char* b2 = last ? nB : cB + (size_t)(t + 2) * kstep;
            const char* a3 = a2 + kstep; const char* b3 = b2 + kstep;
            if constexpr (SP2) {
            PG8_LDB(B0, 0, 0); PG8_LDB(B1, 0, 1); PG8_SCHED; PG8_LDA(At, 0, 0); PG8_STAGE(PG8_SA(1, 1), a1 + hstepA, voffA);
            PG8_WAIT_V(8); PG8_WAIT_L(0); PG8_BAR; PG8_MMA(0, 0, At, B0); PG8_MMA(0, 1, At, B1); PG8_BAR; PG8_SCHED;
            PG8_LDA(At, 0, 1); PG8_STAGE(PG8_SB(0, 0), b2, voffB); PG8_STAGE(PG8_SB(0, 1), b2 + hstepB, voffB); PG8_STAGE(PG8_SA(0, 0), a2, voffA);
            PG8_WAIT_V(8); PG8_WAIT_L(0); PG8_BAR; PG8_MMA(1, 0, At, B0); PG8_MMA(1, 1, At, B1); PG8_BAR; PG8_SCHED;
            PG8_LDB(B0, 1, 0); PG8_LDB(B1, 1, 1); PG8_SCHED; PG8_LDA(At, 1, 0); PG8_STAGE(PG8_SA(0, 1), a2 + hstepA, voffA);
            PG8_WAIT_V(8); PG8_WAIT_L(0); PG8_BAR; PG8_MMA(0, 0, At, B0); PG8_MMA(0, 1, At, B1); PG8_BAR; PG8_SCHED;
            PG8_LDA(At, 1, 1); PG8_STAGE(PG8_SB(1, 0), b3, voffB); PG8_STAGE(PG8_SB(1, 1), b3 + hstepB, voffB); PG8_STAGE(PG8_SA(1, 0), a3, voffA);
            PG8_WAIT_V(8); PG8_WAIT_L(0); PG8_BAR; PG8_MMA(1, 0, At, B0); PG8_MMA(1, 1, At, B1); PG8_BAR; PG8_SCHED;
            } else {
            PG8_LDB(B0, 0, 0); PG8_SCHED; PG8_LDA(At, 0, 0); PG8_STAGE(PG8_SA(1, 1), a1 + hstepA, voffA);
            PG8_WAIT_L(8); PG8_BAR; PG8_WAIT_L(0); PG8_MMA(0, 0, At, B0); PG8_BAR; PG8_SCHED;
            PG8_LDB(B1, 0, 1); PG8_STAGE(PG8_SB(0, 0), b2, voffB);
            PG8_BAR; PG8_WAIT_L(0); PG8_MMA(0, 1, At, B1); PG8_BAR;
            PG8_LDA(At, 0, 1); PG8_STAGE(PG8_SA(0, 0), a2, voffA);
            PG8_BAR; PG8_WAIT_L(0); PG8_MMA(1, 0, At, B0); PG8_BAR; PG8_SCHED;
            PG8_STAGE(PG8_SB(0, 1), b2 + hstepB, voffB);
            PG8_WAIT_V(6); PG8_BAR; PG8_MMA(1, 1, At, B1); PG8_BAR;
            PG8_LDB(B0, 1, 0); PG8_SCHED; PG8_LDA(At, 1, 0); PG8_STAGE(PG8_SA(0, 1), a2 + hstepA, voffA);
            PG8_WAIT_L(8); PG8_BAR; PG8_WAIT_L(0); PG8_MMA(0, 0, At, B0); PG8_BAR; PG8_SCHED;
            PG8_LDB(B1, 1, 1); PG8_STAGE(PG8_SB(1, 0), b3, voffB);
            PG8_BAR; PG8_WAIT_L(0); PG8_MMA(0, 1, At, B1); PG8_BAR;
            PG8_LDA(At, 1, 1); PG8_STAGE(PG8_SA(1, 0), a3, voffA);
            PG8_BAR; PG8_WAIT_L(0); PG8_MMA(1, 0, At, B0); PG8_BAR; PG8_SCHED;
            PG8_STAGE(PG8_SB(1, 1), b3 + hstepB, voffB);
            PG8_WAIT_V(6); PG8_BAR; PG8_MMA(1, 1, At, B1); PG8_BAR;
            }
        }
        }
        if constexpr (KS) PG8_KSCALE(3);
        if constexpr (ALIGN_EPI) { if (wr == 0) PG8_BAR; }
        if constexpr (!Epi::AFTER_DRAIN) { E(acc, cur, wr, wc, fr, fq); }
        if (!has_next) break;
#pragma unroll
        for (int a = 0; a < 2; ++a)
#pragma unroll
            for (int b = 0; b < 2; ++b)
#pragma unroll
                for (int m = 0; m < 4; ++m)
#pragma unroll
                    for (int n = 0; n < 2; ++n) acc[a][b][m][n] = (f32x4){0.f, 0.f, 0.f, 0.f};
        cur = nxt; cA = nA; cB = nB; ++ui;
        if constexpr (ALIGN_EPI) { if (wr == 1) PG8_BAR; }
    }
    PG8_WAIT_V(0);
    if constexpr (!ALIGN_EPI) { if (wr == 0) PG8_BAR; }
    PG8_BAR;
    if constexpr (Epi::AFTER_DRAIN) { E.fused(acc, cur, wr, wc, fr, fq, lds, wid, lane); }
#undef PG8_KSCALE
#undef PG8_SA
#undef PG8_SB
#undef PG8_STAGE
#undef PG8_LDA
#undef PG8_LDB
#undef PG8_MMA
#undef PG8_WAIT_V
#undef PG8_WAIT_L
#undef PG8_BAR
#undef PG8_SCHED
}
}

constexpr int NWAVES = 8;
constexpr int DM = 1024, TP = 16384, NBATCH = 8, SEQ = 2048, NSMP = 128, MV = TP + NSMP  , MP = 16640  , NPAN = 65;
constexpr int EVEN_IN = 6144, EVEN_P = 4096  , ODD_IN = 5152, ODD_WROWS = 5376  , ODD_INP = 5120  , DIN = 2048, CONVD = 3072, NHEAD = 32, NMEM = 256;
constexpr float EPS = 1e-6f;
constexpr size_t OUT_Y = 0, OUT_MK = 16908288, OUT_MV = 25296896, OUT_PP = 33685504, OUT_PS = 33931264, OUT_CP = 37863424, OUT_CS = 37896192,
                 OUT_SCP = 38420480, OUT_SCS = 38567936, OUT_SP = 40927232, OUT_SS = 45121536, OUT_TOTAL = 112230400;
constexpr size_t MiB = 1u << 20;
constexpr size_t WS_CTL = 0, CTL_ZERO_BYTES = 5 * MiB;
constexpr size_t WS_SSQ = 1 * MiB;
constexpr size_t WS_GSSQ = 3 * MiB;
constexpr size_t WS_WTE_IN = 5 * MiB;
constexpr size_t WS_WTE_OUT = WS_WTE_IN + 24 * MiB;
constexpr size_t WS_WTO_IN = WS_WTE_OUT + 8 * MiB;
constexpr size_t WS_WTO_OUT = WS_WTO_IN + 21 * MiB;
constexpr size_t WS_WTQ = WS_WTO_OUT + 8 * MiB;
constexpr size_t WS_WTK = WS_WTQ + 8 * MiB, WS_WTV = WS_WTK + 8 * MiB, WS_WTO = WS_WTV + 8 * MiB;
constexpr size_t WS_WTP = WS_WTO + 8 * MiB;
constexpr size_t WS_MEMB = WS_WTP + 1 * MiB;
constexpr size_t WS_KB = WS_MEMB + 4 * MiB;
constexpr size_t WS_VT = WS_KB + 16 * MiB;
constexpr size_t WS_H = WS_VT + 16 * MiB;
constexpr size_t WS_Q = WS_H + 34 * MiB, WS_PB = WS_Q + 34 * MiB, WS_O = WS_PB + 34 * MiB, WS_DIFF = WS_O + 34 * MiB;
constexpr size_t WS_MIX = WS_DIFF + 34 * MiB;
constexpr size_t WS_YG = WS_MIX + 66 * MiB;
constexpr size_t WS_CONVX = WS_YG + 66 * MiB;
constexpr size_t WS_DT = WS_CONVX + 98 * MiB;
constexpr size_t WS_PROJ = WS_DT + 3 * MiB;
constexpr size_t WS_WTU = WS_PROJ + 196 * MiB;
constexpr size_t WS_SSQH = WS_WTU + 4 * MiB;
constexpr size_t WS_END = WS_SSQH + 5 * MiB;
constexpr int CW_BAR = 4096;
constexpr int RING_BYTES = 131072, SSD_SMALL_OFF = 131072, MISC_OFF = 163840 - 128, LDS_BYTES = 163840;

#define GAS __attribute__((address_space(1)))
#define LAS __attribute__((address_space(3)))
#define DI __device__ __forceinline__
typedef unsigned short bf16;
typedef unsigned v4u __attribute__((ext_vector_type(4)));
typedef unsigned v2u __attribute__((ext_vector_type(2)));
typedef float f32x4 __attribute__((ext_vector_type(4)));
typedef float f32x16 __attribute__((ext_vector_type(16)));
typedef short bf16x8 __attribute__((ext_vector_type(8)));
typedef GAS unsigned gu32;
#define LDS_WAIT() asm volatile("s_waitcnt lgkmcnt(0)" ::: "memory")
DI unsigned f2bf(float f) { unsigned u = __builtin_bit_cast(unsigned, f); return (u + 0x7fffu + ((u >> 16) & 1u)) >> 16; }
DI unsigned pk2(float lo, float hi) { unsigned r; asm("v_cvt_pk_bf16_f32 %0, %1, %2" : "=v"(r) : "v"(lo), "v"(hi)); return r; }
DI float bflo(unsigned w) { return __uint_as_float(w << 16); }
DI float bfhi(unsigned w) { return __uint_as_float(w & 0xffff0000u); }
DI float bf1(bf16 h) { return __uint_as_float(((unsigned)h) << 16); }
DI void unpack8(const v4u v, float (&f)[8]) { f[0] = bflo(v.x); f[1] = bfhi(v.x); f[2] = bflo(v.y); f[3] = bfhi(v.y); f[4] = bflo(v.z); f[5] = bfhi(v.z); f[6] = bflo(v.w); f[7] = bfhi(v.w); }
DI v4u pack8(const float (&f)[8]) { v4u o; o.x = pk2(f[0], f[1]); o.y = pk2(f[2], f[3]); o.z = pk2(f[4], f[5]); o.w = pk2(f[6], f[7]); return o; }
DI void ld8(const bf16* p, float (&f)[8]) { unpack8(*(const GAS v4u*)p, f); }
DI void ld8f(const float* p, float (&f)[8]) { const f32x4 a = *(const GAS f32x4*)p, b = *(const GAS f32x4*)(p + 4); f[0] = a[0]; f[1] = a[1]; f[2] = a[2]; f[3] = a[3]; f[4] = b[0]; f[5] = b[1]; f[6] = b[2]; f[7] = b[3]; }
DI void st8(bf16* p, const float (&f)[8]) { *(GAS v4u*)p = pack8(f); }
DI void st8f(float* p, const float (&f)[8]) { *(GAS f32x4*)p = (f32x4){f[0], f[1], f[2], f[3]}; *(GAS f32x4*)(p + 4) = (f32x4){f[4], f[5], f[6], f[7]}; }
DI float silu(float z) { return z * __builtin_amdgcn_rcpf(1.0f + __builtin_amdgcn_exp2f(-1.44269504089f * z)); }
DI float wave_sum(float v) {
#pragma unroll
    for (int o = 1; o < 64; o <<= 1) v += __shfl_xor(v, o);
    return v;
}

#define XB_TMO      128
#define XB_XCNT(j)  (256  + 64 * (j))
#define XB_XSUB(j)  (1280 + 64 * (j))
#define XB_XGEN(j)  (2304 + 64 * (j))
#define XB_TOP      3328
#define XB_TOPGEN   3392
#define XCD_BAR_WORDS 3456
#define XB_SPIN_CAP (1u << 18)
DI unsigned xb_ld(unsigned* p)              { return __hip_atomic_load(p, __ATOMIC_RELAXED, __HIP_MEMORY_SCOPE_AGENT); }
DI unsigned xb_add(unsigned* p, unsigned v) { return __hip_atomic_fetch_add(p, v, __ATOMIC_RELAXED, __HIP_MEMORY_SCOPE_AGENT); }
DI unsigned xb_xcc_id() { return (unsigned)__builtin_amdgcn_s_getreg((3 << 11) | 20) & 0xFu; }
#define XB_SPIN(cond, bar) do { unsigned _sp = 0; while (cond) { __builtin_amdgcn_s_sleep(1); \
    if ((++_sp & 255u) == 0u) { if (xb_ld(&(bar)[XB_TMO])) break; if (_sp > XB_SPIN_CAP) { atomicAdd(&(bar)[XB_TMO], 1u); break; } } } } while (0)
struct XcdBarrier { unsigned* bar; unsigned x; volatile LAS unsigned* st; };
DI XcdBarrier xcd_barrier_post(unsigned* bar, volatile LAS unsigned* st) {
    XcdBarrier b; b.bar = bar; b.x = xb_xcc_id(); b.st = st;
    if (threadIdx.x == 0) (void)xb_add(&bar[XB_XCNT(b.x)], 1u);
    return b;
}
DI void xcd_barrier_complete(unsigned* bar, unsigned x, unsigned& nloc, unsigned& nx) {
    const unsigned G = gridDim.x * gridDim.y * gridDim.z;
    unsigned sum, cnt, mine, sp = 0u;
    for (;;) {
        sum = 0u; cnt = 0u; mine = 0u;
#pragma unroll
        for (unsigned j = 0; j < 16; ++j) { const unsigned c = xb_ld(&bar[XB_XCNT(j)]); sum += c; cnt += (c > 0u) ? 1u : 0u; mine = (j == x) ? c : mine; }
        if (sum == G) break;
        __builtin_amdgcn_s_sleep(1);
        if ((++sp & 255u) == 0u) { if (xb_ld(&bar[XB_TMO])) break; if (sp > XB_SPIN_CAP) { atomicAdd(&bar[XB_TMO], 1u); break; } }
    }
    nloc = mine > 0u ? mine : 1u; nx = cnt > 0u ? cnt : 1u;
}
DI void xcd_barrier(const XcdBarrier& b) {
    asm volatile("s_waitcnt vmcnt(0)" ::: "memory");
    __syncthreads();
    if (threadIdx.x == 0) {
        unsigned* bar = b.bar;
        __builtin_amdgcn_s_waitcnt(0);
        unsigned nloc = b.st[0], nx = b.st[1];
        if (nloc == 0u) { xcd_barrier_complete(bar, b.x, nloc, nx); b.st[0] = nloc; b.st[1] = nx; }
        const unsigned old = xb_add(&bar[XB_XSUB(b.x)], 1u);
        const unsigned gen = old / nloc;
        __builtin_amdgcn_fence(__ATOMIC_ACQUIRE, "agent");
        if (old + 1u == (gen + 1u) * nloc) {
            __builtin_amdgcn_fence(__ATOMIC_RELEASE, "agent");
            asm volatile("s_waitcnt vmcnt(0)" ::: "memory");
            const unsigned og = xb_add(&bar[XB_TOP], 1u);
            const unsigned tg = og / nx;
            if (og + 1u == (tg + 1u) * nx) xb_add(&bar[XB_TOPGEN], 1u);
            else XB_SPIN(xb_ld(&bar[XB_TOPGEN]) == tg, bar);
            asm volatile("" ::: "memory");
            xb_add(&bar[XB_XGEN(b.x)], 1u);
            asm volatile("s_waitcnt vmcnt(0)" ::: "memory");
        } else {
            XB_SPIN(xb_ld(&bar[XB_XGEN(b.x)]) == gen, bar);
            asm volatile("s_waitcnt vmcnt(0)" ::: "memory");
        }
    }
    __syncthreads();
}

struct Args { const float* in[29]; float* out; unsigned char* ws; int ph_lo, ph_hi; };
struct Frame {
    LAS unsigned char* lds;
    int tid, lane, wave, vcu, G;
    const float* const* in; float* out; unsigned char* ws;
};
enum { I_XP = 0, I_XS, I_MEM, I_CK, I_CV, I_SPOOL, I_SCONV, I_SSCONV, I_SSSM, I_NMIX, I_NXA, I_NFIN, I_WINE, I_POOLW, I_POOLS, I_CONVW, I_WOUTE, I_WINO, I_SCW, I_SCB, I_DTB, I_ALOG, I_DSKIP, I_SNORM, I_WOUTO, I_WQ, I_WK, I_WV, I_WO };

DI void p0_transpose_item(const float* W, int K, int N, bf16* WT, LAS float* scr, int item, int lane, const float* gk = nullptr) {
    const int nblk = N / 32, kb = item / nblk, nb = item % nblk, k0 = 64 * kb, n0 = 32 * nb;
    {
        const int kr = lane >> 3, ns = lane & 7; f32x4 v[8];
#pragma unroll
        for (int i = 0; i < 8; ++i) v[i] = *(const GAS f32x4*)(W + (size_t)(k0 + 8 * i + kr) * N + n0 + 4 * ns);
#pragma unroll
        for (int i = 0; i < 8; ++i) { const int kk = 8 * i + kr; const float gg = gk ? ((const GAS float*)gk)[k0 + kk] : 1.0f; LAS float* d = scr + kk * 33 + 4 * ns;
            d[0] = v[i][0] * gg; d[1] = v[i][1] * gg; d[2] = v[i][2] * gg; d[3] = v[i][3] * gg; } }
    LDS_WAIT(); asm volatile("" ::: "memory");
    const int c = lane & 7;
#pragma unroll
    for (int j = 0; j < 4; ++j) { const int n = (lane >> 3) + 8 * j; const LAS float* s = scr + (8 * c) * 33 + n;
        v4u o; o.x = pk2(s[0 * 33], s[1 * 33]); o.y = pk2(s[2 * 33], s[3 * 33]); o.z = pk2(s[4 * 33], s[5 * 33]); o.w = pk2(s[6 * 33], s[7 * 33]);
        *(GAS v4u*)(WT + (size_t)(n0 + n) * K + k0 + 8 * c) = o; }
    LDS_WAIT(); asm volatile("" ::: "memory");
}
DI void p0_prologue(Frame& F) {
    LAS float* scr = (LAS float*)(F.lds + F.wave * 16384);
    const int gw = F.vcu * NWAVES + F.wave, NGW = F.G * NWAVES;
    unsigned char* ws = F.ws;
    constexpr int IT_WINE = 16 * 192, IT_WOUT = 32 * 32, IT_WINO = 16 * 161, IT_SQ = 16 * 32, IT_PW = 4 * 8;
    constexpr int N0 = 2 * IT_WINE, N1 = N0 + 2 * IT_WOUT, N2 = N1 + 2 * IT_WINO, N3 = N2 + 2 * IT_WOUT, N4 = N3 + 16 * IT_SQ, N5 = N4 + 8 * IT_PW;
    for (int it = gw; it < N5; it += NGW) {
        if (it < N0) { const int mi = it / IT_WINE, r = it % IT_WINE;
            bf16* dst = (r % 192) < 32 ? (bf16*)(ws + WS_WTU) + (size_t)mi * DM * DM : (bf16*)(ws + WS_WTE_IN) + (size_t)mi * EVEN_IN * DM;
            {
                const int nb = r % 192;
                if (nb >= 64) { const int blk = (nb - 64) >> 5, cb = (nb - 64) & 31, chunk = cb >> 2, sub = cb & 3;
                    const int nnb = (blk == 1 || blk == 2) ? 64 + chunk * 8 + sub + (blk == 2 ? 4 : 0) : 128 + chunk * 8 + sub + (blk == 3 ? 4 : 0);
                    dst += (ptrdiff_t)(nnb - nb) * 32 * DM; } }
            p0_transpose_item(F.in[I_WINE] + (size_t)mi * DM * EVEN_IN, DM, EVEN_IN, dst, scr, r, F.lane, F.in[I_NMIX] + (size_t)(2 * mi) * DM); }
        else if (it < N1) { const int q = it - N0, mi = q / IT_WOUT, r = q % IT_WOUT; p0_transpose_item(F.in[I_WOUTE] + (size_t)mi * 2048 * DM, 2048, DM, (bf16*)(ws + WS_WTE_OUT) + (size_t)mi * DM * 2048, scr, r, F.lane); }
        else if (it < N2) { const int q = it - N1, mi = q / IT_WINO, r = q % IT_WINO; p0_transpose_item(F.in[I_WINO] + (size_t)mi * DM * ODD_IN, DM, ODD_IN, (bf16*)(ws + WS_WTO_IN) + (size_t)mi * ODD_WROWS * DM, scr, r, F.lane, F.in[I_NMIX] + (size_t)(2 * mi + 1) * DM); }
        else if (it < N3) { const int q = it - N2, mi = q / IT_WOUT, r = q % IT_WOUT; p0_transpose_item(F.in[I_WOUTO] + (size_t)mi * 2048 * DM, 2048, DM, (bf16*)(ws + WS_WTO_OUT) + (size_t)mi * DM * 2048, scr, r, F.lane, F.in[I_SNORM] + (size_t)mi * DIN); }
        else if (it < N4) { const int q = it - N3, mi = q / IT_SQ, r = q % IT_SQ, which = mi >> 2, l = mi & 3;
            const float* src = F.in[I_WQ + which] + (size_t)l * DM * DM;
            bf16* dst = (bf16*)(ws + (which == 0 ? WS_WTQ : which == 1 ? WS_WTK : which == 2 ? WS_WTV : WS_WTO)) + (size_t)l * DM * DM;
            p0_transpose_item(src, DM, DM, dst, scr, r, F.lane, which == 0 ? F.in[I_NXA] + (size_t)l * DM : nullptr); }
        else { const int q = it - N4, mi = q / IT_PW, r = q % IT_PW; p0_transpose_item(F.in[I_POOLW] + (size_t)mi * 65536, 256, 256, (bf16*)(ws + WS_WTP) + (size_t)mi * 65536, scr, r, F.lane); }
    }
    for (int it = gw; it < 2 * 4 * 32 * 8; it += NGW) {
        const int mi = it >> 10, gg = (it >> 8) & 3, kb = (it >> 3) & 31, nb = it & 7, r = F.lane & 31, h = F.lane >> 5;
        const float* Wi = F.in[I_WINE] + (size_t)mi * DM * EVEN_IN + (size_t)(32 * kb + r) * EVEN_IN + gg * 256;
        const float* Wp = F.in[I_POOLW] + (size_t)(mi * 4 + gg) * 65536 + nb * 32 + r;
        f32x16 acc;
#pragma unroll
        for (int k = 0; k < 16; ++k) acc[k] = 0.f;
        for (int j0 = 0; j0 < 256; j0 += 16) {
            f32x4 a4[4]; float b[16];
#pragma unroll
            for (int q = 0; q < 4; ++q) a4[q] = *(const GAS f32x4*)(Wi + j0 + 4 * q);
#pragma unroll
            for (int q = 0; q < 8; ++q) { b[2 * q] = ((const GAS float*)Wp)[(size_t)(j0 + 2 * q + h) * 256]; }
#pragma unroll
            for (int q = 0; q < 8; ++q) { const float av = (q & 1) ? (h ? a4[q >> 1][3] : a4[q >> 1][2]) : (h ? a4[q >> 1][1] : a4[q >> 1][0]);
                acc = __builtin_amdgcn_mfma_f32_32x32x2f32(av, b[2 * q], acc, 0, 0, 0); }
        }
        bf16* dst = (bf16*)(ws + WS_WTE_IN) + (size_t)mi * EVEN_IN * DM + (size_t)(gg * 256 + nb * 32 + r) * DM + 32 * kb;
        const float* gk = F.in[I_NMIX] + (size_t)(2 * mi) * DM + 32 * kb;
#pragma unroll
        for (int q4 = 0; q4 < 4; ++q4) { const int k0 = 8 * q4 + 4 * h; const f32x4 g4 = *(const GAS f32x4*)(gk + k0);
            *(GAS v2u*)(dst + k0) = (v2u){pk2(acc[4 * q4] * g4[0], acc[4 * q4 + 1] * g4[1]), pk2(acc[4 * q4 + 2] * g4[2], acc[4 * q4 + 3] * g4[3])}; }
    }
    const int gt = F.vcu * 512 + F.tid, NGT = F.G * 512;
    for (int i = gt; i < 2 * 224 * 128; i += NGT) { const int mi = i / (224 * 128), r = i % (224 * 128);
        *(GAS v4u*)((bf16*)(ws + WS_WTO_IN) + ((size_t)mi * ODD_WROWS + ODD_IN) * DM + (size_t)r * 8) = (v4u){0u, 0u, 0u, 0u}; }
    for (int i = gt; i < 2048 * 128; i += NGT) { float f[8]; ld8f(F.in[I_MEM] + (size_t)i * 8, f); st8((bf16*)(ws + WS_MEMB) + (size_t)i * 8, f); }
    bf16* H = (bf16*)(ws + WS_H); unsigned long long* SSQ = (unsigned long long*)(ws + WS_SSQ);
    for (int m0 = 2 * gw; m0 < MV; m0 += 2 * NGW) {
        f32x4 v[2][4];
#pragma unroll
        for (int rr = 0; rr < 2; ++rr) { const int m = m0 + rr; const float* xrow = m < TP ? F.in[I_XP] + (size_t)m * DM : F.in[I_XS] + (size_t)(m - TP) * DM; const GAS f32x4* xr = (const GAS f32x4*)xrow + F.lane;
#pragma unroll
            for (int j = 0; j < 4; ++j) v[rr][j] = xr[64 * j]; }
#pragma unroll
        for (int rr = 0; rr < 2; ++rr) { const int m = m0 + rr; GAS v2u* o8 = (GAS v2u*)(H + (size_t)m * DM) + F.lane; float s = 0.f;
#pragma unroll
            for (int j = 0; j < 4; ++j) { const f32x4 x = v[rr][j]; s += (x.x * x.x + x.y * x.y) + (x.z * x.z + x.w * x.w); o8[64 * j] = (v2u){pk2(x.x, x.y), pk2(x.z, x.w)}; }
            s = wave_sum(s);
            if (F.lane == 0) ((GAS unsigned long long*)SSQ)[m] = (unsigned long long)(s * 1048576.0f); }
    }
}
DI void t_norm(Frame& F, const float* g, bool fin) {
    const int gw = F.vcu * NWAVES + F.wave, NGW = F.G * NWAVES;
    const bf16* H = (const bf16*)(F.ws + WS_H);
    for (int m0 = 2 * gw; m0 < MV; m0 += 2 * NGW) {
        v4u w[2][2];
#pragma unroll
        for (int rr = 0; rr < 2; ++rr) { const GAS v4u* hr = (const GAS v4u*)(H + (size_t)(m0 + rr) * DM) + F.lane; w[rr][0] = hr[0]; w[rr][1] = hr[64]; }
#pragma unroll
        for (int rr = 0; rr < 2; ++rr) { float x[2][8]; float s = 0.f;
#pragma unroll
            for (int j = 0; j < 2; ++j)
#pragma unroll
                for (int e = 0; e < 4; ++e) { x[j][2 * e] = __uint_as_float(w[rr][j][e] << 16); x[j][2 * e + 1] = __uint_as_float(w[rr][j][e] & 0xffff0000u); s += x[j][2 * e] * x[j][2 * e] + x[j][2 * e + 1] * x[j][2 * e + 1]; }
            const float rstd = 1.f / sqrtf(wave_sum(s) * (1.f / DM) + EPS);
            GAS f32x4* yo = (GAS f32x4*)(F.out + (size_t)(m0 + rr) * DM);
#pragma unroll
            for (int j = 0; j < 2; ++j) { const int c0 = 512 * j + 8 * F.lane; const f32x4 g0 = *(const GAS f32x4*)(g + c0), g1 = *(const GAS f32x4*)(g + c0 + 4);
                yo[(c0 >> 2)] = (f32x4){x[j][0] * rstd * g0.x, x[j][1] * rstd * g0.y, x[j][2] * rstd * g0.z, x[j][3] * rstd * g0.w};
                yo[(c0 >> 2) + 1] = (f32x4){x[j][4] * rstd * g1.x, x[j][5] * rstd * g1.y, x[j][6] * rstd * g1.z, x[j][7] * rstd * g1.w}; }
        }
    }
}
DI void t_even_mix(Frame& F, int i) {
    const bf16* PROJ = (const bf16*)(F.ws + WS_PROJ); bf16* MIX = (bf16*)(F.ws + WS_MIX);
    const int c8 = F.tid & 127, sub = F.tid >> 7, ch = c8 * 8, w = 2 << (ch >> 8);
    float cw0[8], cw1[8], cw2[8], psc[8];
    ld8f(F.in[I_CONVW] + (size_t)(i * 3 + 0) * DM + ch, cw0); ld8f(F.in[I_CONVW] + (size_t)(i * 3 + 1) * DM + ch, cw1); ld8f(F.in[I_CONVW] + (size_t)(i * 3 + 2) * DM + ch, cw2);
    ld8f(F.in[I_POOLS] + (size_t)i * DM + ch, psc);
    for (int item = F.vcu * 512 + F.tid; item < (TP / 16) * 128; item += F.G * 512) {
        const int run = item >> 7, t0 = run * 16, b = t0 >> 11, tt0 = t0 & 2047;
        const bf16* pr0 = PROJ + (size_t)t0 * EVEN_P;
        float S[8], cv1[8], cv2[8], tmp[8], cg[8], vv[8];
#pragma unroll
        for (int j = 0; j < 8; ++j) { S[j] = 0.f; cv1[j] = 0.f; cv2[j] = 0.f; }
        if (tt0 > 0) {
            for (int k = 1; k < w; ++k) { ld8(pr0 - (size_t)k * EVEN_P + ch, tmp);
#pragma unroll
                for (int j = 0; j < 8; ++j) S[j] += tmp[j]; }
            ld8(pr0 - EVEN_P + 2048 + ch, cv1);
            ld8(pr0 - 2 * EVEN_P + 2048 + ch, cv2);
        }
        if (tt0 > 0 && tt0 + 16 <= SEQ - 15) {
            const float inv = 1.0f / (float)w;
#pragma unroll 4
            for (int k = 0; k < 16; ++k) {
                const size_t t = (size_t)t0 + k; const bf16* pr = pr0 + (size_t)k * EVEN_P;
                float u0[8], uo[8], gp[8], bg[8], cv0[8];
                ld8(pr + ch, u0); ld8(pr + 1024 + ch, gp); ld8(pr + 2048 + ch, cv0); ld8(pr + 3072 + ch, bg); ld8(pr - (size_t)(w - 1) * EVEN_P + ch, uo);
#pragma unroll
                for (int j = 0; j < 8; ++j) { S[j] += u0[j]; tmp[j] = (S[j] * inv - u0[j]) * psc[j] * silu(gp[j]); S[j] -= uo[j]; }
                st8(MIX + t * DIN + ch, tmp);
#pragma unroll
                for (int j = 0; j < 8; ++j) { tmp[j] = bg[j] * (cw0[j] * cv2[j] + cw1[j] * cv1[j] + cw2[j] * cv0[j]); cv2[j] = cv1[j]; cv1[j] = cv0[j]; }
                st8(MIX + t * DIN + 1024 + ch, tmp);
            }
        } else {
#pragma unroll 2
        for (int k = 0; k < 16; ++k) {
            const int tt = tt0 + k; const size_t t = (size_t)t0 + k; const bf16* pr = pr0 + (size_t)k * EVEN_P;
            float u0[8], uo[8], gp[8], bg[8], cv0[8];
            ld8(pr + ch, u0); ld8(pr + 1024 + ch, gp); ld8(pr + 2048 + ch, cv0); ld8(pr + 3072 + ch, bg);
            const bool drop = tt - (w - 1) >= 0;
            if (drop) ld8(pr - (size_t)(w - 1) * EVEN_P + ch, uo);
            const float inv = 1.0f / (float)(tt + 1 < w ? tt + 1 : w);
#pragma unroll
            for (int j = 0; j < 8; ++j) { S[j] += u0[j]; tmp[j] = (S[j] * inv - u0[j]) * psc[j] * silu(gp[j]); if (drop) S[j] -= uo[j]; }
            st8(MIX + t * DIN + ch, tmp);
#pragma unroll
            for (int j = 0; j < 8; ++j) { tmp[j] = bg[j] * (cw0[j] * cv2[j] + cw1[j] * cv1[j] + cw2[j] * cv0[j]); cv2[j] = cv1[j]; cv1[j] = cv0[j]; }
            st8(MIX + t * DIN + 1024 + ch, tmp);
            if (tt >= SEQ - 2) st8f(F.out + OUT_CP + ((size_t)(i * NBATCH + b) * 2 + (tt - (SEQ - 2))) * DM + ch, cv0);
        }
        }
    }
    LAS float* DF = (LAS float*)F.lds;
    const bf16* WTP = (const bf16*)(F.ws + WS_WTP) + (size_t)i * 4 * 65536;
    for (int it = F.vcu; it < (NSMP / 4) * 8; it += F.G) {
        const int rq = it >> 3, os = it & 7, bb = rq * 4 + sub; const size_t row = TP + bb;
        const bf16* pr = PROJ + (size_t)TP * EVEN_P + (size_t)bb * EVEN_IN;
        const int pA = 2048 + (ch >> 7) * 256 + (ch & 127), pB = pA + 2048;
        const float* pref = F.in[I_SPOOL] + ((size_t)(i * NSMP + bb) * 15) * DM + ch;
        float* pso = F.out + OUT_PS + ((size_t)(i * NSMP + bb) * 15) * DM + ch;
        float u0[8], sum[8], tmp[8];
        ld8(pr + ch, u0);
#pragma unroll
        for (int j = 0; j < 8; ++j) sum[j] = u0[j];
        for (int k = 0; k < 15; ++k) { ld8f(pref + (size_t)k * DM, tmp);
            if (os == 0 && k >= 1) st8f(pso + (size_t)(k - 1) * DM, tmp);
            if (15 - k < w) {
#pragma unroll
                for (int j = 0; j < 8; ++j) sum[j] += tmp[j]; } }
        const float inv = 1.0f / (float)w;
#pragma unroll
        for (int j = 0; j < 8; ++j) DF[sub * 1024 + ch + j] = sum[j] * inv - u0[j];
        if (os == 0) {
            st8f(pso + (size_t)14 * DM, u0);
            float cg[8], vv[8], cv0[8], p0[8], p1[8], bg[8], gc[8];
            ld8(pr + pA, cg); ld8(pr + pA + 128, vv);
#pragma unroll
            for (int j = 0; j < 8; ++j) cv0[j] = cg[j] * vv[j];
            ld8f(F.in[I_SCONV] + ((size_t)(i * NSMP + bb) * 2 + 0) * DM + ch, p0); ld8f(F.in[I_SCONV] + ((size_t)(i * NSMP + bb) * 2 + 1) * DM + ch, p1);
            ld8(pr + pB, bg); ld8(pr + pB + 128, gc);
#pragma unroll
            for (int j = 0; j < 8; ++j) tmp[j] = bg[j] * (cw0[j] * p0[j] + cw1[j] * p1[j] + cw2[j] * cv0[j]) * silu(gc[j]);
            st8(MIX + row * DIN + 1024 + ch, tmp);
            st8f(F.out + OUT_CS + ((size_t)(i * NSMP + bb) * 2 + 0) * DM + ch, p1); st8f(F.out + OUT_CS + ((size_t)(i * NSMP + bb) * 2 + 1) * DM + ch, cv0);
        }
        __syncthreads();
        {   const int n = os * 128 + (F.tid & 127), gg = n >> 8; const LAS float* dfr = DF + sub * 1024 + gg * 256; const bf16* wr = WTP + (size_t)gg * 65536 + (size_t)(n & 255) * 256;
            float acc = 0.f;
#pragma unroll 16
            for (int k0 = 0; k0 < 256; k0 += 8) { float wv[8]; ld8(wr + k0, wv); const f32x4 d0 = *(const LAS f32x4*)(dfr + k0), d1 = *(const LAS f32x4*)(dfr + k0 + 4);
                acc += (d0[0] * wv[0] + d0[1] * wv[1]) + (d0[2] * wv[2] + d0[3] * wv[3]) + (d1[0] * wv[4] + d1[1] * wv[5]) + (d1[2] * wv[6] + d1[3] * wv[7]); }
            const float gpv = bf1(((const GAS bf16*)pr)[1024 + n]), sc = ((const GAS float*)F.in[I_POOLS])[(size_t)i * DM + n];
            ((GAS bf16*)MIX)[row * DIN + n] = (bf16)f2bf(acc * sc * silu(gpv));
        }
        __syncthreads();
    }
}
DI void t_conv(Frame& F, int i) {
    const bf16* PROJ = (const bf16*)(F.ws + WS_PROJ); bf16* CONVX = (bf16*)(F.ws + WS_CONVX); float* DT = (float*)(F.ws + WS_DT);
    const int gt = F.vcu * 512 + F.tid, NGT = F.G * 512;
    const float* cwp = F.in[I_SCW] + (size_t)i * 4 * CONVD; const float* cbp = F.in[I_SCB] + (size_t)i * CONVD;
    for (int idx = gt; idx < (TP / 16) * 384; idx += NGT) {
        const int run = idx / 384, c8 = idx - run * 384, ch = c8 * 8, t0 = run * 16, tt0 = t0 & 2047, b = t0 >> 11;
        const bf16* pr0 = PROJ + (size_t)t0 * ODD_INP + 2048 + ch;
        float w0[8], w1[8], w2[8], w3[8], bb[8], x0[8], x1[8], x2[8];
        ld8f(cwp + ch, w0); ld8f(cwp + CONVD + ch, w1); ld8f(cwp + 2 * CONVD + ch, w2); ld8f(cwp + 3 * CONVD + ch, w3); ld8f(cbp + ch, bb);
        if (tt0 > 0) { ld8(pr0 - 3 * ODD_INP, x0); ld8(pr0 - 2 * ODD_INP, x1); ld8(pr0 - ODD_INP, x2); }
        else {
#pragma unroll
            for (int j = 0; j < 8; ++j) { x0[j] = 0.f; x1[j] = 0.f; x2[j] = 0.f; } }
        v4u xr[16];
#pragma unroll
        for (int k = 0; k < 16; ++k) xr[k] = *(const GAS v4u*)(pr0 + (size_t)k * ODD_INP);
#pragma unroll
        for (int k = 0; k < 16; ++k) {
            float x3[8], acc[8]; unpack8(xr[k], x3);
#pragma unroll
            for (int j = 0; j < 8; ++j) { acc[j] = silu(bb[j] + w0[j] * x0[j] + w1[j] * x1[j] + w2[j] * x2[j] + w3[j] * x3[j]); x0[j] = x1[j]; x1[j] = x2[j]; x2[j] = x3[j]; }
            st8(CONVX + (size_t)(t0 + k) * CONVD + ch, acc);
            const int tt = tt0 + k;
            if (tt >= SEQ - 3) st8f(F.out + OUT_SCP + ((size_t)(i * NBATCH + b) * 3 + (tt - (SEQ - 3))) * CONVD + ch, x3);
        }
    }
    for (int idx = gt; idx < NSMP * 384; idx += NGT) {
        const int bb = idx / 384, c8 = idx - bb * 384, ch = c8 * 8; const size_t row = TP + bb;
        const float* st = F.in[I_SSCONV] + ((size_t)(i * NSMP + bb) * 3) * CONVD + ch; float* so = F.out + OUT_SCS + ((size_t)(i * NSMP + bb) * 3) * CONVD + ch;
        float x3[8], s0[8], s1[8], s2[8], acc[8], w[8];
        ld8(PROJ + row * ODD_INP + 2048 + ch, x3); ld8f(st, s0); ld8f(st + CONVD, s1); ld8f(st + 2 * CONVD, s2);
        ld8f(cbp + ch, acc);
        ld8f(cwp + ch, w);
#pragma unroll
        for (int j = 0; j < 8; ++j) acc[j] += w[j] * s0[j];
        ld8f(cwp + CONVD + ch, w);
#pragma unroll
        for (int j = 0; j < 8; ++j) acc[j] += w[j] * s1[j];
        ld8f(cwp + 2 * CONVD + ch, w);
#pragma unroll
        for (int j = 0; j < 8; ++j) acc[j] += w[j] * s2[j];
        ld8f(cwp + 3 * CONVD + ch, w);
#pragma unroll
        for (int j = 0; j < 8; ++j) acc[j] = silu(acc[j] + w[j] * x3[j]);
        st8(CONVX + row * CONVD + ch, acc);
        st8f(so, s1); st8f(so + CONVD, s2); st8f(so + 2 * CONVD, x3);
    }
}
DI void t_gnorm(Frame& F, int i) {
    const int gw = F.vcu * NWAVES + F.wave, NGW = F.G * NWAVES;
    const bf16* YG = (const bf16*)(F.ws + WS_YG); bf16* MIX = (bf16*)(F.ws + WS_MIX); const float* nw = F.in[I_SNORM] + (size_t)i * DIN;
    for (int m = gw; m < MV; m += NGW) {
#pragma unroll
        for (int j = 0; j < 4; ++j) { float f[8], g[8]; const int ch = (F.lane + 64 * j) * 8;
            ld8(YG + (size_t)m * DIN + ch, f); float s = 0.f;
#pragma unroll
            for (int k = 0; k < 8; ++k) s += f[k] * f[k];
            const float rstd = 1.f / sqrtf(wave_sum(s) * (1.f / 512.f) + EPS);
            ld8f(nw + ch, g);
#pragma unroll
            for (int k = 0; k < 8; ++k) f[k] = f[k] * rstd * g[k];
            st8(MIX + (size_t)m * DIN + ch, f); }
    }
}
DI void t_sattn(Frame& F, int l) {
    const bf16* Q = (const bf16*)(F.ws + WS_Q); bf16* O = (bf16*)(F.ws + WS_O);
    LAS float* SC = (LAS float*)F.lds; LAS float* RED = (LAS float*)(F.lds + 4096);
    const int hd = F.lane >> 5, l32 = F.lane & 31;
    const float c2 = 0.0625f * 1.44269504089f;
#define SA_LOAD(buf, base, r0) do { _Pragma("unroll") for (int u = 0; u < 8; ++u) { buf[u][0] = *(const GAS f32x4*)((base) + (size_t)((r0) + u) * DM); buf[u][1] = *(const GAS f32x4*)((base) + (size_t)((r0) + u) * DM + 4); } } while (0)
#define SA_DOT(buf, r0) do { _Pragma("unroll") for (int u = 0; u < 8; ++u) { float d = (q[0] * buf[u][0][0] + q[1] * buf[u][0][1]) + (q[2] * buf[u][0][2] + q[3] * buf[u][0][3]) + (q[4] * buf[u][1][0] + q[5] * buf[u][1][1]) + (q[6] * buf[u][1][2] + q[7] * buf[u][1][3]); \
        _Pragma("unroll") for (int o = 1; o < 32; o <<= 1) d += __shfl_xor(d, o); if (l32 == 0) SC[hd * 256 + (r0) + u] = d; } } while (0)
#define SA_PV(buf, r0) do { _Pragma("unroll") for (int u = 0; u < 8; ++u) { const float p = __builtin_amdgcn_exp2f((SC[hd * 256 + (r0) + u] - mx) * c2) * inv; \
        acc[0] += p * buf[u][0][0]; acc[1] += p * buf[u][0][1]; acc[2] += p * buf[u][0][2]; acc[3] += p * buf[u][0][3]; acc[4] += p * buf[u][1][0]; acc[5] += p * buf[u][1][1]; acc[6] += p * buf[u][1][2]; acc[7] += p * buf[u][1][3]; } } while (0)
    for (int it = F.vcu; it < 256; it += F.G) {
        const int b = it >> 1, hp = it & 1, w0 = F.wave * 32;
        const float* Kc = F.in[I_CK] + ((size_t)(l * NSMP + b) * NMEM) * DM + hp * 512 + F.lane * 8;
        const float* Vc = F.in[I_CV] + ((size_t)(l * NSMP + b) * NMEM) * DM + hp * 512 + F.lane * 8;
        f32x4 A[8][2], B[8][2];
        SA_LOAD(A, Kc, w0); SA_LOAD(B, Kc, w0 + 8);
        float q[8]; ld8(Q + (size_t)(TP + b) * DM + hp * 512 + F.lane * 8, q);
        SA_DOT(A, w0); SA_LOAD(A, Kc, w0 + 16);
        SA_DOT(B, w0 + 8); SA_LOAD(B, Kc, w0 + 24);
        SA_DOT(A, w0 + 16); SA_LOAD(A, Vc, w0);
        SA_DOT(B, w0 + 24); SA_LOAD(B, Vc, w0 + 8);
        __syncthreads();
        float mx = -3.0e38f;
#pragma unroll
        for (int j = 0; j < 8; ++j) mx = fmaxf(mx, SC[hd * 256 + l32 * 8 + j]);
#pragma unroll
        for (int o = 1; o < 32; o <<= 1) mx = fmaxf(mx, __shfl_xor(mx, o));
        float sm = 0.f;
#pragma unroll
        for (int j = 0; j < 8; ++j) sm += __builtin_amdgcn_exp2f((SC[hd * 256 + l32 * 8 + j] - mx) * c2);
#pragma unroll
        for (int o = 1; o < 32; o <<= 1) sm += __shfl_xor(sm, o);
        const float inv = 1.0f / sm;
        float acc[8];
#pragma unroll
        for (int j = 0; j < 8; ++j) acc[j] = 0.f;
        SA_PV(A, w0); SA_LOAD(A, Vc, w0 + 16);
        SA_PV(B, w0 + 8); SA_LOAD(B, Vc, w0 + 24);
        SA_PV(A, w0 + 16); SA_PV(B, w0 + 24);
#pragma unroll
        for (int j = 0; j < 8; ++j) RED[F.wave * 512 + F.lane * 8 + j] = acc[j];
        __syncthreads();
        float o = 0.f;
#pragma unroll
        for (int w = 0; w < 8; ++w) o += RED[w * 512 + F.tid];
        ((GAS bf16*)O)[(size_t)(TP + b) * DM + hp * 512 + F.tid] = (bf16)f2bf(o);
        __syncthreads();
    }
#undef SA_LOAD
#undef SA_DOT
#undef SA_PV
}
struct MiniBf16 { bf16* O; int ldc; const unsigned long long* ssq;
    DI void operator()(const f32x4 acc, size_t row, int col) const { const float rs = ssq ? 1.0f / sqrtf((float)((const GAS unsigned long long*)ssq)[row] * (1.0f / (1024.0f * 1048576.0f)) + EPS) : 1.0f;
        *(GAS v2u*)(O + row * ldc + col) = (v2u){pk2(acc[0] * rs, acc[1] * rs), pk2(acc[2] * rs, acc[3] * rs)}; } };
struct MiniResAdd { bf16* Xb; unsigned long long* ssq;
    DI void operator()(const f32x4 acc, size_t row, int col) const { GAS v2u* p = (GAS v2u*)(Xb + row * 1024 + col); const v2u w = *p;
        const float x[4] = {__uint_as_float(w[0] << 16) + acc[0], __uint_as_float(w[0] & 0xffff0000u) + acc[1], __uint_as_float(w[1] << 16) + acc[2], __uint_as_float(w[1] & 0xffff0000u) + acc[3]};
        *p = (v2u){pk2(x[0], x[1]), pk2(x[2], x[3])};
        float sq = (x[0] * x[0] + x[1] * x[1]) + (x[2] * x[2] + x[3] * x[3]); sq += __shfl_xor(sq, 16); sq += __shfl_xor(sq, 32);
        if ((col & 15) == 0) atomicAdd(ssq + row, (unsigned long long)(sq * 1048576.0f)); } };
struct MiniPoolState { float* out; const unsigned long long* ssq;
    DI void operator()(const f32x4 acc, size_t row, int col) const { const int b = (int)(row >> 11), j = (int)(row & 2047) - (SEQ - 15); if (j < 0) return;
        const float rs = 1.0f / sqrtf((float)((const GAS unsigned long long*)ssq)[row] * (1.0f / (1024.0f * 1048576.0f)) + EPS);
        *(GAS f32x4*)(out + ((size_t)b * 15 + j) * DM + col) = acc * rs; } };
struct MiniPoolGate { bf16* O; int ldc; const bf16* gate; int ldg; const float* scale;
    DI void operator()(const f32x4 acc, size_t row, int c) const { const f32x4 sc = *(const GAS f32x4*)(scale + c); const v2u gw = *(const GAS v2u*)(gate + row * ldg + c);
        *(GAS v2u*)(O + row * ldc + c) = (v2u){pk2(acc[0] * sc[0] * silu(bflo(gw.x)), acc[1] * sc[1] * silu(bfhi(gw.x))), pk2(acc[2] * sc[2] * silu(bflo(gw.y)), acc[3] * sc[3] * silu(bfhi(gw.y)))}; } };
template <int KB  , class Epi> DI void mini_gemm(Frame& F, const bf16* A  , int lda, const bf16* Bt, int ldb, int K, int nCB, const Epi& E, int shift, const float* gssq = nullptr  , int rbase = TP, int rstride = 16  ) {
    const int NGW = F.G * NWAVES; int vc = F.vcu - shift; vc = vc < 0 ? vc + F.G : vc; const int gw = F.wave * F.G + vc;
    const int fr = F.lane & 15, fq = F.lane >> 4;
    for (int u = gw; u < 8 * nCB; u += NGW) {
        const int rb = u & 7, cb = u >> 3;
        const size_t grow = (size_t)rbase + (size_t)rb * rstride + fr;
        const bf16* ap = A + grow * lda + 8 * fq;
        const bf16* bp = Bt + (size_t)(16 * cb + fr) * ldb + 8 * fq;
        f32x4 acc = (f32x4){0.f, 0.f, 0.f, 0.f};
        float rg[4] = {1.f, 1.f, 1.f, 1.f};
        if (gssq) { const GAS float* q = (const GAS float*)gssq + grow;
#pragma unroll
            for (int gi = 0; gi < 4; ++gi) { float a = 0.f;
#pragma unroll
                for (int e = 0; e < 8; ++e) a += q[(size_t)(gi * 8 + e) * MP];
                rg[gi] = 1.0f / sqrtf(a * (1.0f / 512.0f) + EPS); } }
        {
            const int ns = K >> 8;
            bf16x8 a[3][8], b[3][8];
#define MG_LOAD(buf, st) do { _Pragma("unroll") for (int s2 = 0; s2 < 8; ++s2) { a[buf][s2] = *(const GAS bf16x8*)(ap + (st) * 256 + 32 * s2); b[buf][s2] = *(const GAS bf16x8*)(bp + (st) * 256 + 32 * s2); } } while (0)
            MG_LOAD(0, 0); MG_LOAD(1, 1); MG_LOAD(2, 2);
#pragma unroll
            for (int st = 0; st < 8; ++st) if (st < ns) {
                if (gssq && st > 0 && (st & 1) == 0) { const int gi = st >> 1; acc = acc * (gi == 1 ? rg[0] / rg[1] : gi == 2 ? rg[1] / rg[2] : rg[2] / rg[3]); }
#pragma unroll
                for (int s2 = 0; s2 < 8; ++s2) acc = __builtin_amdgcn_mfma_f32_16x16x32_bf16(b[st % 3][s2], a[st % 3][s2], acc, 0, 0, 0);
                if (st + 3 < ns) MG_LOAD(st % 3, st + 3);
            }
#undef MG_LOAD
        }
        if (gssq) acc = acc * rg[3];
        E(acc, grow, 16 * cb + 4 * fq);
    }
}

DI void dt_gemm(Frame& F, const bf16* A, const bf16* Bt  , const unsigned long long* ssq, float* out  , const float* dtb  ) {
    const int NGW = F.G * NWAVES, gw = F.wave * F.G + F.vcu, fr = F.lane & 15, fq = F.lane >> 4;
    for (int u = gw; u < MV / 16; u += NGW) {
        const size_t row = (size_t)u * 16 + fr;
        const bf16* ap = A + row * DM + 8 * fq; const bf16* bp0 = Bt + (size_t)fr * DM + 8 * fq; const bf16* bp1 = bp0 + 16 * DM;
        f32x4 acc0 = (f32x4){0.f, 0.f, 0.f, 0.f}, acc1 = acc0;
        {
            bf16x8 a[2][8], b0[2][8], b1[2][8];
#define DG_LOAD(buf, st) do { _Pragma("unroll") for (int s2 = 0; s2 < 8; ++s2) { a[buf][s2] = *(const GAS bf16x8*)(ap + (st) * 256 + 32 * s2); b0[buf][s2] = *(const GAS bf16x8*)(bp0 + (st) * 256 + 32 * s2); b1[buf][s2] = *(const GAS bf16x8*)(bp1 + (st) * 256 + 32 * s2); } } while (0)
            DG_LOAD(0, 0); DG_LOAD(1, 1);
#pragma unroll
            for (int st = 0; st < 4; ++st) {
#pragma unroll
                for (int s2 = 0; s2 < 8; ++s2) { acc0 = __builtin_amdgcn_mfma_f32_16x16x32_bf16(b0[st & 1][s2], a[st & 1][s2], acc0, 0, 0, 0); acc1 = __builtin_amdgcn_mfma_f32_16x16x32_bf16(b1[st & 1][s2], a[st & 1][s2], acc1, 0, 0, 0); }
                if (st + 2 < 4) DG_LOAD(st & 1, st + 2);
            }
#undef DG_LOAD
        }
        const float rs = 1.0f / sqrtf((float)((const GAS unsigned long long*)ssq)[row] * (1.0f / (1024.0f * 1048576.0f)) + EPS);
#pragma unroll
        for (int j = 0; j < 4; ++j) { const float x0 = acc0[j] * rs + ((const GAS float*)dtb)[4 * fq + j], x1 = acc1[j] * rs + ((const GAS float*)dtb)[16 + 4 * fq + j];
            ((GAS float*)out)[(size_t)(4 * fq + j) * MP + row] = x0 > 20.f ? x0 : log1pf(__expf(x0)); ((GAS float*)out)[(size_t)(16 + 4 * fq + j) * MP + row] = x1 > 20.f ? x1 : log1pf(__expf(x1)); }
    }
}

#define MFMA32(a, b, c) __builtin_amdgcn_mfma_f32_32x32x16_bf16((a), (b), (c), 0, 0, 0)
typedef short s16x4 __attribute__((ext_vector_type(4)));
constexpr int RS = 272;
DI bf16x8 frag_row(const LAS unsigned char* rowbase  , int ks) { return *(const LAS bf16x8*)(rowbase + ks * 32); }
DI bf16x8 frag_tr(const LAS unsigned char* trbase, int krow0, int c) {
    const s16x4 lo = __builtin_amdgcn_ds_read_tr16_b64_v4i16((LAS s16x4*)(trbase + krow0 * RS + c * 64));
    const s16x4 hi = __builtin_amdgcn_ds_read_tr16_b64_v4i16((LAS s16x4*)(trbase + (krow0 + 4) * RS + c * 64));
    return (bf16x8){lo[0], lo[1], lo[2], lo[3], hi[0], hi[1], hi[2], hi[3]};
}
DI void ssd_prompt_item(Frame& F, int i, int b, int head, float* ssqh) {
    LAS unsigned char* BM = F.lds;
    LAS unsigned char* CM = F.lds + 128 * RS;
    LAS unsigned char* LL = F.lds + 256 * RS;
    LAS unsigned char* XD = F.lds + 384 * RS;
    LAS unsigned char* SB = F.lds + 448 * RS;
    LAS unsigned char* XE = F.lds + 512 * RS;
    LAS float* DTL = (LAS float*)(F.lds + 576 * RS + 2048);
    LAS float* ACSB = (LAS float*)(F.lds + 576 * RS);
    const bf16* CONVX = (const bf16*)(F.ws + WS_CONVX); const bf16* PROJ = (const bf16*)(F.ws + WS_PROJ); const float* DT = (const float*)(F.ws + WS_DT); bf16* YG = (bf16*)(F.ws + WS_YG);
    const int w = F.wave, g = head >> 3, lb = w & 3, pb = w >> 2;
    const float Ah = -__expf(((const GAS float*)F.in[I_ALOG])[i * 32 + head]), Dh = ((const GAS float*)F.in[I_DSKIP])[i * 32 + head];
    f32x16 st;
#pragma unroll
    for (int k = 0; k < 16; ++k) st[k] = 0.f;
    for (int idx = F.tid; idx < 64 * RS / 16; idx += 512) *(LAS v4u*)(SB + idx * 16) = (v4u){0u, 0u, 0u, 0u};
    v4u vb[4], vc[4], vx[2], zt[2]; float dtx[2]; float d0 = 0.f, d1 = 0.f;
#define SSD_ISSUE(cc) do { const size_t r0_ = (size_t)b * SEQ + (size_t)(cc) * 128; \
        _Pragma("unroll") for (int i4 = 0; i4 < 4; ++i4) { const int q_ = F.tid + 512 * i4, s_ = q_ >> 4, ch_ = q_ & 15; const bf16* src_ = CONVX + (r0_ + s_) * CONVD + 2048 + g * 128 + ch_ * 8; \
            vb[i4] = *(const GAS v4u*)src_; vc[i4] = *(const GAS v4u*)(src_ + 512); } \
        _Pragma("unroll") for (int i2 = 0; i2 < 2; ++i2) { const int q_ = F.tid + 512 * i2, s_ = q_ >> 3, ch_ = q_ & 7; vx[i2] = *(const GAS v4u*)(CONVX + (r0_ + s_) * CONVD + head * 64 + ch_ * 8); \
            dtx[i2] = ((const GAS float*)DT)[(size_t)head * MP + r0_ + s_]; } \
        } while (0)
#define SSD_SCAN(cc) do { if (w == 0) { const int ln_ = F.lane; float a0 = d0 * Ah * 1.44269504089f, a1 = d1 * Ah * 1.44269504089f; \
        _Pragma("unroll") for (int o = 1; o < 64; o <<= 1) { const float t0 = __shfl_up(a0, o), t1 = __shfl_up(a1, o); if (ln_ >= o) { a0 += t0; a1 += t1; } } \
        a1 += __shfl(a0, 63); const float al_ = __shfl(a1, 63); LAS float* A_ = ACSB + ((cc) & 1) * 256; \
        A_[ln_] = a0; A_[ln_ + 64] = a1; A_[128 + ln_] = __builtin_amdgcn_exp2f(al_ - a0); A_[192 + ln_] = __builtin_amdgcn_exp2f(al_ - a1); } } while (0)
#define SSD_ISSUE_D(cc) do { const size_t r0_ = (size_t)b * SEQ + (size_t)(cc) * 128; d0 = ((const GAS float*)DT)[(size_t)head * MP + r0_ + F.lane]; d1 = ((const GAS float*)DT)[(size_t)head * MP + r0_ + 64 + F.lane]; } while (0)
#define SSD_ISSUE_Z(cc) do { const size_t r0_ = (size_t)b * SEQ + (size_t)(cc) * 128; _Pragma("unroll") for (int i2 = 0; i2 < 2; ++i2) { const int q_ = F.tid + 512 * i2; zt[i2] = *(const GAS v4u*)(PROJ + (r0_ + (q_ >> 3)) * ODD_INP + head * 64 + (q_ & 7) * 8); } } while (0)
    SSD_ISSUE(0); SSD_ISSUE_D(0); SSD_ISSUE_Z(0);
    SSD_SCAN(0);
    SSD_ISSUE_D(1);
    __syncthreads();
#define SSD_BAR() asm volatile("s_waitcnt lgkmcnt(0)\n\ts_barrier" ::: "memory")
    for (int c = 0; c < 16; ++c) {
        const size_t row0 = (size_t)b * SEQ + (size_t)c * 128;
        int tid = F.tid; asm volatile("" : "+v"(tid));
        const int lane = tid & 63, r = lane & 31, h = lane >> 5;
        LAS float* ACS = ACSB + (c & 1) * 256; LAS float* TE = ACS + 128;
#pragma unroll
        for (int i4 = 0; i4 < 4; ++i4) { const int q = tid + 512 * i4, s = q >> 4, ch = q & 15;
            *(LAS v4u*)(BM + s * RS + ch * 16) = vb[i4]; *(LAS v4u*)(CM + s * RS + ch * 16) = vc[i4]; }
        {
#pragma unroll
            for (int i2 = 0; i2 < 2; ++i2) { const int q = tid + 512 * i2, s = q >> 3, ch = q & 7;
                const float dts = dtx[i2], tes = TE[s]; float f[8]; unpack8(vx[i2], f);
                if (ch == 0) DTL[s] = dts;
#pragma unroll
                for (int j = 0; j < 8; ++j) f[j] *= dts;
                *(LAS v4u*)(XD + (s & 63) * RS + ((s >> 6) * 8 + ch) * 16) = pack8(f);
#pragma unroll
                for (int j = 0; j < 8; ++j) f[j] *= tes;
                *(LAS v4u*)(XE + (s & 63) * RS + ((s >> 6) * 8 + ch) * 16) = pack8(f); } }
        SSD_ISSUE((c + 1 < 16 ? c + 1 : 15));
        SSD_BAR();
        if (c + 1 < 16) SSD_SCAN(c + 1);
        SSD_ISSUE_D((c + 2 < 16 ? c + 2 : 15));
        const int rowoff = r * RS + 16 * h;
        const int troff = (8 * h + ((lane & 15) >> 2)) * RS + (2 * ((lane >> 4) & 1) + ((lane & 3) >> 1)) * 16 + 8 * (lane & 1);
        const int l = lb * 32 + r; const float al = ACS[l];
        const f32x16 zero16 = {0.f, 0.f, 0.f, 0.f, 0.f, 0.f, 0.f, 0.f, 0.f, 0.f, 0.f, 0.f, 0.f, 0.f, 0.f, 0.f};
#define SSD_CHAIN8(acc, first, AF, BF) do { _Pragma("unroll") for (int kb_ = 0; kb_ < 8; kb_ += 4) { bf16x8 fa_[4], fb_[4]; \
            _Pragma("unroll") for (int j_ = 0; j_ < 4; ++j_) { const int ks = kb_ + j_; fa_[j_] = AF; fb_[j_] = BF; } \
            __builtin_amdgcn_sched_barrier(0); \
            _Pragma("unroll") for (int j_ = 0; j_ < 4; ++j_) acc = MFMA32(fa_[j_], fb_[j_], (first && kb_ == 0 && j_ == 0) ? zero16 : acc); } } while (0)
#pragma unroll
        for (int bi = 0; bi < 2; ++bi) { const int sb = 2 * pb + bi;
            if (sb <= lb) {
                f32x16 cb;
                SSD_CHAIN8(cb, true, frag_row(BM + sb * 32 * RS + rowoff, ks), frag_row(CM + lb * 32 * RS + rowoff, ks));
                if (sb < lb) {
#pragma unroll
                    for (int k = 0; k < 16; ++k) { const int s0 = sb * 32 + (k & 3) + 8 * (k >> 2) + 4 * h; cb[k] = cb[k] * __builtin_amdgcn_exp2f(al - ACS[s0]); }
                } else {
#pragma unroll
                    for (int k = 0; k < 16; ++k) { const int s0 = sb * 32 + (k & 3) + 8 * (k >> 2) + 4 * h; cb[k] = cb[k] * (__builtin_amdgcn_exp2f(fminf(al - ACS[s0], 0.f)) * (s0 <= l ? 1.f : 0.f)); }
                }
#pragma unroll
                for (int q4 = 0; q4 < 4; ++q4) *(LAS v2u*)(LL + l * RS + (sb * 4 + q4) * 16 + 8 * h) = (v2u){pk2(cb[4 * q4], cb[4 * q4 + 1]), pk2(cb[4 * q4 + 2], cb[4 * q4 + 3])};
            } }
        f32x16 yo;
        SSD_CHAIN8(yo, true, frag_row(SB + pb * 32 * RS + rowoff, ks), frag_row(CM + lb * 32 * RS + rowoff, ks));
        { const float dec = __builtin_amdgcn_exp2f(ACS[127]);
#pragma unroll
          for (int k = 0; k < 16; ++k) st[k] *= dec; }
        SSD_CHAIN8(st, false, frag_tr(BM + troff, 16 * ks, lb), frag_tr(XE + troff, 16 * (ks & 3), 2 * (ks >> 2) + pb));
        SSD_BAR();
        f32x16 yd = zero16;
        for (int sbk = 0; sbk <= lb; ++sbk) { bf16x8 fx[2], fl[2];
#pragma unroll
            for (int j = 0; j < 2; ++j) { const int ks = 2 * sbk + j; fx[j] = frag_tr(XD + troff, 16 * (ks & 3), 2 * (ks >> 2) + pb); fl[j] = frag_row(LL + lb * 32 * RS + rowoff, ks); }
            __builtin_amdgcn_sched_barrier(0);
            yd = MFMA32(fx[0], fl[0], yd); yd = MFMA32(fx[1], fl[1], yd); }
#undef SSD_CHAIN8
        { const float el = __builtin_amdgcn_exp2f(al);
#pragma unroll
          for (int q4 = 0; q4 < 4; ++q4) { const int p0 = pb * 32 + 8 * q4 + 4 * h;
              *(LAS f32x4*)(BM + l * RS + p0 * 4) = (f32x4){yd[4 * q4] + el * yo[4 * q4], yd[4 * q4 + 1] + el * yo[4 * q4 + 1], yd[4 * q4 + 2] + el * yo[4 * q4 + 2], yd[4 * q4 + 3] + el * yo[4 * q4 + 3]}; } }
        SSD_BAR();
#pragma unroll
        for (int i2 = 0; i2 < 2; ++i2) { const int q = tid + 512 * i2, tk = q >> 3, c16 = q & 7;
            const f32x4 ya = *(const LAS f32x4*)(BM + tk * RS + c16 * 32), yb = *(const LAS f32x4*)(BM + tk * RS + c16 * 32 + 16);
            float xf[8], zf[8], f[8]; unpack8(*(const LAS v4u*)(XD + (tk & 63) * RS + ((tk >> 6) * 64 + c16 * 8) * 2), xf); unpack8(zt[i2], zf);
            { const float rdt = Dh * __builtin_amdgcn_rcpf(DTL[tk]);
#pragma unroll
              for (int j = 0; j < 8; ++j) xf[j] *= rdt; }
            f[0] = (ya[0] + xf[0]) * silu(zf[0]); f[1] = (ya[1] + xf[1]) * silu(zf[1]); f[2] = (ya[2] + xf[2]) * silu(zf[2]); f[3] = (ya[3] + xf[3]) * silu(zf[3]);
            f[4] = (yb[0] + xf[4]) * silu(zf[4]); f[5] = (yb[1] + xf[5]) * silu(zf[5]); f[6] = (yb[2] + xf[6]) * silu(zf[6]); f[7] = (yb[3] + xf[7]) * silu(zf[7]);
            *(GAS v4u*)(YG + (row0 + tk) * DIN + head * 64 + c16 * 8) = pack8(f);
            float sq = (f[0] * f[0] + f[1] * f[1]) + (f[2] * f[2] + f[3] * f[3]) + (f[4] * f[4] + f[5] * f[5]) + (f[6] * f[6] + f[7] * f[7]);
            sq += __shfl_xor(sq, 1); sq += __shfl_xor(sq, 2); sq += __shfl_xor(sq, 4);
            if (c16 == 0) ((GAS float*)ssqh)[(size_t)head * MP + row0 + tk] = sq; }
        SSD_ISSUE_Z((c + 1 < 16 ? c + 1 : 15));
        SSD_BAR();
        { const int p = pb * 32 + r;
#pragma unroll
          for (int q4 = 0; q4 < 4; ++q4) *(LAS v2u*)(SB + p * RS + (lb * 4 + q4) * 16 + 8 * h) = (v2u){pk2(st[4 * q4], st[4 * q4 + 1]), pk2(st[4 * q4 + 2], st[4 * q4 + 3])}; }
    }
#undef SSD_BAR
#undef SSD_ISSUE
#undef SSD_ISSUE_Z
#undef SSD_ISSUE_D
#undef SSD_SCAN
    { const int r = F.lane & 31, h = F.lane >> 5; const int p = pb * 32 + r; float* so = F.out + OUT_SP + (((size_t)(i * NBATCH + b) * NHEAD + head) * 64 + p) * 128;
#pragma unroll
      for (int q4 = 0; q4 < 4; ++q4) { const int n0 = lb * 32 + 8 * q4 + 4 * h; *(GAS f32x4*)(so + n0) = (f32x4){st[4 * q4], st[4 * q4 + 1], st[4 * q4 + 2], st[4 * q4 + 3]}; } }
    __syncthreads();
}
DI void ssd_sample(Frame& F, int i, float* ssqh) {
    const bf16* CONVX = (const bf16*)(F.ws + WS_CONVX); const bf16* PROJ = (const bf16*)(F.ws + WS_PROJ); const float* DT = (const float*)(F.ws + WS_DT); bf16* YG = (bf16*)(F.ws + WS_YG);
    const int gw = F.vcu * NWAVES + F.wave, NGW = F.G * NWAVES, psub = F.lane >> 5, n4 = (F.lane & 31) * 4;
    for (int it = gw; it < NSMP * NHEAD; it += NGW) {
        const int b = it >> 5, head = it & 31, g = head >> 3; const size_t row = TP + b;
        const size_t sbase = (((size_t)(i * NSMP + b) * NHEAD + head) * 64) * 128 + n4;
        const float* sin = F.in[I_SSSM] + sbase + (size_t)psub * 128; float* sout = F.out + OUT_SS + sbase + (size_t)psub * 128;
        f32x4 s0[32];
#pragma unroll
        for (int pp = 0; pp < 32; ++pp) s0[pp] = *(const GAS f32x4*)(sin + (size_t)pp * 256);
        const float dt = ((const GAS float*)DT)[(size_t)head * MP + row], Ah = -__expf(((const GAS float*)F.in[I_ALOG])[i * 32 + head]), Dh = ((const GAS float*)F.in[I_DSKIP])[i * 32 + head];
        const float dA = __expf(dt * Ah);
        const v2u bw = *(const GAS v2u*)(CONVX + row * CONVD + 2048 + g * 128 + n4), cw = *(const GAS v2u*)(CONVX + row * CONVD + 2560 + g * 128 + n4);
        const f32x4 B4 = (f32x4){bflo(bw.x), bfhi(bw.x), bflo(bw.y), bfhi(bw.y)}, C4 = (f32x4){bflo(cw.x), bfhi(cw.x), bflo(cw.y), bfhi(cw.y)};
        const float xl = bf1(((const GAS bf16*)CONVX)[row * CONVD + head * 64 + F.lane]), zl = bf1(((const GAS bf16*)PROJ)[row * ODD_INP + head * 64 + F.lane]);
        float sq = 0.f;
#pragma unroll
        for (int pp = 0; pp < 32; ++pp) { const int p = 2 * pp + psub;
            const float xe = __shfl(xl, 2 * pp), xo = __shfl(xl, 2 * pp + 1), xv = psub ? xo : xe, dx = dt * xv;
            const f32x4 sn = s0[pp] * dA + B4 * dx; *(GAS f32x4*)(sout + (size_t)pp * 256) = sn;
            float d = (sn[0] * C4[0] + sn[1] * C4[1]) + (sn[2] * C4[2] + sn[3] * C4[3]);
#pragma unroll
            for (int o = 1; o < 32; o <<= 1) d += __shfl_xor(d, o);
            const float ze = __shfl(zl, 2 * pp), zo = __shfl(zl, 2 * pp + 1), z = psub ? zo : ze;
            if ((F.lane & 31) == 0) { const float yv = (d + Dh * xv) * silu(z); sq += yv * yv; ((GAS bf16*)YG)[row * DIN + head * 64 + p] = (bf16)f2bf(yv); } }
        sq += __shfl_xor(sq, 32);
        if (F.lane == 0) ((GAS float*)ssqh)[(size_t)head * MP + row] = sq;
    }
}

#if MK_PER_PHASE
#define GRID_BAR() do { } while (0)
#else
#define GRID_BAR() do { for (int rb_ = 0; rb_ < REP_BAR; ++rb_) xcd_barrier(bar); } while (0)
#endif
#ifdef DBG_ONLY
#define IN(k) (lo <= (k) && (k) < hi && ((((k) < 2) ? (k) : 2 + ((k) - 2) % 11) == DBG_ONLY))
#else
#define IN(k) (lo <= (k) && (k) < hi)
#endif
#ifndef AMP_MASK
#define AMP_MASK 0
#endif
#if AMP_MASK
#define AMP_CLS(k) ((k) < 2 ? (k) : ((((k) - 2) % 11) == 0 ? 2 : (((k) - 2) % 11) == 1 ? 3 : (((k) - 2) % 11) == 2 ? 4 : (((k) - 2) % 11) == 4 ? 5 : (((k) - 2) % 11) == 6 ? 6 : (((k) - 2) % 11) == 7 ? 7 : (((k) - 2) % 11) == 9 ? 8 : 9))
#undef IN
#define IN(k) (lo <= (k) && (k) < hi && ((amp_t0 = __builtin_amdgcn_s_memrealtime()), true))
#define AMP_END(k) do { if ((AMP_MASK >> AMP_CLS(k)) & 1) { __syncthreads(); const unsigned long long t1_ = __builtin_amdgcn_s_memrealtime(); const unsigned long long d_ = t1_ - amp_t0; while (__builtin_amdgcn_s_memrealtime() - t1_ < d_) __builtin_amdgcn_s_sleep(4); } } while (0)
#else
#define AMP_END(k) do { } while (0)
#endif
#if AMP_MASK
#define AMP_SUB_BEGIN() unsigned long long amp_s0 = __builtin_amdgcn_s_memrealtime()
#define AMP_SUB_END(cls) do { if ((AMP_MASK >> (cls)) & 1) { __syncthreads(); const unsigned long long t1_ = __builtin_amdgcn_s_memrealtime(); const unsigned long long d_ = t1_ - amp_s0; while (__builtin_amdgcn_s_memrealtime() - t1_ < d_) __builtin_amdgcn_s_sleep(4); } } while (0)
#else
#define AMP_SUB_BEGIN() do { } while (0)
#define AMP_SUB_END(cls) do { } while (0)
#endif
#define SEAM(k) do { AMP_END(k); if ((k) + 1 < hi) GRID_BAR(); } while (0)
#define REFRESH() do { int t_ = threadIdx.x; asm volatile("" : "+v"(t_)); F.tid = t_; F.lane = t_ & 63; } while (0)
constexpr int PH_PER_LAYER = 11, PH_LAYER0 = 2, N_PHASES = PH_LAYER0 + 4 * PH_PER_LAYER;
template <int l> DI void layer_phases(Frame& F, const int lo, const int hi, const XcdBarrier& bar) {
#if AMP_MASK
    unsigned long long amp_t0 = 0;
#endif
    unsigned char* ws = F.ws;
    LAS unsigned char* ring = F.lds;
    bf16* H = (bf16*)(ws + WS_H); bf16* Qb = (bf16*)(ws + WS_Q); bf16* Pb = (bf16*)(ws + WS_PB); bf16* Ob = (bf16*)(ws + WS_O); bf16* DIFF = (bf16*)(ws + WS_DIFF);
    bf16* MIX = (bf16*)(ws + WS_MIX); bf16* PROJ = (bf16*)(ws + WS_PROJ);
    const int c = (int)blockIdx.x;

    constexpr int pb = PH_LAYER0 + l * PH_PER_LAYER, i = l >> 1; constexpr bool evn = (l & 1) == 0;
    unsigned long long* SSQ = (unsigned long long*)(ws + WS_SSQ);
    constexpr size_t SSQ_I = (size_t)MV;
        if (IN(pb + 0)) {
            constexpr int N = evn ? EVEN_IN : ODD_INP;
            pg8::Gemm g{H, evn ? (const bf16*)(ws + WS_WTE_IN) + (size_t)i * EVEN_IN * DM : (const bf16*)(ws + WS_WTO_IN) + (size_t)i * ODD_WROWS * DM, DM, DM, DM};
            pg8::StaticOrder S; S.init(64, N / 256, F.G, c);
            if constexpr (evn) { pg8::EpiEvenIn E{PROJ, SSQ + (2 * l) * SSQ_I};
                for (int rep = 0; rep < REP_G1; ++rep) pg8::gemm_phase<pg8::EpiEvenIn, pg8::AddrStd, true, true>(ring, g, S, E, pg8::AddrStd{}); }
            else { pg8::EpiBf16S E{PROJ, N, SSQ + (2 * l) * SSQ_I};
                for (int rep = 0; rep < REP_G1; ++rep) pg8::gemm_phase<pg8::EpiBf16S, pg8::AddrStd, true, true>(ring, g, S, E, pg8::AddrStd{}); }
            REFRESH();
            if constexpr (evn) {
                const bf16* WTU = (const bf16*)(ws + WS_WTU) + (size_t)i * DM * DM;
                for (int rep = 0; rep < REP_MINI; ++rep) {
                bf16* PS = PROJ + (size_t)TP * EVEN_P - (size_t)TP * EVEN_IN;
                mini_gemm<16>(F, H, DM, WTU, DM, DM, 64, MiniBf16{PS, N, SSQ + (2 * l) * SSQ_I}, 0);
                mini_gemm<16>(F, H, DM, g.Bt + (size_t)1024 * DM, DM, DM, (N - 1024) / 16, MiniBf16{PS + 1024, N, SSQ + (2 * l) * SSQ_I}, 64);
                mini_gemm<16>(F, H, DM, WTU, DM, DM, 64, MiniPoolState{F.out + OUT_PP + (size_t)i * NBATCH * 15 * DM, SSQ + (2 * l) * SSQ_I}, 128, nullptr, SEQ - 16, SEQ); }
            } else {
                for (int rep = 0; rep < REP_MINI; ++rep) mini_gemm<16>(F, H, DM, g.Bt, DM, DM, N / 16, MiniBf16{PROJ, N, SSQ + (2 * l) * SSQ_I}, 0);
                dt_gemm(F, H, g.Bt + (size_t)ODD_INP * DM, SSQ + (2 * l) * SSQ_I, (float*)(ws + WS_DT), F.in[I_DTB] + (size_t)i * 32);
            }
            SEAM(pb + 0);
        }
        if (IN(pb + 1)) { REFRESH(); for (int rep = 0; rep < REP_THIN; ++rep) { if constexpr (evn) t_even_mix(F, i); else t_conv(F, i); } SEAM(pb + 1); }
        if constexpr (!evn) if (IN(pb + 2)) {
                REFRESH();
                const bool stream_first = (F.vcu & 1) != 0;
                if (stream_first) { for (int rep = 0; rep < REP_SSDS; ++rep) ssd_sample(F, i, rep == 0 ? (float*)(ws + WS_SSQH) + (size_t)i * 32 * MP : (float*)(ws + WS_DIFF)); __syncthreads(); }
                for (int rep = 0; rep < REP_SSD; ++rep) for (int it = F.vcu; it < NBATCH * NHEAD; it += F.G) ssd_prompt_item(F, i, it >> 5, it & 31, rep == 0 ? (float*)(ws + WS_SSQH) + (size_t)i * 32 * MP : (float*)(ws + WS_DIFF));
                if (!stream_first) { REFRESH(); for (int rep = 0; rep < REP_SSDS; ++rep) ssd_sample(F, i, rep == 0 ? (float*)(ws + WS_SSQH) + (size_t)i * 32 * MP : (float*)(ws + WS_DIFF)); }
            SEAM(pb + 2);
        }
        if (IN(pb + 4)) {
            bf16* YGb = (bf16*)(ws + WS_YG); const float* GSSQ = (const float*)(ws + WS_SSQH) + (size_t)i * 32 * MP;
            pg8::Gemm g{evn ? MIX : YGb, evn ? (const bf16*)(ws + WS_WTE_OUT) + (size_t)i * DM * 2048 : (const bf16*)(ws + WS_WTO_OUT) + (size_t)i * DM * 2048, DIN, DIN, DIN};
            pg8::StaticOrder S; S.init(64, 4, F.G, c);
            pg8::EpiResAdd E{H, SSQ + (2 * l + 1) * SSQ_I, 0};
            pg8::EpiResAdd E0{H, SSQ, hi > 9999 ? 0 : 1};
            if constexpr (evn) {
                for (int rep = 1; rep < REP_RES; ++rep) pg8::gemm_phase<pg8::EpiResAdd, pg8::AddrStd, true, true>(ring, g, S, E0, pg8::AddrStd{});
                pg8::gemm_phase<pg8::EpiResAdd, pg8::AddrStd, true, true>(ring, g, S, E, pg8::AddrStd{});
                REFRESH(); mini_gemm<16>(F, MIX, DIN, g.Bt, DIN, DIN, 64, MiniResAdd{H, SSQ + (2 * l + 1) * SSQ_I}, 0);
            } else {
                for (int rep = 1; rep < REP_RES; ++rep) pg8::gemm_phase<pg8::EpiResAdd, pg8::AddrStd, true, true, true>(ring, g, S, E0, pg8::AddrStd{}, GSSQ);
                pg8::gemm_phase<pg8::EpiResAdd, pg8::AddrStd, true, true, true>(ring, g, S, E, pg8::AddrStd{}, GSSQ);
                REFRESH(); mini_gemm<16>(F, YGb, DIN, g.Bt, DIN, DIN, 64, MiniResAdd{H, SSQ + (2 * l + 1) * SSQ_I}, 0, GSSQ);
            }
            SEAM(pb + 4);
        }
        if (IN(pb + 6)) {
            pg8::Gemm g{H, (const bf16*)(ws + WS_WTQ) + (size_t)l * DM * DM, DM, DM, DM};
            pg8::StaticOrder S; S.init(64, 4, F.G, c);
            pg8::EpiBf16S E{Qb, DM, SSQ + (2 * l + 1) * SSQ_I};
            for (int rep = 0; rep < REP_G4; ++rep) pg8::gemm_phase<pg8::EpiBf16S, pg8::AddrStd, true, true>(ring, g, S, E, pg8::AddrStd{});
            REFRESH(); for (int rep = 0; rep < REP_MINI; ++rep) mini_gemm<16>(F, H, DM, g.Bt, DM, DM, 64, MiniBf16{Qb, DM, SSQ + (2 * l + 1) * SSQ_I}, 0);
            SEAM(pb + 6);
        }
        if (IN(pb + 7)) {
            const bool stream_first = (F.vcu & 1) != 0;
            if (stream_first) { REFRESH(); AMP_SUB_BEGIN(); for (int rep = 0; rep < REP_SATTN; ++rep) t_sattn(F, l); __syncthreads(); AMP_SUB_END(10); }
            { pg8::Gemm g{Qb, (const bf16*)(ws + WS_KB) + (size_t)l * 2048 * DM, DM, DM, 256};
              pg8::StaticOrder S; S.init(64, 4, F.G, c);
              pg8::EpiSoftmax E{Pb, DM, 0.0625f * 1.44269504089f};
              for (int rep = 0; rep < REP_G5; ++rep) { pg8::gemm_phase<pg8::EpiSoftmax, pg8::AddrScore, false, true>(ring, g, S, E, pg8::AddrScore{}); __syncthreads(); } }
            asm volatile("s_waitcnt vmcnt(0)" ::: "memory"); __syncthreads();
            { pg8::Gemm g{Pb, (const bf16*)(ws + WS_VT) + (size_t)l * 8 * 1024 * 256, DM, 256, 256};
              pg8::StaticOrder S; S.init(64, 4, F.G, c);
              pg8::EpiBf16S E{Ob, DM, nullptr};
              for (int rep = 0; rep < REP_G6; ++rep) pg8::gemm_phase<pg8::EpiBf16S, pg8::AddrPV, true, true>(ring, g, S, E, pg8::AddrPV{}); }
            __syncthreads();
            if (!stream_first) { REFRESH(); AMP_SUB_BEGIN(); for (int rep = 0; rep < REP_SATTN; ++rep) t_sattn(F, l); AMP_SUB_END(10); }
            SEAM(pb + 7);
        }
        if (IN(pb + 9)) {
            pg8::Gemm g{Ob, (const bf16*)(ws + WS_WTO) + (size_t)l * DM * DM, DM, DM, DM};
            pg8::StaticOrder S; S.init(64, 4, F.G, c);
            pg8::EpiResAdd E{H, SSQ + (2 * l + 2) * SSQ_I, 0};
            for (int rep = 1; rep < REP_RES; ++rep) { pg8::EpiResAdd E0{H, SSQ, hi > 9999 ? 0 : 1}; pg8::gemm_phase<pg8::EpiResAdd, pg8::AddrStd, true, true>(ring, g, S, E0, pg8::AddrStd{}); }
            pg8::gemm_phase<pg8::EpiResAdd, pg8::AddrStd, true, true>(ring, g, S, E, pg8::AddrStd{});
            REFRESH(); mini_gemm<16>(F, Ob, DM, g.Bt, DM, DM, 64, MiniResAdd{H, SSQ + (2 * l + 2) * SSQ_I}, 0);
            SEAM(pb + 9);
        }
        if constexpr (l == 3) if (IN(pb + 10)) { REFRESH(); t_norm(F, F.in[I_NFIN], true); SEAM(pb + 10); }
}
__global__ void __launch_bounds__(NWAVES * 64, 2) trunk_fwd(Args args) {
    extern __shared__ __attribute__((aligned(16))) unsigned char lds[];
    Frame F;
    F.lds = (LAS unsigned char*)lds;
    F.tid = threadIdx.x; F.lane = F.tid & 63; F.wave = __builtin_amdgcn_readfirstlane(F.tid >> 6);
    F.G = gridDim.x; { const int bx = blockIdx.x; F.vcu = (F.G % 8 == 0) ? (bx % 8) * (F.G / 8) + bx / 8 : bx; }
    F.in = args.in; F.out = args.out; F.ws = args.ws;
    unsigned char* ws = args.ws;
    volatile LAS unsigned* MISC = (volatile LAS unsigned*)(F.lds + MISC_OFF);
    if (F.tid < 32) MISC[F.tid] = 0u;
    __syncthreads();
#if MK_PER_PHASE
    XcdBarrier bar; bar.bar = (unsigned*)(ws + WS_CTL) + CW_BAR; bar.x = 0; bar.st = MISC + 8;
#else
    XcdBarrier bar = xcd_barrier_post((unsigned*)(ws + WS_CTL) + CW_BAR, MISC + 8);
#endif
    const int lo = args.ph_lo, hi = args.ph_hi;
    LAS unsigned char* ring = F.lds;
    const int c = (int)blockIdx.x;

#if AMP_MASK
    unsigned long long amp_t0 = 0;
#endif
    if (IN(0)) { REFRESH(); for (int rep = 0; rep < REP_P0; ++rep) p0_prologue(F); SEAM(0); }
    if (IN(1)) {
        for (int rep = 0; rep < REP_P1; ++rep) {
        { pg8::Gemm g{(const bf16*)(ws + WS_MEMB), (const bf16*)(ws + WS_WTK), DM, DM, DM}; pg8::StaticOrder S; S.init(8, 16, F.G, c);
          pg8::EpiKproj E{F.out + OUT_MK, (bf16*)(ws + WS_KB)};
          pg8::gemm_phase<pg8::EpiKproj, pg8::AddrStd, true, true>(ring, g, S, E, pg8::AddrStd{}); }
        { pg8::Gemm g{(const bf16*)(ws + WS_WTV), (const bf16*)(ws + WS_MEMB), DM, DM, DM}; pg8::StaticOrder S; S.init(16, 8, F.G, (c + F.G / 2) % F.G);
          pg8::EpiVT E{F.out + OUT_MV, (bf16*)(ws + WS_VT)};
          pg8::gemm_phase<pg8::EpiVT, pg8::AddrStd, true, true>(ring, g, S, E, pg8::AddrStd{}); }
        }
        SEAM(1);
    }
    layer_phases<0>(F, lo, hi, bar); layer_phases<1>(F, lo, hi, bar); layer_phases<2>(F, lo, hi, bar); layer_phases<3>(F, lo, hi, bar);
#undef IN
#undef SEAM
}

extern "C" void kernel_launch(void* const* d_in, const int* in_sizes, int n_in, void* d_out, int out_size, void* d_ws, size_t ws_size, hipStream_t stream) {
    static int grid = 0;
    if (grid == 0) {
        if (n_in != 29 || (size_t)out_size != OUT_TOTAL || ws_size < WS_END) { fprintf(stderr, "kernel_launch: unexpected shapes: n_in %d out %d ws %zu (need %zu)\n", n_in, out_size, ws_size, (size_t)WS_END); grid = -1; return; }
        if (hipFuncSetAttribute((const void*)trunk_fwd, hipFuncAttributeMaxDynamicSharedMemorySize, LDS_BYTES) != hipSuccess) { fprintf(stderr, "kernel_launch: hipFuncSetAttribute failed\n"); grid = -1; return; }
        int dev = 0, cus = 0;
        if (hipGetDevice(&dev) != hipSuccess || hipDeviceGetAttribute(&cus, hipDeviceAttributeMultiprocessorCount, dev) != hipSuccess) { grid = -1; return; }
        (void)hipGetLastError();
        grid = cus < 256 ? cus : 256;
        if (grid != 256) fprintf(stderr, "kernel_launch: %d CUs; this kernel is built for a 256-CU grid\n", cus);
    }
    if (grid < 0) return;
    (void)hipMemsetAsync((char*)d_ws + WS_CTL, 0, CTL_ZERO_BYTES, stream);
    Args a{};
    for (int i = 0; i < 29; ++i) a.in[i] = (const float*)d_in[i];
    a.out = (float*)d_out; a.ws = (unsigned char*)d_ws;
#if MK_PER_PHASE
    for (int p = 0; p < N_PHASES; ++p) {
        if (p >= PH_LAYER0) { const int l = (p - PH_LAYER0) / PH_PER_LAYER, k = (p - PH_LAYER0) % PH_PER_LAYER; if (k == 3 || k == 5 || k == 8 || (k == 2 && (l & 1) == 0) || (k == 10 && l != 3)) continue; }
        a.ph_lo = p; a.ph_hi = p + 1;
        hipLaunchKernelGGL(trunk_fwd, dim3(grid), dim3(NWAVES * 64), LDS_BYTES, stream, a);
    }
#else
    a.ph_lo = 0; a.ph_hi = N_PHASES;
    hipLaunchKernelGGL(trunk_fwd, dim3(grid), dim3(NWAVES * 64), LDS_BYTES, stream, a);
#endif
}
```

```cpp
#include <hip/hip_runtime.h>
#include <cstdio>
#include <cstdint>

#ifndef REP_SSD
#define REP_SSD 1
#endif
#ifndef REP_SSDS
#define REP_SSDS 1
#endif
#ifndef REP_SATTN
#define REP_SATTN 1
#endif
#ifndef REP_THIN
#define REP_THIN 1
#endif
#ifndef REP_G1
#define REP_G1 1
#endif
#ifndef REP_G2
#define REP_G2 1
#endif
#ifndef REP_G4
#define REP_G4 1
#endif
#ifndef REP_G5
#define REP_G5 1
#endif
#ifndef REP_G6
#define REP_G6 1
#endif
#ifndef REP_P1
#define REP_P1 1
#endif
#ifndef REP_RES
#define REP_RES 1
#endif
#ifndef REP_BAR
#define REP_BAR 1
#endif
#ifndef REP_MINI
#define REP_MINI 1
#endif
#ifndef REP_P0
#define REP_P0 1
#endif
#ifndef MK_PER_PHASE
#define MK_PER_PHASE 0
#endif

namespace pg8 {
#define PG8_LAS __attribute__((address_space(3)))
typedef unsigned short bf16_t;
typedef short bf16x8 __attribute__((ext_vector_type(8)));
typedef float f32x4 __attribute__((ext_vector_type(4)));
typedef unsigned u32x4 __attribute__((ext_vector_type(4)));
typedef unsigned u32x2 __attribute__((ext_vector_type(2)));
constexpr int BM = 256, BK = 64, HALF = 128, HTB = HALF * BK * 2  , STAGE_BYTES = 8 * HTB, NXCD = 8, WGM = 8;

__host__ __device__ __forceinline__ int lds_byte(int r, int c) { const int st = (r >> 4) * 2 + (c >> 5), rr = r & 15, cc = c & 31, ob = rr * 64 + cc * 2; return st * 1024 + (ob ^ (((ob >> 9) & 1) << 5)); }
__host__ __device__ __forceinline__ void stage_rc(int b, int& R, int& C) { const int st = b / 1024, sb = b % 1024, swz = sb ^ (((sb >> 9) & 1) << 5); R = (st >> 1) * 16 + swz / 64; C = (st & 1) * 32 + (swz % 64) / 2; }
__host__ __device__ __forceinline__ int perm32(int rho) { const int n = rho >> 4, i = rho & 15; return 8 * (i >> 2) + 4 * n + (i & 3); }

struct Unit { int pm, pn; };
struct Gemm { const bf16_t* A; const bf16_t* Bt; int lda, ldb, K; };

struct StaticOrder {
    int nM, nN, nwg, G, c;
    __host__ __device__ void init(int nM_, int nN_, int G_, int c_) { nM = nM_; nN = nN_; nwg = nM * nN; G = G_; c = c_; }
    __host__ __device__ bool next(int i, Unit& u) const {
        const long L = (long)i * G + c; if (L >= nwg) return false;
        int wgid = (int)L; { const int q = nwg / NXCD, r = nwg % NXCD, xcd = wgid % NXCD, off = wgid / NXCD; wgid = (xcd < r ? xcd * (q + 1) : r * (q + 1) + (xcd - r) * q) + off; }
        const int nig = WGM * nN, gid = wgid / nig, fm = gid * WGM, gsz = (nM - fm) < WGM ? (nM - fm) : WGM;
        u.pm = fm + ((wgid % nig) % gsz); u.pn = (wgid % nig) / gsz; return true;
    }
};
struct AddrStd  { __device__ __forceinline__ size_t a(const Unit& u, const Gemm& g) const { return (size_t)u.pm * 256 * g.lda; }
                  __device__ __forceinline__ size_t b(const Unit& u, const Gemm& g) const { return (size_t)u.pn * 256 * g.ldb; } };
struct AddrColA { __device__ __forceinline__ size_t a(const Unit& u, const Gemm& g) const { return (size_t)u.pm * 256 * g.lda + (size_t)u.pn * 256; }
                  __device__ __forceinline__ size_t b(const Unit& u, const Gemm& g) const { return (size_t)u.pn * 256 * g.ldb; } };
struct AddrScore { __device__ __forceinline__ size_t a(const Unit& u, const Gemm& g) const { return (size_t)u.pm * 256 * g.lda + (size_t)u.pn * 256; }
                   __device__ __forceinline__ size_t b(const Unit& u, const Gemm& g) const { return (size_t)(u.pm >> 3) * 256 * g.ldb + (size_t)u.pn * 256; } };
struct AddrPV   { __device__ __forceinline__ size_t a(const Unit& u, const Gemm& g) const { return (size_t)u.pm * 256 * g.lda + (size_t)u.pn * 256; }
                  __device__ __forceinline__ size_t b(const Unit& u, const Gemm& g) const { return ((size_t)(u.pm >> 3) * 1024 + (size_t)u.pn * 256) * 256; } };

__device__ __forceinline__ unsigned cvt_pk_bf16(float lo, float hi) { unsigned r; asm volatile("v_cvt_pk_bf16_f32 %0, %1, %2" : "=v"(r) : "v"(lo), "v"(hi)); return r; }
__device__ __forceinline__ float bf_lo(unsigned w) { return __uint_as_float(w << 16); }
__device__ __forceinline__ float bf_hi(unsigned w) { return __uint_as_float(w & 0xffff0000u); }
__device__ __forceinline__ float silu_f(float z) { return z * __builtin_amdgcn_rcpf(1.0f + __builtin_amdgcn_exp2f(-1.44269504089f * z)); }

struct EpiBf16S {
    static constexpr bool PERM = true, AFTER_DRAIN = false;
    bf16_t* O; int ldc; const unsigned long long* ssq;
    __device__ __forceinline__ void operator()(const f32x4 (&acc)[2][2][4][2], const Unit& u, int wr, int wc, int fr, int fq) const {
        const int row0 = u.pm * BM + wr * 64 + fr, col0 = u.pn * BM + wc * 32 + 8 * fq;
        unsigned long long sv[2][4];
        if (ssq) {
#pragma unroll
            for (int ai = 0; ai < 2; ++ai)
#pragma unroll
                for (int m = 0; m < 4; ++m) sv[ai][m] = ssq[row0 + ai * HALF + m * 16]; }
#pragma unroll
        for (int ai = 0; ai < 2; ++ai)
#pragma unroll
            for (int m = 0; m < 4; ++m) { const size_t row = (size_t)(row0 + ai * HALF + m * 16); bf16_t* rowp = O + row * ldc + col0;
                float rs = 1.0f;
                if (ssq) rs = __builtin_amdgcn_rsqf((float)sv[ai][m] * (1.0f / (1024.0f * 1048576.0f)) + 1e-6f);
#pragma unroll
                for (int bj = 0; bj < 2; ++bj) { const f32x4 v0 = acc[ai][bj][m][0] * rs, v1 = acc[ai][bj][m][1] * rs;
                    u32x4 w; w.x = cvt_pk_bf16(v0[0], v0[1]); w.y = cvt_pk_bf16(v0[2], v0[3]); w.z = cvt_pk_bf16(v1[0], v1[1]); w.w = cvt_pk_bf16(v1[2], v1[3]);
                    *(u32x4*)(rowp + bj * HALF) = w; } }
    }
};
struct EpiEvenIn {
    static constexpr bool PERM = true, AFTER_DRAIN = false;
    bf16_t* O; const unsigned long long* ssq;
    __device__ __forceinline__ void operator()(const f32x4 (&acc)[2][2][4][2], const Unit& u, int wr, int wc, int fr, int fq) const {
        const int row0 = u.pm * BM + wr * 64 + fr, cw = wc * 32 + 8 * fq;
        unsigned long long sv[2][4];
#pragma unroll
        for (int ai = 0; ai < 2; ++ai)
#pragma unroll
            for (int m = 0; m < 4; ++m) sv[ai][m] = ssq[row0 + ai * HALF + m * 16];
#pragma unroll
        for (int ai = 0; ai < 2; ++ai)
#pragma unroll
            for (int m = 0; m < 4; ++m) { const size_t row = (size_t)(row0 + ai * HALF + m * 16); bf16_t* rowp = O + row * 4096;
                const float rs = __builtin_amdgcn_rsqf((float)sv[ai][m] * (1.0f / (1024.0f * 1048576.0f)) + 1e-6f);
                if (u.pn < 8) {
#pragma unroll
                    for (int bj = 0; bj < 2; ++bj) { const f32x4 v0 = acc[ai][bj][m][0] * rs, v1 = acc[ai][bj][m][1] * rs;
                        u32x4 w; w.x = cvt_pk_bf16(v0[0], v0[1]); w.y = cvt_pk_bf16(v0[2], v0[3]); w.z = cvt_pk_bf16(v1[0], v1[1]); w.w = cvt_pk_bf16(v1[2], v1[3]);
                        *(u32x4*)(rowp + u.pn * BM + cw + bj * HALF) = w; }
                } else {
                    float o[8];
#pragma unroll
                    for (int n = 0; n < 2; ++n)
#pragma unroll
                        for (int j = 0; j < 4; ++j) { const float a = acc[ai][0][m][n][j] * rs, b = acc[ai][1][m][n][j] * rs;
                            o[4 * n + j] = u.pn < 16 ? a * b : a * (b * __builtin_amdgcn_rcpf(1.0f + __builtin_amdgcn_exp2f(-1.44269504089f * b))); }
                    u32x4 w; w.x = cvt_pk_bf16(o[0], o[1]); w.y = cvt_pk_bf16(o[2], o[3]); w.z = cvt_pk_bf16(o[4], o[5]); w.w = cvt_pk_bf16(o[6], o[7]);
                    *(u32x4*)(rowp + 2048 + (u.pn - 8) * HALF + cw) = w; } }
    }
};
struct EpiResAdd {
    static constexpr bool PERM = true, AFTER_DRAIN = false;
    bf16_t* Xb; unsigned long long* ssq; int dry;
    __device__ __forceinline__ void row_update(const f32x4 (&acc)[2][2][4][2], int ai, int m, const u32x4 (&w)[2], bf16_t* rowp, size_t row, int fq) const {
        float sq = 0.f;
#pragma unroll
        for (int bj = 0; bj < 2; ++bj) { const unsigned int ww[4] = {w[bj].x, w[bj].y, w[bj].z, w[bj].w}; float o[8];
#pragma unroll
            for (int e = 0; e < 4; ++e) { o[2 * e] = __uint_as_float(ww[e] << 16) + acc[ai][bj][m][e >> 1][2 * (e & 1)]; o[2 * e + 1] = __uint_as_float(ww[e] & 0xffff0000u) + acc[ai][bj][m][e >> 1][2 * (e & 1) + 1]; }
#pragma unroll
            for (int e = 0; e < 8; e += 2) sq += o[e] * o[e] + o[e + 1] * o[e + 1];
            u32x4 v; v.x = cvt_pk_bf16(o[0], o[1]); v.y = cvt_pk_bf16(o[2], o[3]); v.z = cvt_pk_bf16(o[4], o[5]); v.w = cvt_pk_bf16(o[6], o[7]);
            *(u32x4*)(rowp + bj * HALF) = v; }
        sq += __shfl_xor(sq, 16); sq += __shfl_xor(sq, 32);
        if (fq == 0) atomicAdd(ssq + row, (unsigned long long)(sq * 1048576.0f));
    }
    __device__ __forceinline__ void operator()(const f32x4 (&acc)[2][2][4][2], const Unit& u, int wr, int wc, int fr, int fq) const {
        if (dry) return;
        const int row0 = u.pm * BM + wr * 64 + fr, col0 = u.pn * BM + wc * 32 + 8 * fq;
        u32x4 w[4][2][2];
#define RA_LOAD(p) do { _Pragma("unroll") for (int r = 0; r < 2; ++r) _Pragma("unroll") for (int bj = 0; bj < 2; ++bj) \
            w[(p) & 3][r][bj] = *(const u32x4*)(Xb + (size_t)(row0 + ((p) >> 1) * HALF + (2 * ((p) & 1) + r) * 16) * 1024 + col0 + bj * HALF); } while (0)
        RA_LOAD(0); RA_LOAD(1);
#pragma unroll
        for (int p = 0; p < 4; ++p) {
            if (p + 2 < 4) RA_LOAD(p + 2);
#pragma unroll
            for (int r = 0; r < 2; ++r) { const int ai = p >> 1, m = 2 * (p & 1) + r; const size_t row = (size_t)(row0 + ai * HALF + m * 16);
                row_update(acc, ai, m, w[p & 3][r], Xb + row * 1024 + col0, row, fq); }
            asm volatile("" ::: "memory"); }
#undef RA_LOAD
    }
};
struct EpiPoolGate {
    static constexpr bool PERM = true, AFTER_DRAIN = false;
    bf16_t* O; int ldc; const bf16_t* gate; int ldg; const float* scale;
    __device__ __forceinline__ void operator()(const f32x4 (&acc)[2][2][4][2], const Unit& u, int wr, int wc, int fr, int fq) const {
        const int row0 = u.pm * BM + wr * 64 + fr, col0 = u.pn * BM + wc * 32 + 8 * fq;
        f32x4 sc[2][2];
#pragma unroll
        for (int bj = 0; bj < 2; ++bj)
#pragma unroll
            for (int n = 0; n < 2; ++n) sc[bj][n] = *(const f32x4*)(scale + col0 + bj * HALF + 4 * n);
#pragma unroll
        for (int ai = 0; ai < 2; ++ai)
#pragma unroll
            for (int m = 0; m < 4; ++m) { const size_t row = (size_t)(row0 + ai * HALF + m * 16);
#pragma unroll
                for (int bj = 0; bj < 2; ++bj) { const u32x4 gw = *(const u32x4*)(gate + row * ldg + col0 + bj * HALF);
                    const f32x4 v0 = acc[ai][bj][m][0] * sc[bj][0], v1 = acc[ai][bj][m][1] * sc[bj][1];
                    u32x4 w; w.x = cvt_pk_bf16(v0[0] * silu_f(bf_lo(gw.x)), v0[1] * silu_f(bf_hi(gw.x))); w.y = cvt_pk_bf16(v0[2] * silu_f(bf_lo(gw.y)), v0[3] * silu_f(bf_hi(gw.y)));
                    w.z = cvt_pk_bf16(v1[0] * silu_f(bf_lo(gw.z)), v1[1] * silu_f(bf_hi(gw.z))); w.w = cvt_pk_bf16(v1[2] * silu_f(bf_lo(gw.w)), v1[3] * silu_f(bf_hi(gw.w)));
                    *(u32x4*)(O + row * ldc + col0 + bj * HALF) = w; } }
    }
};
struct EpiKproj {
    static constexpr bool PERM = false, AFTER_DRAIN = false;
    float* outK; bf16_t* KB;
    __device__ __forceinline__ void operator()(const f32x4 (&acc)[2][2][4][2], const Unit& u, int wr, int wc, int fr, int fq) const {
        const int l = u.pn >> 2, row0 = u.pm * BM + wr * 64 + fr, col0 = (u.pn & 3) * BM + wc * 32 + 4 * fq;
        float* ob = outK + (size_t)l * 2048 * 1024; bf16_t* kb = KB + (size_t)l * 2048 * 1024;
#pragma unroll
        for (int ai = 0; ai < 2; ++ai)
#pragma unroll
            for (int m = 0; m < 4; ++m) { const size_t ro = (size_t)(row0 + ai * HALF + m * 16) * 1024 + col0;
#pragma unroll
                for (int bj = 0; bj < 2; ++bj)
#pragma unroll
                    for (int n = 0; n < 2; ++n) { const f32x4 v = acc[ai][bj][m][n]; *(f32x4*)(ob + ro + bj * HALF + n * 16) = v;
                        if (KB) { u32x2 w; w.x = cvt_pk_bf16(v[0], v[1]); w.y = cvt_pk_bf16(v[2], v[3]); *(u32x2*)(kb + ro + bj * HALF + n * 16) = w; } } }
    }
};
struct EpiVT {
    static constexpr bool PERM = false, AFTER_DRAIN = false;
    float* outV; bf16_t* VT;
    __device__ __forceinline__ void operator()(const f32x4 (&acc)[2][2][4][2], const Unit& u, int wr, int wc, int fr, int fq) const {
        const int l = u.pm >> 2, e0 = (u.pm & 3) * BM + wr * 64 + fr, b = u.pn, m0 = wc * 32 + 4 * fq;
        bf16_t* vb = VT + ((size_t)l * 8 + b) * 1024 * 256;
#pragma unroll
        for (int ai = 0; ai < 2; ++ai)
#pragma unroll
            for (int m = 0; m < 4; ++m) { const int e = e0 + ai * HALF + m * 16;
#pragma unroll
                for (int bj = 0; bj < 2; ++bj)
#pragma unroll
                    for (int n = 0; n < 2; ++n) { const f32x4 v = acc[ai][bj][m][n]; const int mm = m0 + bj * HALF + n * 16;
                        u32x2 w; w.x = cvt_pk_bf16(v[0], v[1]); w.y = cvt_pk_bf16(v[2], v[3]); *(u32x2*)(vb + (size_t)e * 256 + mm) = w;
                        float* ov = outV + (size_t)l * 2048 * 1024 + (size_t)(b * 256 + mm) * 1024 + e;
                        ov[0] = v[0]; ov[1024] = v[1]; ov[2048] = v[2]; ov[3072] = v[3]; } }
    }
};
struct EpiSoftmax {
    static constexpr bool PERM = true, AFTER_DRAIN = true;
    bf16_t* P; int ldc; float c2;
    __device__ __forceinline__ void fused(f32x4 (&acc)[2][2][4][2], const Unit& u, int wr, int wc, int fr, int fq, PG8_LAS unsigned char* lds, int wid, int lane) const {
        PG8_LAS f32x4* TM = (PG8_LAS f32x4*)lds;
        PG8_LAS f32x4* TS = (PG8_LAS f32x4*)(lds + 4096);
        PG8_LAS float* TMf = (PG8_LAS float*)lds; PG8_LAS float* TSf = (PG8_LAS float*)(lds + 4096);
#pragma unroll
        for (int ai = 0; ai < 2; ++ai)
#pragma unroll
            for (int m = 0; m < 4; ++m) { float mx = -3.0e38f;
#pragma unroll
                for (int bj = 0; bj < 2; ++bj)
#pragma unroll
                    for (int n = 0; n < 2; ++n) { const f32x4 x = acc[ai][bj][m][n]; mx = fmaxf(mx, fmaxf(fmaxf(x[0], x[1]), fmaxf(x[2], x[3]))); }
                mx = fmaxf(mx, __shfl_xor(mx, 16)); mx = fmaxf(mx, __shfl_xor(mx, 32));
                if (fq == 0) TMf[(ai * HALF + wr * 64 + m * 16 + fr) * 4 + wc] = mx; }
        asm volatile("s_waitcnt lgkmcnt(0)" ::: "memory"); __builtin_amdgcn_s_barrier(); asm volatile("" ::: "memory");
#pragma unroll
        for (int ai = 0; ai < 2; ++ai)
#pragma unroll
            for (int m = 0; m < 4; ++m) { const int rl = ai * HALF + wr * 64 + m * 16 + fr; const f32x4 t = TM[rl]; const float mx = fmaxf(fmaxf(t[0], t[1]), fmaxf(t[2], t[3])); float s = 0.f;
#pragma unroll
                for (int bj = 0; bj < 2; ++bj)
#pragma unroll
                    for (int n = 0; n < 2; ++n) { f32x4 x = acc[ai][bj][m][n];
#pragma unroll
                        for (int j = 0; j < 4; ++j) { x[j] = __builtin_amdgcn_exp2f((x[j] - mx) * c2); s += x[j]; }
                        acc[ai][bj][m][n] = x; }
                s += __shfl_xor(s, 16); s += __shfl_xor(s, 32);
                if (fq == 0) TSf[rl * 4 + wc] = s; }
        asm volatile("s_waitcnt lgkmcnt(0)" ::: "memory"); __builtin_amdgcn_s_barrier(); asm volatile("" ::: "memory");
        const int row0 = u.pm * BM + wr * 64 + fr, col0 = u.pn * BM + wc * 32 + 8 * fq;
#pragma unroll
        for (int ai = 0; ai < 2; ++ai)
#pragma unroll
            for (int m = 0; m < 4; ++m) { const int rl = ai * HALF + wr * 64 + m * 16 + fr; const f32x4 t = TS[rl]; const float inv = 1.0f / ((t[0] + t[1]) + (t[2] + t[3]));
                bf16_t* rowp = P + (size_t)(row0 + ai * HALF + m * 16) * ldc + col0;
#pragma unroll
                for (int bj = 0; bj < 2; ++bj) { const f32x4 v0 = acc[ai][bj][m][0] * inv, v1 = acc[ai][bj][m][1] * inv;
                    u32x4 w; w.x = cvt_pk_bf16(v0[0], v0[1]); w.y = cvt_pk_bf16(v0[2], v0[3]); w.z = cvt_pk_bf16(v1[0], v1[1]); w.w = cvt_pk_bf16(v1[2], v1[3]);
                    *(u32x4*)(rowp + bj * HALF) = w; } }
    }
};

template <class Epi, class Addr, bool ALIGN_EPI = false, bool SP2 = false, bool KS = false>
__device__ __forceinline__ void gemm_phase(PG8_LAS unsigned char* lds, const Gemm g, const StaticOrder& S, const Epi& E, const Addr AD, const float* ssqh = nullptr) {
    int tid = threadIdx.x; asm volatile("" : "+v"(tid));
    const int wid = __builtin_amdgcn_readfirstlane(tid >> 6), lane = tid & 63, wr = wid >> 2, wc = wid & 3, fr = lane & 15, fq = lane >> 4;
    const int K = g.K, nt = K / BK;
    unsigned voffA[2], voffB[2];
#pragma unroll
    for (int i = 0; i < 2; ++i) { int R, C; stage_rc(tid * 16 + i * 8192, R, C); const int Rb = Epi::PERM ? ((R & ~31) + perm32(R & 31)) : R;
        voffA[i] = (unsigned)(R * g.lda + C) * 2u; voffB[i] = (unsigned)(Rb * g.ldb + C) * 2u; }
    const size_t kstep = (size_t)(BK * 2);
    const size_t hstepA = (size_t)HALF * g.lda * 2, hstepB = (size_t)HALF * g.ldb * 2;
    const unsigned ldsw = (unsigned)wid * 1024u;
    const int aoff = lds_byte(wr * 64 + fr, fq * 8), boff = lds_byte(wc * 32 + fr, fq * 8);
#define PG8_SA(b, h) (((b) * 2 + (h)) * HTB)
#define PG8_SB(b, h) ((4 + (b) * 2 + (h)) * HTB)
#define PG8_STAGE(bufoff, gbase, voff) do { _Pragma("unroll") for (int _i = 0; _i < 2; ++_i) \
        __builtin_amdgcn_global_load_lds((const unsigned*)((const char*)(gbase) + (voff)[_i]), (PG8_LAS unsigned*)(lds + (bufoff) + ldsw + _i * 8192), 16, 0, 0); } while (0)
#define PG8_LDA(dst, b, h) do { _Pragma("unroll") for (int m = 0; m < 4; ++m) _Pragma("unroll") for (int k = 0; k < 2; ++k) dst[m][k] = *(const PG8_LAS bf16x8*)(lds + PG8_SA(b, h) + aoff + m * 2048 + k * 1024); } while (0)
#define PG8_LDB(dst, b, h) do { _Pragma("unroll") for (int n = 0; n < 2; ++n) _Pragma("unroll") for (int k = 0; k < 2; ++k) dst[n][k] = *(const PG8_LAS bf16x8*)(lds + PG8_SB(b, h) + boff + n * 2048 + k * 1024); } while (0)
#define PG8_MMA(ai, bj, At, Bt) do { __builtin_amdgcn_s_setprio(1); _Pragma("unroll") for (int m = 0; m < 4; ++m) _Pragma("unroll") for (int n = 0; n < 2; ++n) _Pragma("unroll") for (int k = 0; k < 2; ++k) \
        acc[ai][bj][m][n] = __builtin_amdgcn_mfma_f32_16x16x32_bf16(Bt[n][k], At[m][k], acc[ai][bj][m][n], 0, 0, 0); __builtin_amdgcn_s_setprio(0); } while (0)
#define PG8_WAIT_V(n) asm volatile("s_waitcnt vmcnt(" #n ")" ::: "memory")
#define PG8_WAIT_L(n) asm volatile("s_waitcnt lgkmcnt(" #n ")" ::: "memory")
#define PG8_BAR __builtin_amdgcn_s_barrier()
#define PG8_SCHED __builtin_amdgcn_sched_barrier(0)
    Unit cur, nxt; int ui = 0;
    if (!S.next(0, cur)) return;
    f32x4 acc[2][2][4][2];
#pragma unroll
    for (int a = 0; a < 2; ++a)
#pragma unroll
        for (int b = 0; b < 2; ++b)
#pragma unroll
            for (int m = 0; m < 4; ++m)
#pragma unroll
                for (int n = 0; n < 2; ++n) acc[a][b][m][n] = (f32x4){0.f, 0.f, 0.f, 0.f};
    bf16x8 At[4][2], B0[2][2], B1[2][2];
    const char* cA = (const char*)g.A + 2 * AD.a(cur, g); const char* cB = (const char*)g.Bt + 2 * AD.b(cur, g);
    PG8_LAS float* kstab = (PG8_LAS float*)(lds + STAGE_BYTES);
    if constexpr (KS) { if (tid < 256) { const float* q = ssqh + (size_t)(cur.pm * BM + tid); float r[4];
#pragma unroll
            for (int gi = 0; gi < 4; ++gi) { float a = 0.f;
#pragma unroll
                for (int e = 0; e < 8; ++e) a += q[(size_t)(gi * 8 + e) * 16640];
                r[gi] = 1.0f / sqrtf(a * (1.0f / 512.0f) + 1e-6f); }
            *(PG8_LAS f32x4*)(kstab + tid * 4) = (f32x4){r[0] / r[1], r[1] / r[2], r[2] / r[3], r[3]}; } }
#define PG8_KSCALE(gi) do { _Pragma("unroll") for (int ai = 0; ai < 2; ++ai) _Pragma("unroll") for (int m = 0; m < 4; ++m) { const float f_ = kstab[(ai * HALF + wr * 64 + m * 16 + fr) * 4 + (gi)]; \
        _Pragma("unroll") for (int bj = 0; bj < 2; ++bj) _Pragma("unroll") for (int n = 0; n < 2; ++n) acc[ai][bj][m][n] = acc[ai][bj][m][n] * f_; } } while (0)
    if constexpr (SP2) {
        PG8_STAGE(PG8_SB(0, 0), cB, voffB); PG8_STAGE(PG8_SB(0, 1), cB + hstepB, voffB); PG8_STAGE(PG8_SA(0, 0), cA, voffA); PG8_STAGE(PG8_SA(0, 1), cA + hstepA, voffA);
        if (wr == 1) PG8_BAR;
        PG8_WAIT_V(2); PG8_BAR;
        PG8_STAGE(PG8_SB(1, 0), cB + kstep, voffB); PG8_STAGE(PG8_SA(1, 0), cA + kstep, voffA); PG8_STAGE(PG8_SB(1, 1), cB + hstepB + kstep, voffB);
        PG8_WAIT_V(6); PG8_BAR;
    } else {
        PG8_STAGE(PG8_SB(0, 0), cB, voffB); PG8_STAGE(PG8_SA(0, 0), cA, voffA); PG8_STAGE(PG8_SB(0, 1), cB + hstepB, voffB); PG8_STAGE(PG8_SA(0, 1), cA + hstepA, voffA);
        if (wr == 1) PG8_BAR;
        PG8_WAIT_V(4); PG8_BAR;
        PG8_STAGE(PG8_SB(1, 0), cB + kstep, voffB); PG8_STAGE(PG8_SA(1, 0), cA + kstep, voffA); PG8_STAGE(PG8_SB(1, 1), cB + hstepB + kstep, voffB);
        PG8_WAIT_V(6); PG8_BAR;
    }
    for (;;) {
        const bool has_next = S.next(ui + 1, nxt);
        const char* nA = has_next ? (const char*)g.A + 2 * AD.a(nxt, g) : cA; const char* nB = has_next ? (const char*)g.Bt + 2 * AD.b(nxt, g) : cB;
        for (int seg = 0; seg < (KS ? 4 : 1); ++seg) {
        if constexpr (KS) { if (seg > 0) PG8_KSCALE(seg - 1); }
        for (int t = KS ? seg * 8 : 0; t < (KS ? seg * 8 + 8 : nt); t += 2) {
            const bool last = (t == nt - 2);
            const char* a1 = cA + (size_t)(t + 1) * kstep;
            const char* a2 = last ? nA : cA + (size_t)(t + 2) * kstep; const char* b2 = last ? nB : cB + (size_t)(t + 2) * kstep;
            const char* a3 = a2 + kstep; const char* b3 = b2 + kstep;
            if constexpr (SP2) {
            PG8_LDB(B0, 0, 0); PG8_LDB(B1, 0, 1); PG8_SCHED; PG8_LDA(At, 0, 0); PG8_STAGE(PG8_SA(1, 1), a1 + hstepA, voffA);
            PG8_WAIT_V(8); PG8_WAIT_L(0); PG8_BAR; PG8_MMA(0, 0, At, B0); PG8_MMA(0, 1, At, B1); PG8_BAR; PG8_SCHED;
            PG8_LDA(At, 0, 1); PG8_STAGE(PG8_SB(0, 0), b2, voffB); PG8_STAGE(PG8_SB(0, 1), b2 + hstepB, voffB); PG8_STAGE(PG8_SA(0, 0), a2, voffA);
            PG8_WAIT_V(8); PG8_WAIT_L(0); PG8_BAR; PG8_MMA(1, 0, At, B0); PG8_MMA(1, 1, At, B1); PG8_BAR; PG8_SCHED;
            PG8_LDB(B0, 1, 0); PG8_LDB(B1, 1, 1); PG8_SCHED; PG8_LDA(At, 1, 0); PG8_STAGE(PG8_SA(0, 1), a2 + hstepA, voffA);
            PG8_WAIT_V(8); PG8_WAIT_L(0); PG8_BAR; PG8_MMA(0, 0, At, B0); PG8_MMA(0, 1, At, B1); PG8_BAR; PG8_SCHED;
            PG8_LDA(At, 1, 1); PG8_STAGE(PG8_SB(1, 0), b3, voffB); PG8_STAGE(PG8_SB(1, 1), b3 + hstepB, voffB); PG8_STAGE(PG8_SA(1, 0), a3, voffA);
            PG8_WAIT_V(8); PG8_WAIT_L(0); PG8_BAR; PG8_MMA(1, 0, At, B0); PG8_MMA(1, 1, At, B1); PG8_BAR; PG8_SCHED;
            } else {
            PG8_LDB(B0, 0, 0); PG8_SCHED; PG8_LDA(At, 0, 0); PG8_STAGE(PG8_SA(1, 1), a1 + hstepA, voffA);
            PG8_WAIT_L(8); PG8_BAR; PG8_WAIT_L(0); PG8_MMA(0, 0, At, B0); PG8_BAR; PG8_SCHED;
            PG8_LDB(B1, 0, 1); PG8_STAGE(PG8_SB(0, 0), b2, voffB);
            PG8_BAR; PG8_WAIT_L(0); PG8_MMA(0, 1, At, B1); PG8_BAR;
            PG8_LDA(At, 0, 1); PG8_STAGE(PG8_SA(0, 0), a2, voffA);
            PG8_BAR; PG8_WAIT_L(0); PG8_MMA(1, 0, At, B0); PG8_BAR; PG8_SCHED;
            PG8_STAGE(PG8_SB(0, 1), b2 + hstepB, voffB);
            PG8_WAIT_V(6); PG8_BAR; PG8_MMA(1, 1, At, B1); PG8_BAR;
            PG8_LDB(B0, 1, 0); PG8_SCHED; PG8_LDA(At, 1, 0); PG8_STAGE(PG8_SA(0, 1), a2 + hstepA, voffA);
            PG8_WAIT_L(8); PG8_BAR; PG8_WAIT_L(0); PG8_MMA(0, 0, At, B0); PG8_BAR; PG8_SCHED;
            PG8_LDB(B1, 1, 1); PG8_STAGE(PG8_SB(1, 0), b3, voffB);
            PG8_BAR; PG8_WAIT_L(0); PG8_MMA(0, 1, At, B1); PG8_BAR;
            PG8_LDA(At, 1, 1); PG8_STAGE(PG8_SA(1, 0), a3, voffA);
            PG8_BAR; PG8_WAIT_L(0); PG8_MMA(1, 0, At, B0); PG8_BAR; PG8_SCHED;
            PG8_STAGE(PG8_SB(1, 1), b3 + hstepB, voffB);
            PG8_WAIT_V(6); PG8_BAR; PG8_MMA(1, 1, At, B1); PG8_BAR;
            }
        }
        }
        if constexpr (KS) PG8_KSCALE(3);
        if constexpr (ALIGN_EPI) { if (wr == 0) PG8_BAR; }
        if constexpr (!Epi::AFTER_DRAIN) { E(acc, cur, wr, wc, fr, fq); }
        if (!has_next) break;
#pragma unroll
        for (int a = 0; a < 2; ++a)
#pragma unroll
            for (int b = 0; b < 2; ++b)
#pragma unroll
                for (int m = 0; m < 4; ++m)
#pragma unroll
                    for (int n = 0; n < 2; ++n) acc[a][b][m][n] = (f32x4){0.f, 0.f, 0.f, 0.f};
        cur = nxt; cA = nA; cB = nB; ++ui;
        if constexpr (ALIGN_EPI) { if (wr == 1) PG8_BAR; }
    }
    PG8_WAIT_V(0);
    if constexpr (!ALIGN_EPI) { if (wr == 0) PG8_BAR; }
    PG8_BAR;
    if constexpr (Epi::AFTER_DRAIN) { E.fused(acc, cur, wr, wc, fr, fq, lds, wid, lane); }
#undef PG8_KSCALE
#undef PG8_SA
#undef PG8_SB
#undef PG8_STAGE
#undef PG8_LDA
#undef PG8_LDB
#undef PG8_MMA
#undef PG8_WAIT_V
#undef PG8_WAIT_L
#undef PG8_BAR
#undef PG8_SCHED
}
}

constexpr int NWAVES = 8;
constexpr int DM = 1024, TP = 16384, NBATCH = 8, SEQ = 2048, NSMP = 128, MV = TP + NSMP  , MP = 16640  , NPAN = 65;
constexpr int EVEN_IN = 6144, EVEN_P = 4096  , ODD_IN = 5152, ODD_WROWS = 5376  , ODD_INP = 5120  , DIN = 2048, CONVD = 3072, NHEAD = 32, NMEM = 256;
constexpr float EPS = 1e-6f;
constexpr size_t OUT_Y = 0, OUT_MK = 16908288, OUT_MV = 25296896, OUT_PP = 33685504, OUT_PS = 33931264, OUT_CP = 37863424, OUT_CS = 37896192,
                 OUT_SCP = 38420480, OUT_SCS = 38567936, OUT_SP = 40927232, OUT_SS = 45121536, OUT_TOTAL = 112230400;
constexpr size_t MiB = 1u << 20;
constexpr size_t WS_CTL = 0, CTL_ZERO_BYTES = 5 * MiB;
constexpr size_t WS_SSQ = 1 * MiB;
constexpr size_t WS_GSSQ = 3 * MiB;
constexpr size_t WS_WTE_IN = 5 * MiB;
constexpr size_t WS_WTE_OUT = WS_WTE_IN + 24 * MiB;
constexpr size_t WS_WTO_IN = WS_WTE_OUT + 8 * MiB;
constexpr size_t WS_WTO_OUT = WS_WTO_IN + 21 * MiB;
constexpr size_t WS_WTQ = WS_WTO_OUT + 8 * MiB;
constexpr size_t WS_WTK = WS_WTQ + 8 * MiB, WS_WTV = WS_WTK + 8 * MiB, WS_WTO = WS_WTV + 8 * MiB;
constexpr size_t WS_WTP = WS_WTO + 8 * MiB;
constexpr size_t WS_MEMB = WS_WTP + 1 * MiB;
constexpr size_t WS_KB = WS_MEMB + 4 * MiB;
constexpr size_t WS_VT = WS_KB + 16 * MiB;
constexpr size_t WS_H = WS_VT + 16 * MiB;
constexpr size_t WS_Q = WS_H + 34 * MiB, WS_PB = WS_Q + 34 * MiB, WS_O = WS_PB + 34 * MiB, WS_DIFF = WS_O + 34 * MiB;
constexpr size_t WS_MIX = WS_DIFF + 34 * MiB;
constexpr size_t WS_YG = WS_MIX + 66 * MiB;
constexpr size_t WS_CONVX = WS_YG + 66 * MiB;
constexpr size_t WS_DT = WS_CONVX + 98 * MiB;
constexpr size_t WS_PROJ = WS_DT + 3 * MiB;
constexpr size_t WS_WTU = WS_PROJ + 196 * MiB;
constexpr size_t WS_SSQH = WS_WTU + 4 * MiB;
constexpr size_t WS_END = WS_SSQH + 5 * MiB;
constexpr int CW_BAR = 4096;
constexpr int RING_BYTES = 131072, SSD_SMALL_OFF = 131072, MISC_OFF = 163840 - 128, LDS_BYTES = 163840;

#define GAS __attribute__((address_space(1)))
#define LAS __attribute__((address_space(3)))
#define DI __device__ __forceinline__
typedef unsigned short bf16;
typedef unsigned v4u __attribute__((ext_vector_type(4)));
typedef unsigned v2u __attribute__((ext_vector_type(2)));
typedef float f32x4 __attribute__((ext_vector_type(4)));
typedef float f32x16 __attribute__((ext_vector_type(16)));
typedef short bf16x8 __attribute__((ext_vector_type(8)));
typedef GAS unsigned gu32;
#define LDS_WAIT() asm volatile("s_waitcnt lgkmcnt(0)" ::: "memory")
DI unsigned f2bf(float f) { unsigned u = __builtin_bit_cast(unsigned, f); return (u + 0x7fffu + ((u >> 16) & 1u)) >> 16; }
DI unsigned pk2(float lo, float hi) { unsigned r; asm("v_cvt_pk_bf16_f32 %0, %1, %2" : "=v"(r) : "v"(lo), "v"(hi)); return r; }
DI float bflo(unsigned w) { return __uint_as_float(w << 16); }
DI float bfhi(unsigned w) { return __uint_as_float(w & 0xffff0000u); }
DI float bf1(bf16 h) { return __uint_as_float(((unsigned)h) << 16); }
DI void unpack8(const v4u v, float (&f)[8]) { f[0] = bflo(v.x); f[1] = bfhi(v.x); f[2] = bflo(v.y); f[3] = bfhi(v.y); f[4] = bflo(v.z); f[5] = bfhi(v.z); f[6] = bflo(v.w); f[7] = bfhi(v.w); }
DI v4u pack8(const float (&f)[8]) { v4u o; o.x = pk2(f[0], f[1]); o.y = pk2(f[2], f[3]); o.z = pk2(f[4], f[5]); o.w = pk2(f[6], f[7]); return o; }
DI void ld8(const bf16* p, float (&f)[8]) { unpack8(*(const GAS v4u*)p, f); }
DI void ld8f(const float* p, float (&f)[8]) { const f32x4 a = *(const GAS f32x4*)p, b = *(const GAS f32x4*)(p + 4); f[0] = a[0]; f[1] = a[1]; f[2] = a[2]; f[3] = a[3]; f[4] = b[0]; f[5] = b[1]; f[6] = b[2]; f[7] = b[3]; }
DI void st8(bf16* p, const float (&f)[8]) { *(GAS v4u*)p = pack8(f); }
DI void st8f(float* p, const float (&f)[8]) { *(GAS f32x4*)p = (f32x4){f[0], f[1], f[2], f[3]}; *(GAS f32x4*)(p + 4) = (f32x4){f[4], f[5], f[6], f[7]}; }
DI float silu(float z) { return z * __builtin_amdgcn_rcpf(1.0f + __builtin_amdgcn_exp2f(-1.44269504089f * z)); }
DI float wave_sum(float v) {
#pragma unroll
    for (int o = 1; o < 64; o <<= 1) v += __shfl_xor(v, o);
    return v;
}

#define XB_TMO      128
#define XB_XCNT(j)  (256  + 64 * (j))
#define XB_XSUB(j)  (1280 + 64 * (j))
#define XB_XGEN(j)  (2304 + 64 * (j))
#define XB_TOP      3328
#define XB_TOPGEN   3392
#define XCD_BAR_WORDS 3456
#define XB_SPIN_CAP (1u << 18)
DI unsigned xb_ld(unsigned* p)              { return __hip_atomic_load(p, __ATOMIC_RELAXED, __HIP_MEMORY_SCOPE_AGENT); }
DI unsigned xb_add(unsigned* p, unsigned v) { return __hip_atomic_fetch_add(p, v, __ATOMIC_RELAXED, __HIP_MEMORY_SCOPE_AGENT); }
DI unsigned xb_xcc_id() { return (unsigned)__builtin_amdgcn_s_getreg((3 << 11) | 20) & 0xFu; }
#define XB_SPIN(cond, bar) do { unsigned _sp = 0; while (cond) { __builtin_amdgcn_s_sleep(1); \
    if ((++_sp & 255u) == 0u) { if (xb_ld(&(bar)[XB_TMO])) break; if (_sp > XB_SPIN_CAP) { atomicAdd(&(bar)[XB_TMO], 1u); break; } } } } while (0)
struct XcdBarrier { unsigned* bar; unsigned x; volatile LAS unsigned* st; };
DI XcdBarrier xcd_barrier_post(unsigned* bar, volatile LAS unsigned* st) {
    XcdBarrier b; b.bar = bar; b.x = xb_xcc_id(); b.st = st;
    if (threadIdx.x == 0) (void)xb_add(&bar[XB_XCNT(b.x)], 1u);
    return b;
}
DI void xcd_barrier_complete(unsigned* bar, unsigned x, unsigned& nloc, unsigned& nx) {
    const unsigned G = gridDim.x * gridDim.y * gridDim.z;
    unsigned sum, cnt, mine, sp = 0u;
    for (;;) {
        sum = 0u; cnt = 0u; mine = 0u;
#pragma unroll
        for (unsigned j = 0; j < 16; ++j) { const unsigned c = xb_ld(&bar[XB_XCNT(j)]); sum += c; cnt += (c > 0u) ? 1u : 0u; mine = (j == x) ? c : mine; }
        if (sum == G) break;
        __builtin_amdgcn_s_sleep(1);
        if ((++sp & 255u) == 0u) { if (xb_ld(&bar[XB_TMO])) break; if (sp > XB_SPIN_CAP) { atomicAdd(&bar[XB_TMO], 1u); break; } }
    }
    nloc = mine > 0u ? mine : 1u; nx = cnt > 0u ? cnt : 1u;
}
DI void xcd_barrier(const XcdBarrier& b) {
    asm volatile("s_waitcnt vmcnt(0)" ::: "memory");
    __syncthreads();
    if (threadIdx.x == 0) {
        unsigned* bar = b.bar;
        __builtin_amdgcn_s_waitcnt(0);
        unsigned nloc = b.st[0], nx = b.st[1];
        if (nloc == 0u) { xcd_barrier_complete(bar, b.x, nloc, nx); b.st[0] = nloc; b.st[1] = nx; }
        const unsigned old = xb_add(&bar[XB_XSUB(b.x)], 1u);
        const unsigned gen = old / nloc;
        __builtin_amdgcn_fence(__ATOMIC_ACQUIRE, "agent");
        if (old + 1u == (gen + 1u) * nloc) {
            __builtin_amdgcn_fence(__ATOMIC_RELEASE, "agent");
            asm volatile("s_waitcnt vmcnt(0)" ::: "memory");
            const unsigned og = xb_add(&bar[XB_TOP], 1u);
            const unsigned tg = og / nx;
            if (og + 1u == (tg + 1u) * nx) xb_add(&bar[XB_TOPGEN], 1u);
            else XB_SPIN(xb_ld(&bar[XB_TOPGEN]) == tg, bar);
            asm volatile("" ::: "memory");
            xb_add(&bar[XB_XGEN(b.x)], 1u);
            asm volatile("s_waitcnt vmcnt(0)" ::: "memory");
        } else {
            XB_SPIN(xb_ld(&bar[XB_XGEN(b.x)]) == gen, bar);
            asm volatile("s_waitcnt vmcnt(0)" ::: "memory");
        }
    }
    __syncthreads();
}

struct Args { const float* in[29]; float* out; unsigned char* ws; int ph_lo, ph_hi; };
struct Frame {
    LAS unsigned char* lds;
    int tid, lane, wave, vcu, G;
    const float* const* in; float* out; unsigned char* ws;
};
enum { I_XP = 0, I_XS, I_MEM, I_CK, I_CV, I_SPOOL, I_SCONV, I_SSCONV, I_SSSM, I_NMIX, I_NXA, I_NFIN, I_WINE, I_POOLW, I_POOLS, I_CONVW, I_WOUTE, I_WINO, I_SCW, I_SCB, I_DTB, I_ALOG, I_DSKIP, I_SNORM, I_WOUTO, I_WQ, I_WK, I_WV, I_WO };

DI void p0_transpose_item(const float* W, int K, int N, bf16* WT, LAS float* scr, int item, int lane, const float* gk = nullptr) {
    const int nblk = N / 32, kb = item / nblk, nb = item % nblk, k0 = 64 * kb, n0 = 32 * nb;
    {
        const int kr = lane >> 3, ns = lane & 7; f32x4 v[8];
#pragma unroll
        for (int i = 0; i < 8; ++i) v[i] = *(const GAS f32x4*)(W + (size_t)(k0 + 8 * i + kr) * N + n0 + 4 * ns);
#pragma unroll
        for (int i = 0; i < 8; ++i) { const int kk = 8 * i + kr; const float gg = gk ? ((const GAS float*)gk)[k0 + kk] : 1.0f; LAS float* d = scr + kk * 33 + 4 * ns;
            d[0] = v[i][0] * gg; d[1] = v[i][1] * gg; d[2] = v[i][2] * gg; d[3] = v[i][3] * gg; } }
    LDS_WAIT(); asm volatile("" ::: "memory");
    const int c = lane & 7;
#pragma unroll
    for (int j = 0; j < 4; ++j) { const int n = (lane >> 3) + 8 * j; const LAS float* s = scr + (8 * c) * 33 + n;
        v4u o; o.x = pk2(s[0 * 33], s[1 * 33]); o.y = pk2(s[2 * 33], s[3 * 33]); o.z = pk2(s[4 * 33], s[5 * 33]); o.w = pk2(s[6 * 33], s[7 * 33]);
        *(GAS v4u*)(WT + (size_t)(n0 + n) * K + k0 + 8 * c) = o; }
    LDS_WAIT(); asm volatile("" ::: "memory");
}
DI void p0_prologue(Frame& F) {
    LAS float* scr = (LAS float*)(F.lds + F.wave * 16384);
    const int gw = F.vcu * NWAVES + F.wave, NGW = F.G * NWAVES;
    unsigned char* ws = F.ws;
    constexpr int IT_WINE = 16 * 192, IT_WOUT = 32 * 32, IT_WINO = 16 * 161, IT_SQ = 16 * 32, IT_PW = 4 * 8;
    constexpr int N0 = 2 * IT_WINE, N1 = N0 + 2 * IT_WOUT, N2 = N1 + 2 * IT_WINO, N3 = N2 + 2 * IT_WOUT, N4 = N3 + 16 * IT_SQ, N5 = N4 + 8 * IT_PW;
    for (int it = gw; it < N5; it += NGW) {
        if (it < N0) { const int mi = it / IT_WINE, r = it % IT_WINE;
            bf16* dst = (r % 192) < 32 ? (bf16*)(ws + WS_WTU) + (size_t)mi * DM * DM : (bf16*)(ws + WS_WTE_IN) + (size_t)mi * EVEN_IN * DM;
            {
                const int nb = r % 192;
                if (nb >= 64) { const int blk = (nb - 64) >> 5, cb = (nb - 64) & 31, chunk = cb >> 2, sub = cb & 3;
                    const int nnb = (blk == 1 || blk == 2) ? 64 + chunk * 8 + sub + (blk == 2 ? 4 : 0) : 128 + chunk * 8 + sub + (blk == 3 ? 4 : 0);
                    dst += (ptrdiff_t)(nnb - nb) * 32 * DM; } }
            p0_transpose_item(F.in[I_WINE] + (size_t)mi * DM * EVEN_IN, DM, EVEN_IN, dst, scr, r, F.lane, F.in[I_NMIX] + (size_t)(2 * mi) * DM); }
        else if (it < N1) { const int q = it - N0, mi = q / IT_WOUT, r = q % IT_WOUT; p0_transpose_item(F.in[I_WOUTE] + (size_t)mi * 2048 * DM, 2048, DM, (bf16*)(ws + WS_WTE_OUT) + (size_t)mi * DM * 2048, scr, r, F.lane); }
        else if (it < N2) { const int q = it - N1, mi = q / IT_WINO, r = q % IT_WINO; p0_transpose_item(F.in[I_WINO] + (size_t)mi * DM * ODD_IN, DM, ODD_IN, (bf16*)(ws + WS_WTO_IN) + (size_t)mi * ODD_WROWS * DM, scr, r, F.lane, F.in[I_NMIX] + (size_t)(2 * mi + 1) * DM); }
        else if (it < N3) { const int q = it - N2, mi = q / IT_WOUT, r = q % IT_WOUT; p0_transpose_item(F.in[I_WOUTO] + (size_t)mi * 2048 * DM, 2048, DM, (bf16*)(ws + WS_WTO_OUT) + (size_t)mi * DM * 2048, scr, r, F.lane, F.in[I_SNORM] + (size_t)mi * DIN); }
        else if (it < N4) { const int q = it - N3, mi = q / IT_SQ, r = q % IT_SQ, which = mi >> 2, l = mi & 3;
            const float* src = F.in[I_WQ + which] + (size_t)l * DM * DM;
            bf16* dst = (bf16*)(ws + (which == 0 ? WS_WTQ : which == 1 ? WS_WTK : which == 2 ? WS_WTV : WS_WTO)) + (size_t)l * DM * DM;
            p0_transpose_item(src, DM, DM, dst, scr, r, F.lane, which == 0 ? F.in[I_NXA] + (size_t)l * DM : nullptr); }
        else { const int q = it - N4, mi = q / IT_PW, r = q % IT_PW; p0_transpose_item(F.in[I_POOLW] + (size_t)mi * 65536, 256, 256, (bf16*)(ws + WS_WTP) + (size_t)mi * 65536, scr, r, F.lane); }
    }
    for (int it = gw; it < 2 * 4 * 32 * 8; it += NGW) {
        const int mi = it >> 10, gg = (it >> 8) & 3, kb = (it >> 3) & 31, nb = it & 7, r = F.lane & 31, h = F.lane >> 5;
        const float* Wi = F.in[I_WINE] + (size_t)mi * DM * EVEN_IN + (size_t)(32 * kb + r) * EVEN_IN + gg * 256;
        const float* Wp = F.in[I_POOLW] + (size_t)(mi * 4 + gg) * 65536 + nb * 32 + r;
        f32x16 acc;
#pragma unroll
        for (int k = 0; k < 16; ++k) acc[k] = 0.f;
        for (int j0 = 0; j0 < 256; j0 += 16) {
            f32x4 a4[4]; float b[16];
#pragma unroll
            for (int q = 0; q < 4; ++q) a4[q] = *(const GAS f32x4*)(Wi + j0 + 4 * q);
#pragma unroll
            for (int q = 0; q < 8; ++q) { b[2 * q] = ((const GAS float*)Wp)[(size_t)(j0 + 2 * q + h) * 256]; }
#pragma unroll
            for (int q = 0; q < 8; ++q) { const float av = (q & 1) ? (h ? a4[q >> 1][3] : a4[q >> 1][2]) : (h ? a4[q >> 1][1] : a4[q >> 1][0]);
                acc = __builtin_amdgcn_mfma_f32_32x32x2f32(av, b[2 * q], acc, 0, 0, 0); }
        }
        bf16* dst = (bf16*)(ws + WS_WTE_IN) + (size_t)mi * EVEN_IN * DM + (size_t)(gg * 256 + nb * 32 + r) * DM + 32 * kb;
        const float* gk = F.in[I_NMIX] + (size_t)(2 * mi) * DM + 32 * kb;
#pragma unroll
        for (int q4 = 0; q4 < 4; ++q4) { const int k0 = 8 * q4 + 4 * h; const f32x4 g4 = *(const GAS f32x4*)(gk + k0);
            *(GAS v2u*)(dst + k0) = (v2u){pk2(acc[4 * q4] * g4[0], acc[4 * q4 + 1] * g4[1]), pk2(acc[4 * q4 + 2] * g4[2], acc[4 * q4 + 3] * g4[3])}; }
    }
    const int gt = F.vcu * 512 + F.tid, NGT = F.G * 512;
    for (int i = gt; i < 2 * 224 * 128; i += NGT) { const int mi = i / (224 * 128), r = i % (224 * 128);
        *(GAS v4u*)((bf16*)(ws + WS_WTO_IN) + ((size_t)mi * ODD_WROWS + ODD_IN) * DM + (size_t)r * 8) = (v4u){0u, 0u, 0u, 0u}; }
    for (int i = gt; i < 2048 * 128; i += NGT) { float f[8]; ld8f(F.in[I_MEM] + (size_t)i * 8, f); st8((bf16*)(ws + WS_MEMB) + (size_t)i * 8, f); }
    bf16* H = (bf16*)(ws + WS_H); unsigned long long* SSQ = (unsigned long long*)(ws + WS_SSQ);
    for (int m0 = 2 * gw; m0 < MV; m0 += 2 * NGW) {
        f32x4 v[2][4];
#pragma unroll
        for (int rr = 0; rr < 2; ++rr) { const int m = m0 + rr; const float* xrow = m < TP ? F.in[I_XP] + (size_t)m * DM : F.in[I_XS] + (size_t)(m - TP) * DM; const GAS f32x4* xr = (const GAS f32x4*)xrow + F.lane;
#pragma unroll
            for (int j = 0; j < 4; ++j) v[rr][j] = xr[64 * j]; }
#pragma unroll
        for (int rr = 0; rr < 2; ++rr) { const int m = m0 + rr; GAS v2u* o8 = (GAS v2u*)(H + (size_t)m * DM) + F.lane; float s = 0.f;
#pragma unroll
            for (int j = 0; j < 4; ++j) { const f32x4 x = v[rr][j]; s += (x.x * x.x + x.y * x.y) + (x.z * x.z + x.w * x.w); o8[64 * j] = (v2u){pk2(x.x, x.y), pk2(x.z, x.w)}; }
            s = wave_sum(s);
            if (F.lane == 0) ((GAS unsigned long long*)SSQ)[m] = (unsigned long long)(s * 1048576.0f); }
    }
}
DI void t_norm(Frame& F, const float* g, bool fin) {
    const int gw = F.vcu * NWAVES + F.wave, NGW = F.G * NWAVES;
    const bf16* H = (const bf16*)(F.ws + WS_H);
    for (int m0 = 2 * gw; m0 < MV; m0 += 2 * NGW) {
        v4u w[2][2];
#pragma unroll
        for (int rr = 0; rr < 2; ++rr) { const GAS v4u* hr = (const GAS v4u*)(H + (size_t)(m0 + rr) * DM) + F.lane; w[rr][0] = hr[0]; w[rr][1] = hr[64]; }
#pragma unroll
        for (int rr = 0; rr < 2; ++rr) { float x[2][8]; float s = 0.f;
#pragma unroll
            for (int j = 0; j < 2; ++j)
#pragma unroll
                for (int e = 0; e < 4; ++e) { x[j][2 * e] = __uint_as_float(w[rr][j][e] << 16); x[j][2 * e + 1] = __uint_as_float(w[rr][j][e] & 0xffff0000u); s += x[j][2 * e] * x[j][2 * e] + x[j][2 * e + 1] * x[j][2 * e + 1]; }
            const float rstd = 1.f / sqrtf(wave_sum(s) * (1.f / DM) + EPS);
            GAS f32x4* yo = (GAS f32x4*)(F.out + (size_t)(m0 + rr) * DM);
#pragma unroll
            for (int j = 0; j < 2; ++j) { const int c0 = 512 * j + 8 * F.lane; const f32x4 g0 = *(const GAS f32x4*)(g + c0), g1 = *(const GAS f32x4*)(g + c0 + 4);
                yo[(c0 >> 2)] = (f32x4){x[j][0] * rstd * g0.x, x[j][1] * rstd * g0.y, x[j][2] * rstd * g0.z, x[j][3] * rstd * g0.w};
                yo[(c0 >> 2) + 1] = (f32x4){x[j][4] * rstd * g1.x, x[j][5] * rstd * g1.y, x[j][6] * rstd * g1.z, x[j][7] * rstd * g1.w}; }
        }
    }
}
DI void t_even_mix(Frame& F, int i) {
    const bf16* PROJ = (const bf16*)(F.ws + WS_PROJ); bf16* MIX = (bf16*)(F.ws + WS_MIX);
    const int c8 = F.tid & 127, sub = F.tid >> 7, ch = c8 * 8, w = 2 << (ch >> 8);
    float cw0[8], cw1[8], cw2[8], psc[8];
    ld8f(F.in[I_CONVW] + (size_t)(i * 3 + 0) * DM + ch, cw0); ld8f(F.in[I_CONVW] + (size_t)(i * 3 + 1) * DM + ch, cw1); ld8f(F.in[I_CONVW] + (size_t)(i * 3 + 2) * DM + ch, cw2);
    ld8f(F.in[I_POOLS] + (size_t)i * DM + ch, psc);
    for (int item = F.vcu * 512 + F.tid; item < (TP / 16) * 128; item += F.G * 512) {
        const int run = item >> 7, t0 = run * 16, b = t0 >> 11, tt0 = t0 & 2047;
        const bf16* pr0 = PROJ + (size_t)t0 * EVEN_P;
        float S[8], cv1[8], cv2[8], tmp[8], cg[8], vv[8];
#pragma unroll
        for (int j = 0; j < 8; ++j) { S[j] = 0.f; cv1[j] = 0.f; cv2[j] = 0.f; }
        if (tt0 > 0) {
            for (int k = 1; k < w; ++k) { ld8(pr0 - (size_t)k * EVEN_P + ch, tmp);
#pragma unroll
                for (int j = 0; j < 8; ++j) S[j] += tmp[j]; }
            ld8(pr0 - EVEN_P + 2048 + ch, cv1);
            ld8(pr0 - 2 * EVEN_P + 2048 + ch, cv2);
        }
        if (tt0 > 0 && tt0 + 16 <= SEQ - 15) {
            const float inv = 1.0f / (float)w;
#pragma unroll 4
            for (int k = 0; k < 16; ++k) {
                const size_t t = (size_t)t0 + k; const bf16* pr = pr0 + (size_t)k * EVEN_P;
                float u0[8], uo[8], gp[8], bg[8], cv0[8];
                ld8(pr + ch, u0); ld8(pr + 1024 + ch, gp); ld8(pr + 2048 + ch, cv0); ld8(pr + 3072 + ch, bg); ld8(pr - (size_t)(w - 1) * EVEN_P + ch, uo);
#pragma unroll
                for (int j = 0; j < 8; ++j) { S[j] += u0[j]; tmp[j] = (S[j] * inv - u0[j]) * psc[j] * silu(gp[j]); S[j] -= uo[j]; }
                st8(MIX + t * DIN + ch, tmp);
#pragma unroll
                for (int j = 0; j < 8; ++j) { tmp[j] = bg[j] * (cw0[j] * cv2[j] + cw1[j] * cv1[j] + cw2[j] * cv0[j]); cv2[j] = cv1[j]; cv1[j] = cv0[j]; }
                st8(MIX + t * DIN + 1024 + ch, tmp);
            }
        } else {
#pragma unroll 2
        for (int k = 0; k < 16; ++k) {
            const int tt = tt0 + k; const size_t t = (size_t)t0 + k; const bf16* pr = pr0 + (size_t)k * EVEN_P;
            float u0[8], uo[8], gp[8], bg[8], cv0[8];
            ld8(pr + ch, u0); ld8(pr + 1024 + ch, gp); ld8(pr + 2048 + ch, cv0); ld8(pr + 3072 + ch, bg);
            const bool drop = tt - (w - 1) >= 0;
            if (drop) ld8(pr - (size_t)(w - 1) * EVEN_P + ch, uo);
            const float inv = 1.0f / (float)(tt + 1 < w ? tt + 1 : w);
#pragma unroll
            for (int j = 0; j < 8; ++j) { S[j] += u0[j]; tmp[j] = (S[j] * inv - u0[j]) * psc[j] * silu(gp[j]); if (drop) S[j] -= uo[j]; }
            st8(MIX + t * DIN + ch, tmp);
#pragma unroll
            for (int j = 0; j < 8; ++j) { tmp[j] = bg[j] * (cw0[j] * cv2[j] + cw1[j] * cv1[j] + cw2[j] * cv0[j]); cv2[j] = cv1[j]; cv1[j] = cv0[j]; }
            st8(MIX + t * DIN + 1024 + ch, tmp);
            if (tt >= SEQ - 2) st8f(F.out + OUT_CP + ((size_t)(i * NBATCH + b) * 2 + (tt - (SEQ - 2))) * DM + ch, cv0);
        }
        }
    }
    LAS float* DF = (LAS float*)F.lds;
    const bf16* WTP = (const bf16*)(F.ws + WS_WTP) + (size_t)i * 4 * 65536;
    for (int it = F.vcu; it < (NSMP / 4) * 8; it += F.G) {
        const int rq = it >> 3, os = it & 7, bb = rq * 4 + sub; const size_t row = TP + bb;
        const bf16* pr = PROJ + (size_t)TP * EVEN_P + (size_t)bb * EVEN_IN;
        const int pA = 2048 + (ch >> 7) * 256 + (ch & 127), pB = pA + 2048;
        const float* pref = F.in[I_SPOOL] + ((size_t)(i * NSMP + bb) * 15) * DM + ch;
        float* pso = F.out + OUT_PS + ((size_t)(i * NSMP + bb) * 15) * DM + ch;
        float u0[8], sum[8], tmp[8];
        ld8(pr + ch, u0);
#pragma unroll
        for (int j = 0; j < 8; ++j) sum[j] = u0[j];
        for (int k = 0; k < 15; ++k) { ld8f(pref + (size_t)k * DM, tmp);
            if (os == 0 && k >= 1) st8f(pso + (size_t)(k - 1) * DM, tmp);
            if (15 - k < w) {
#pragma unroll
                for (int j = 0; j < 8; ++j) sum[j] += tmp[j]; } }
        const float inv = 1.0f / (float)w;
#pragma unroll
        for (int j = 0; j < 8; ++j) DF[sub * 1024 + ch + j] = sum[j] * inv - u0[j];
        if (os == 0) {
            st8f(pso + (size_t)14 * DM, u0);
            float cg[8], vv[8], cv0[8], p0[8], p1[8], bg[8], gc[8];
            ld8(pr + pA, cg); ld8(pr + pA + 128, vv);
#pragma unroll
            for (int j = 0; j < 8; ++j) cv0[j] = cg[j] * vv[j];
            ld8f(F.in[I_SCONV] + ((size_t)(i * NSMP + bb) * 2 + 0) * DM + ch, p0); ld8f(F.in[I_SCONV] + ((size_t)(i * NSMP + bb) * 2 + 1) * DM + ch, p1);
            ld8(pr + pB, bg); ld8(pr + pB + 128, gc);
#pragma unroll
            for (int j = 0; j < 8; ++j) tmp[j] = bg[j] * (cw0[j] * p0[j] + cw1[j] * p1[j] + cw2[j] * cv0[j]) * silu(gc[j]);
            st8(MIX + row * DIN + 1024 + ch, tmp);
            st8f(F.out + OUT_CS + ((size_t)(i * NSMP + bb) * 2 + 0) * DM + ch, p1); st8f(F.out + OUT_CS + ((size_t)(i * NSMP + bb) * 2 + 1) * DM + ch, cv0);
        }
        __syncthreads();
        {   const int n = os * 128 + (F.tid & 127), gg = n >> 8; const LAS float* dfr = DF + sub * 1024 + gg * 256; const bf16* wr = WTP + (size_t)gg * 65536 + (size_t)(n & 255) * 256;
            float acc = 0.f;
#pragma unroll 16
            for (int k0 = 0; k0 < 256; k0 += 8) { float wv[8]; ld8(wr + k0, wv); const f32x4 d0 = *(const LAS f32x4*)(dfr + k0), d1 = *(const LAS f32x4*)(dfr + k0 + 4);
                acc += (d0[0] * wv[0] + d0[1] * wv[1]) + (d0[2] * wv[2] + d0[3] * wv[3]) + (d1[0] * wv[4] + d1[1] * wv[5]) + (d1[2] * wv[6] + d1[3] * wv[7]); }
            const float gpv = bf1(((const GAS bf16*)pr)[1024 + n]), sc = ((const GAS float*)F.in[I_POOLS])[(size_t)i * DM + n];
            ((GAS bf16*)MIX)[row * DIN + n] = (bf16)f2bf(acc * sc * silu(gpv));
        }
        __syncthreads();
    }
}
DI void t_conv(Frame& F, int i) {
    const bf16* PROJ = (const bf16*)(F.ws + WS_PROJ); bf16* CONVX = (bf16*)(F.ws + WS_CONVX); float* DT = (float*)(F.ws + WS_DT);
    const int gt = F.vcu * 512 + F.tid, NGT = F.G * 512;
    const float* cwp = F.in[I_SCW] + (size_t)i * 4 * CONVD; const float* cbp = F.in[I_SCB] + (size_t)i * CONVD;
    for (int idx = gt; idx < (TP / 16) * 384; idx += NGT) {
        const int run = idx / 384, c8 = idx - run * 384, ch = c8 * 8, t0 = run * 16, tt0 = t0 & 2047, b = t0 >> 11;
        const bf16* pr0 = PROJ + (size_t)t0 * ODD_INP + 2048 + ch;
        float w0[8], w1[8], w2[8], w3[8], bb[8], x0[8], x1[8], x2[8];
        ld8f(cwp + ch, w0); ld8f(cwp + CONVD + ch, w1); ld8f(cwp + 2 * CONVD + ch, w2); ld8f(cwp + 3 * CONVD + ch, w3); ld8f(cbp + ch, bb);
        if (tt0 > 0) { ld8(pr0 - 3 * ODD_INP, x0); ld8(pr0 - 2 * ODD_INP, x1); ld8(pr0 - ODD_INP, x2); }
        else {
#pragma unroll
            for (int j = 0; j < 8; ++j) { x0[j] = 0.f; x1[j] = 0.f; x2[j] = 0.f; } }
        v4u xr[16];
#pragma unroll
        for (int k = 0; k < 16; ++k) xr[k] = *(const GAS v4u*)(pr0 + (size_t)k * ODD_INP);
#pragma unroll
        for (int k = 0; k < 16; ++k) {
            float x3[8], acc[8]; unpack8(xr[k], x3);
#pragma unroll
            for (int j = 0; j < 8; ++j) { acc[j] = silu(bb[j] + w0[j] * x0[j] + w1[j] * x1[j] + w2[j] * x2[j] + w3[j] * x3[j]); x0[j] = x1[j]; x1[j] = x2[j]; x2[j] = x3[j]; }
            st8(CONVX + (size_t)(t0 + k) * CONVD + ch, acc);
            const int tt = tt0 + k;
            if (tt >= SEQ - 3) st8f(F.out + OUT_SCP + ((size_t)(i * NBATCH + b) * 3 + (tt - (SEQ - 3))) * CONVD + ch, x3);
        }
    }
    for (int idx = gt; idx < NSMP * 384; idx += NGT) {
        const int bb = idx / 384, c8 = idx - bb * 384, ch = c8 * 8; const size_t row = TP + bb;
        const float* st = F.in[I_SSCONV] + ((size_t)(i * NSMP + bb) * 3) * CONVD + ch; float* so = F.out + OUT_SCS + ((size_t)(i * NSMP + bb) * 3) * CONVD + ch;
        float x3[8], s0[8], s1[8], s2[8], acc[8], w[8];
        ld8(PROJ + row * ODD_INP + 2048 + ch, x3); ld8f(st, s0); ld8f(st + CONVD, s1); ld8f(st + 2 * CONVD, s2);
        ld8f(cbp + ch, acc);
        ld8f(cwp + ch, w);
#pragma unroll
        for (int j = 0; j < 8; ++j) acc[j] += w[j] * s0[j];
        ld8f(cwp + CONVD + ch, w);
#pragma unroll
        for (int j = 0; j < 8; ++j) acc[j] += w[j] * s1[j];
        ld8f(cwp + 2 * CONVD + ch, w);
#pragma unroll
        for (int j = 0; j < 8; ++j) acc[j] += w[j] * s2[j];
        ld8f(cwp + 3 * CONVD + ch, w);
#pragma unroll
        for (int j = 0; j < 8; ++j) acc[j] = silu(acc[j] + w[j] * x3[j]);
        st8(CONVX + row * CONVD + ch, acc);
        st8f(so, s1); st8f(so + CONVD, s2); st8f(so + 2 * CONVD, x3);
    }
}
DI void t_gnorm(Frame& F, int i) {
    const int gw = F.vcu * NWAVES + F.wave, NGW = F.G * NWAVES;
    const bf16* YG = (const bf16*)(F.ws + WS_YG); bf16* MIX = (bf16*)(F.ws + WS_MIX); const float* nw = F.in[I_SNORM] + (size_t)i * DIN;
    for (int m = gw; m < MV; m += NGW) {
#pragma unroll
        for (int j = 0; j < 4; ++j) { float f[8], g[8]; const int ch = (F.lane + 64 * j) * 8;
            ld8(YG + (size_t)m * DIN + ch, f); float s = 0.f;
#pragma unroll
            for (int k = 0; k < 8; ++k) s += f[k] * f[k];
            const float rstd = 1.f / sqrtf(wave_sum(s) * (1.f / 512.f) + EPS);
            ld8f(nw + ch, g);
#pragma unroll
            for (int k = 0; k < 8; ++k) f[k] = f[k] * rstd * g[k];
            st8(MIX + (size_t)m * DIN + ch, f); }
    }
}
DI void t_sattn(Frame& F, int l) {
    const bf16* Q = (const bf16*)(F.ws + WS_Q); bf16* O = (bf16*)(F.ws + WS_O);
    LAS float* SC = (LAS float*)F.lds; LAS float* RED = (LAS float*)(F.lds + 4096);
    const int hd = F.lane >> 5, l32 = F.lane & 31;
    const float c2 = 0.0625f * 1.44269504089f;
#define SA_LOAD(buf, base, r0) do { _Pragma("unroll") for (int u = 0; u < 8; ++u) { buf[u][0] = *(const GAS f32x4*)((base) + (size_t)((r0) + u) * DM); buf[u][1] = *(const GAS f32x4*)((base) + (size_t)((r0) + u) * DM + 4); } } while (0)
#define SA_DOT(buf, r0) do { _Pragma("unroll") for (int u = 0; u < 8; ++u) { float d = (q[0] * buf[u][0][0] + q[1] * buf[u][0][1]) + (q[2] * buf[u][0][2] + q[3] * buf[u][0][3]) + (q[4] * buf[u][1][0] + q[5] * buf[u][1][1]) + (q[6] * buf[u][1][2] + q[7] * buf[u][1][3]); \
        _Pragma("unroll") for (int o = 1; o < 32; o <<= 1) d += __shfl_xor(d, o); if (l32 == 0) SC[hd * 256 + (r0) + u] = d; } } while (0)
#define SA_PV(buf, r0) do { _Pragma("unroll") for (int u = 0; u < 8; ++u) { const float p = __builtin_amdgcn_exp2f((SC[hd * 256 + (r0) + u] - mx) * c2) * inv; \
        acc[0] += p * buf[u][0][0]; acc[1] += p * buf[u][0][1]; acc[2] += p * buf[u][0][2]; acc[3] += p * buf[u][0][3]; acc[4] += p * buf[u][1][0]; acc[5] += p * buf[u][1][1]; acc[6] += p * buf[u][1][2]; acc[7] += p * buf[u][1][3]; } } while (0)
    for (int it = F.vcu; it < 256; it += F.G) {
        const int b = it >> 1, hp = it & 1, w0 = F.wave * 32;
        const float* Kc = F.in[I_CK] + ((size_t)(l * NSMP + b) * NMEM) * DM + hp * 512 + F.lane * 8;
        const float* Vc = F.in[I_CV] + ((size_t)(l * NSMP + b) * NMEM) * DM + hp * 512 + F.lane * 8;
        f32x4 A[8][2], B[8][2];
        SA_LOAD(A, Kc, w0); SA_LOAD(B, Kc, w0 + 8);
        float q[8]; ld8(Q + (size_t)(TP + b) * DM + hp * 512 + F.lane * 8, q);
        SA_DOT(A, w0); SA_LOAD(A, Kc, w0 + 16);
        SA_DOT(B, w0 + 8); SA_LOAD(B, Kc, w0 + 24);
        SA_DOT(A, w0 + 16); SA_LOAD(A, Vc, w0);
        SA_DOT(B, w0 + 24); SA_LOAD(B, Vc, w0 + 8);
        __syncthreads();
        float mx = -3.0e38f;
#pragma unroll
        for (int j = 0; j < 8; ++j) mx = fmaxf(mx, SC[hd * 256 + l32 * 8 + j]);
#pragma unroll
        for (int o = 1; o < 32; o <<= 1) mx = fmaxf(mx, __shfl_xor(mx, o));
        float sm = 0.f;
#pragma unroll
        for (int j = 0; j < 8; ++j) sm += __builtin_amdgcn_exp2f((SC[hd * 256 + l32 * 8 + j] - mx) * c2);
#pragma unroll
        for (int o = 1; o < 32; o <<= 1) sm += __shfl_xor(sm, o);
        const float inv = 1.0f / sm;
        float acc[8];
#pragma unroll
        for (int j = 0; j < 8; ++j) acc[j] = 0.f;
        SA_PV(A, w0); SA_LOAD(A, Vc, w0 + 16);
        SA_PV(B, w0 + 8); SA_LOAD(B, Vc, w0 + 24);
        SA_PV(A, w0 + 16); SA_PV(B, w0 + 24);
#pragma unroll
        for (int j = 0; j < 8; ++j) RED[F.wave * 512 + F.lane * 8 + j] = acc[j];
        __syncthreads();
        float o = 0.f;
#pragma unroll
        for (int w = 0; w < 8; ++w) o += RED[w * 512 + F.tid];
        ((GAS bf16*)O)[(size_t)(TP + b) * DM + hp * 512 + F.tid] = (bf16)f2bf(o);
        __syncthreads();
    }
#undef SA_LOAD
#undef SA_DOT
#undef SA_PV
}
struct MiniBf16 { bf16* O; int ldc; const unsigned long long* ssq;
    typedef unsigned long long Pre;
    DI Pre pre(size_t row, int) const { return ssq ? ((const GAS unsigned long long*)ssq)[row] : 0ull; }
    DI void operator()(const f32x4 acc, size_t row, int col, Pre sv) const { const float rs = ssq ? __builtin_amdgcn_rsqf((float)sv * (1.0f / (1024.0f * 1048576.0f)) + EPS) : 1.0f;
        *(GAS v2u*)(O + row * ldc + col) = (v2u){pk2(acc[0] * rs, acc[1] * rs), pk2(acc[2] * rs, acc[3] * rs)}; } };
struct MiniResAdd { bf16* Xb; unsigned long long* ssq;
    typedef v2u Pre;
    DI Pre pre(size_t row, int col) const { return *(const GAS v2u*)(Xb + row * 1024 + col); }
    DI void operator()(const f32x4 acc, size_t row, int col, Pre w) const { GAS v2u* p = (GAS v2u*)(Xb + row * 1024 + col);
        const float x[4] = {__uint_as_float(w[0] << 16) + acc[0], __uint_as_float(w[0] & 0xffff0000u) + acc[1], __uint_as_float(w[1] << 16) + acc[2], __uint_as_float(w[1] & 0xffff0000u) + acc[3]};
        *p = (v2u){pk2(x[0], x[1]), pk2(x[2], x[3])};
        float sq = (x[0] * x[0] + x[1] * x[1]) + (x[2] * x[2] + x[3] * x[3]); sq += __shfl_xor(sq, 16); sq += __shfl_xor(sq, 32);
        if ((col & 15) == 0) atomicAdd(ssq + row, (unsigned long long)(sq * 1048576.0f)); } };
struct MiniPoolState { float* out; const unsigned long long* ssq;
    typedef unsigned long long Pre;
    DI Pre pre(size_t row, int) const { return ((const GAS unsigned long long*)ssq)[row]; }
    DI void operator()(const f32x4 acc, size_t row, int col, Pre sv) const { const int b = (int)(row >> 11), j = (int)(row & 2047) - (SEQ - 15); if (j < 0) return;
        const float rs = __builtin_amdgcn_rsqf((float)sv * (1.0f / (1024.0f * 1048576.0f)) + EPS);
        *(GAS f32x4*)(out + ((size_t)b * 15 + j) * DM + col) = acc * rs; } };
struct MiniPoolGate { bf16* O; int ldc; const bf16* gate; int ldg; const float* scale;
    typedef int Pre; DI Pre pre(size_t, int) const { return 0; }
    DI void operator()(const f32x4 acc, size_t row, int c, Pre) const { const f32x4 sc = *(const GAS f32x4*)(scale + c); const v2u gw = *(const GAS v2u*)(gate + row * ldg + c);
        *(GAS v2u*)(O + row * ldc + c) = (v2u){pk2(acc[0] * sc[0] * silu(bflo(gw.x)), acc[1] * sc[1] * silu(bfhi(gw.x))), pk2(acc[2] * sc[2] * silu(bflo(gw.y)), acc[3] * sc[3] * silu(bfhi(gw.y)))}; } };
template <int KB  , class Epi> DI void mini_gemm(Frame& F, const bf16* A  , int lda, const bf16* Bt, int ldb, int K, int nCB, const Epi& E, int shift, const float* gssq = nullptr  , int rbase = TP, int rstride = 16  ) {
    const int NGW = F.G * NWAVES; int vc = F.vcu - shift; vc = vc < 0 ? vc + F.G : vc; const int gw = F.wave * F.G + vc;
    const int fr = F.lane & 15, fq = F.lane >> 4;
    for (int u = gw; u < 8 * nCB; u += NGW) {
        const int rb = u & 7, cb = u >> 3;
        const size_t grow = (size_t)rbase + (size_t)rb * rstride + fr;
        const bf16* ap = A + grow * lda + 8 * fq;
        const bf16* bp = Bt + (size_t)(16 * cb + fr) * ldb + 8 * fq;
        f32x4 acc = (f32x4){0.f, 0.f, 0.f, 0.f};
        const typename Epi::Pre epre = E.pre(grow, 16 * cb + 4 * fq);
        float rg[4] = {1.f, 1.f, 1.f, 1.f};
        if (gssq) { const GAS float* q = (const GAS float*)gssq + grow;
#pragma unroll
            for (int gi = 0; gi < 4; ++gi) { float a = 0.f;
#pragma unroll
                for (int e = 0; e < 8; ++e) a += q[(size_t)(gi * 8 + e) * MP];
                rg[gi] = 1.0f / sqrtf(a * (1.0f / 512.0f) + EPS); } }
        {
            const int ns = K >> 8;
            bf16x8 a[3][8], b[3][8];
#define MG_LOAD(buf, st) do { _Pragma("unroll") for (int s2 = 0; s2 < 8; ++s2) { a[buf][s2] = *(const GAS bf16x8*)(ap + (st) * 256 + 32 * s2); b[buf][s2] = *(const GAS bf16x8*)(bp + (st) * 256 + 32 * s2); } } while (0)
            MG_LOAD(0, 0); MG_LOAD(1, 1); MG_LOAD(2, 2);
#pragma unroll
            for (int st = 0; st < 8; ++st) if (st < ns) {
                if (gssq && st > 0 && (st & 1) == 0) { const int gi = st >> 1; acc = acc * (gi == 1 ? rg[0] / rg[1] : gi == 2 ? rg[1] / rg[2] : rg[2] / rg[3]); }
#pragma unroll
                for (int s2 = 0; s2 < 8; ++s2) acc = __builtin_amdgcn_mfma_f32_16x16x32_bf16(b[st % 3][s2], a[st % 3][s2], acc, 0, 0, 0);
                if (st + 3 < ns) MG_LOAD(st % 3, st + 3);
            }
#undef MG_LOAD
        }
        if (gssq) acc = acc * rg[3];
        E(acc, grow, 16 * cb + 4 * fq, epre);
    }
}

DI void dt_gemm(Frame& F, const bf16* A, const bf16* Bt  , const unsigned long long* ssq, float* out  , const float* dtb  ) {
    const int NGW = F.G * NWAVES, gw = F.wave * F.G + F.vcu, fr = F.lane & 15, fq = F.lane >> 4;
    for (int u = gw; u < MV / 16; u += NGW) {
        const size_t row = (size_t)u * 16 + fr;
        const bf16* ap = A + row * DM + 8 * fq; const bf16* bp0 = Bt + (size_t)fr * DM + 8 * fq; const bf16* bp1 = bp0 + 16 * DM;
        f32x4 acc0 = (f32x4){0.f, 0.f, 0.f, 0.f}, acc1 = acc0;
        {
            bf16x8 a[2][8], b0[2][8], b1[2][8];
#define DG_LOAD(buf, st) do { _Pragma("unroll") for (int s2 = 0; s2 < 8; ++s2) { a[buf][s2] = *(const GAS bf16x8*)(ap + (st) * 256 + 32 * s2); b0[buf][s2] = *(const GAS bf16x8*)(bp0 + (st) * 256 + 32 * s2); b1[buf][s2] = *(const GAS bf16x8*)(bp1 + (st) * 256 + 32 * s2); } } while (0)
            DG_LOAD(0, 0); DG_LOAD(1, 1);
#pragma unroll
            for (int st = 0; st < 4; ++st) {
#pragma unroll
                for (int s2 = 0; s2 < 8; ++s2) { acc0 = __builtin_amdgcn_mfma_f32_16x16x32_bf16(b0[st & 1][s2], a[st & 1][s2], acc0, 0, 0, 0); acc1 = __builtin_amdgcn_mfma_f32_16x16x32_bf16(b1[st & 1][s2], a[st & 1][s2], acc1, 0, 0, 0); }
                if (st + 2 < 4) DG_LOAD(st & 1, st + 2);
            }
#undef DG_LOAD
        }
        const float rs = 1.0f / sqrtf((float)((const GAS unsigned long long*)ssq)[row] * (1.0f / (1024.0f * 1048576.0f)) + EPS);
#pragma unroll
        for (int j = 0; j < 4; ++j) { const float x0 = acc0[j] * rs + ((const GAS float*)dtb)[4 * fq + j], x1 = acc1[j] * rs + ((const GAS float*)dtb)[16 + 4 * fq + j];
            ((GAS float*)out)[(size_t)(4 * fq + j) * MP + row] = x0 > 20.f ? x0 : log1pf(__expf(x0)); ((GAS float*)out)[(size_t)(16 + 4 * fq + j) * MP + row] = x1 > 20.f ? x1 : log1pf(__expf(x1)); }
    }
}

#define MFMA32(a, b, c) __builtin_amdgcn_mfma_f32_32x32x16_bf16((a), (b), (c), 0, 0, 0)
typedef short s16x4 __attribute__((ext_vector_type(4)));
constexpr int RS = 272;
DI bf16x8 frag_row(const LAS unsigned char* rowbase  , int ks) { return *(const LAS bf16x8*)(rowbase + ks * 32); }
DI bf16x8 frag_tr(const LAS unsigned char* trbase, int krow0, int c) {
    const s16x4 lo = __builtin_amdgcn_ds_read_tr16_b64_v4i16((LAS s16x4*)(trbase + krow0 * RS + c * 64));
    const s16x4 hi = __builtin_amdgcn_ds_read_tr16_b64_v4i16((LAS s16x4*)(trbase + (krow0 + 4) * RS + c * 64));
    return (bf16x8){lo[0], lo[1], lo[2], lo[3], hi[0], hi[1], hi[2], hi[3]};
}
DI void ssd_prompt_item(Frame& F, int i, int b, int head, float* ssqh) {
    LAS unsigned char* BM = F.lds;
    LAS unsigned char* CM = F.lds + 128 * RS;
    LAS unsigned char* LL = F.lds + 256 * RS;
    LAS unsigned char* XD = F.lds + 384 * RS;
    LAS unsigned char* SB = F.lds + 448 * RS;
    LAS unsigned char* XE = F.lds + 512 * RS;
    LAS float* DTL = (LAS float*)(F.lds + 576 * RS + 2048);
    LAS float* ACSB = (LAS float*)(F.lds + 576 * RS);
    const bf16* CONVX = (const bf16*)(F.ws + WS_CONVX); const bf16* PROJ = (const bf16*)(F.ws + WS_PROJ); const float* DT = (const float*)(F.ws + WS_DT); bf16* YG = (bf16*)(F.ws + WS_YG);
    const int w = F.wave, g = head >> 3, lb = w & 3, pb = w >> 2;
    const float Ah = -__expf(((const GAS float*)F.in[I_ALOG])[i * 32 + head]), Dh = ((const GAS float*)F.in[I_DSKIP])[i * 32 + head];
    f32x16 st;
#pragma unroll
    for (int k = 0; k < 16; ++k) st[k] = 0.f;
    for (int idx = F.tid; idx < 64 * RS / 16; idx += 512) *(LAS v4u*)(SB + idx * 16) = (v4u){0u, 0u, 0u, 0u};
    v4u vb[4], vc[4], vx[2], zt[2]; float dtx[2]; float d0 = 0.f, d1 = 0.f;
#define SSD_ISSUE(cc) do { const size_t r0_ = (size_t)b * SEQ + (size_t)(cc) * 128; \
        _Pragma("unroll") for (int i4 = 0; i4 < 4; ++i4) { const int q_ = F.tid + 512 * i4, s_ = q_ >> 4, ch_ = q_ & 15; const bf16* src_ = CONVX + (r0_ + s_) * CONVD + 2048 + g * 128 + ch_ * 8; \
            vb[i4] = *(const GAS v4u*)src_; vc[i4] = *(const GAS v4u*)(src_ + 512); } \
        _Pragma("unroll") for (int i2 = 0; i2 < 2; ++i2) { const int q_ = F.tid + 512 * i2, s_ = q_ >> 3, ch_ = q_ & 7; vx[i2] = *(const GAS v4u*)(CONVX + (r0_ + s_) * CONVD + head * 64 + ch_ * 8); \
            dtx[i2] = ((const GAS float*)DT)[(size_t)head * MP + r0_ + s_]; } \
        } while (0)
#define SSD_SCAN(cc) do { if (w == 0) { const int ln_ = F.lane; float a0 = d0 * Ah * 1.44269504089f, a1 = d1 * Ah * 1.44269504089f; \
        _Pragma("unroll") for (int o = 1; o < 64; o <<= 1) { const float t0 = __shfl_up(a0, o), t1 = __shfl_up(a1, o); if (ln_ >= o) { a0 += t0; a1 += t1; } } \
        a1 += __shfl(a0, 63); const float al_ = __shfl(a1, 63); LAS float* A_ = ACSB + ((cc) & 1) * 256; \
        A_[ln_] = a0; A_[ln_ + 64] = a1; A_[128 + ln_] = __builtin_amdgcn_exp2f(al_ - a0); A_[192 + ln_] = __builtin_amdgcn_exp2f(al_ - a1); } } while (0)
#define SSD_ISSUE_D(cc) do { const size_t r0_ = (size_t)b * SEQ + (size_t)(cc) * 128; d0 = ((const GAS float*)DT)[(size_t)head * MP + r0_ + F.lane]; d1 = ((const GAS float*)DT)[(size_t)head * MP + r0_ + 64 + F.lane]; } while (0)
#define SSD_ISSUE_Z(cc) do { const size_t r0_ = (size_t)b * SEQ + (size_t)(cc) * 128; _Pragma("unroll") for (int i2 = 0; i2 < 2; ++i2) { const int q_ = F.tid + 512 * i2; zt[i2] = *(const GAS v4u*)(PROJ + (r0_ + (q_ >> 3)) * ODD_INP + head * 64 + (q_ & 7) * 8); } } while (0)
    SSD_ISSUE(0); SSD_ISSUE_D(0); SSD_ISSUE_Z(0);
    SSD_SCAN(0);
    SSD_ISSUE_D(1);
    __syncthreads();
#define SSD_BAR() asm volatile("s_waitcnt lgkmcnt(0)\n\ts_barrier" ::: "memory")
    for (int c = 0; c < 16; ++c) {
        const size_t row0 = (size_t)b * SEQ + (size_t)c * 128;
        int tid = F.tid; asm volatile("" : "+v"(tid));
        const int lane = tid & 63, r = lane & 31, h = lane >> 5;
        LAS float* ACS = ACSB + (c & 1) * 256; LAS float* TE = ACS + 128;
#pragma unroll
        for (int i4 = 0; i4 < 4; ++i4) { const int q = tid + 512 * i4, s = q >> 4, ch = q & 15;
            *(LAS v4u*)(BM + s * RS + ch * 16) = vb[i4]; *(LAS v4u*)(CM + s * RS + ch * 16) = vc[i4]; }
        {
#pragma unroll
            for (int i2 = 0; i2 < 2; ++i2) { const int q = tid + 512 * i2, s = q >> 3, ch = q & 7;
                const float dts = dtx[i2], tes = TE[s]; float f[8]; unpack8(vx[i2], f);
                if (ch == 0) DTL[s] = dts;
#pragma unroll
                for (int j = 0; j < 8; ++j) f[j] *= dts;
                *(LAS v4u*)(XD + (s & 63) * RS + ((s >> 6) * 8 + ch) * 16) = pack8(f);
#pragma unroll
                for (int j = 0; j < 8; ++j) f[j] *= tes;
                *(LAS v4u*)(XE + (s & 63) * RS + ((s >> 6) * 8 + ch) * 16) = pack8(f); } }
        SSD_ISSUE((c + 1 < 16 ? c + 1 : 15));
        SSD_BAR();
        if (c + 1 < 16) SSD_SCAN(c + 1);
        SSD_ISSUE_D((c + 2 < 16 ? c + 2 : 15));
        const int rowoff = r * RS + 16 * h;
        const int troff = (8 * h + ((lane & 15) >> 2)) * RS + (2 * ((lane >> 4) & 1) + ((lane & 3) >> 1)) * 16 + 8 * (lane & 1);
        const int l = lb * 32 + r; const float al = ACS[l];
        const f32x16 zero16 = {0.f, 0.f, 0.f, 0.f, 0.f, 0.f, 0.f, 0.f, 0.f, 0.f, 0.f, 0.f, 0.f, 0.f, 0.f, 0.f};
#define SSD_CHAIN8(acc, first, AF, BF) do { _Pragma("unroll") for (int kb_ = 0; kb_ < 8; kb_ += 4) { bf16x8 fa_[4], fb_[4]; \
            _Pragma("unroll") for (int j_ = 0; j_ < 4; ++j_) { const int ks = kb_ + j_; fa_[j_] = AF; fb_[j_] = BF; } \
            __builtin_amdgcn_sched_barrier(0); \
            _Pragma("unroll") for (int j_ = 0; j_ < 4; ++j_) acc = MFMA32(fa_[j_], fb_[j_], (first && kb_ == 0 && j_ == 0) ? zero16 : acc); } } while (0)
#pragma unroll
        for (int bi = 0; bi < 2; ++bi) { const int sb = 2 * pb + bi;
            if (sb <= lb) {
                f32x16 cb;
                SSD_CHAIN8(cb, true, frag_row(BM + sb * 32 * RS + rowoff, ks), frag_row(CM + lb * 32 * RS + rowoff, ks));
                if (sb < lb) {
#pragma unroll
                    for (int k = 0; k < 16; ++k) { const int s0 = sb * 32 + (k & 3) + 8 * (k >> 2) + 4 * h; cb[k] = cb[k] * __builtin_amdgcn_exp2f(al - ACS[s0]); }
                } else {
#pragma unroll
                    for (int k = 0; k < 16; ++k) { const int s0 = sb * 32 + (k & 3) + 8 * (k >> 2) + 4 * h; cb[k] = cb[k] * (__builtin_amdgcn_exp2f(fminf(al - ACS[s0], 0.f)) * (s0 <= l ? 1.f : 0.f)); }
                }
#pragma unroll
                for (int q4 = 0; q4 < 4; ++q4) *(LAS v2u*)(LL + l * RS + (sb * 4 + q4) * 16 + 8 * h) = (v2u){pk2(cb[4 * q4], cb[4 * q4 + 1]), pk2(cb[4 * q4 + 2], cb[4 * q4 + 3])};
            } }
        f32x16 yo;
        SSD_CHAIN8(yo, true, frag_row(SB + pb * 32 * RS + rowoff, ks), frag_row(CM + lb * 32 * RS + rowoff, ks));
        { const float dec = __builtin_amdgcn_exp2f(ACS[127]);
#pragma unroll
          for (int k = 0; k < 16; ++k) st[k] *= dec; }
        SSD_CHAIN8(st, false, frag_tr(BM + troff, 16 * ks, lb), frag_tr(XE + troff, 16 * (ks & 3), 2 * (ks >> 2) + pb));
        SSD_BAR();
        f32x16 yd = zero16;
        for (int sbk = 0; sbk <= lb; ++sbk) { bf16x8 fx[2], fl[2];
#pragma unroll
            for (int j = 0; j < 2; ++j) { const int ks = 2 * sbk + j; fx[j] = frag_tr(XD + troff, 16 * (ks & 3), 2 * (ks >> 2) + pb); fl[j] = frag_row(LL + lb * 32 * RS + rowoff, ks); }
            __builtin_amdgcn_sched_barrier(0);
            yd = MFMA32(fx[0], fl[0], yd); yd = MFMA32(fx[1], fl[1], yd); }
#undef SSD_CHAIN8
        { const float el = __builtin_amdgcn_exp2f(al);
#pragma unroll
          for (int q4 = 0; q4 < 4; ++q4) { const int p0 = pb * 32 + 8 * q4 + 4 * h;
              *(LAS f32x4*)(BM + l * RS + p0 * 4) = (f32x4){yd[4 * q4] + el * yo[4 * q4], yd[4 * q4 + 1] + el * yo[4 * q4 + 1], yd[4 * q4 + 2] + el * yo[4 * q4 + 2], yd[4 * q4 + 3] + el * yo[4 * q4 + 3]}; } }
        SSD_BAR();
#pragma unroll
        for (int i2 = 0; i2 < 2; ++i2) { const int q = tid + 512 * i2, tk = q >> 3, c16 = q & 7;
            const f32x4 ya = *(const LAS f32x4*)(BM + tk * RS + c16 * 32), yb = *(const LAS f32x4*)(BM + tk * RS + c16 * 32 + 16);
            float xf[8], zf[8], f[8]; unpack8(*(const LAS v4u*)(XD + (tk & 63) * RS + ((tk >> 6) * 64 + c16 * 8) * 2), xf); unpack8(zt[i2], zf);
            { const float rdt = Dh * __builtin_amdgcn_rcpf(DTL[tk]);
#pragma unroll
              for (int j = 0; j < 8; ++j) xf[j] *= rdt; }
            f[0] = (ya[0] + xf[0]) * silu(zf[0]); f[1] = (ya[1] + xf[1]) * silu(zf[1]); f[2] = (ya[2] + xf[2]) * silu(zf[2]); f[3] = (ya[3] + xf[3]) * silu(zf[3]);
            f[4] = (yb[0] + xf[4]) * silu(zf[4]); f[5] = (yb[1] + xf[5]) * silu(zf[5]); f[6] = (yb[2] + xf[6]) * silu(zf[6]); f[7] = (yb[3] + xf[7]) * silu(zf[7]);
            *(GAS v4u*)(YG + (row0 + tk) * DIN + head * 64 + c16 * 8) = pack8(f);
            float sq = (f[0] * f[0] + f[1] * f[1]) + (f[2] * f[2] + f[3] * f[3]) + (f[4] * f[4] + f[5] * f[5]) + (f[6] * f[6] + f[7] * f[7]);
            sq += __shfl_xor(sq, 1); sq += __shfl_xor(sq, 2); sq += __shfl_xor(sq, 4);
            if (c16 == 0) ((GAS float*)ssqh)[(size_t)head * MP + row0 + tk] = sq; }
        SSD_ISSUE_Z((c + 1 < 16 ? c + 1 : 15));
        SSD_BAR();
        { const int p = pb * 32 + r;
#pragma unroll
          for (int q4 = 0; q4 < 4; ++q4) *(LAS v2u*)(SB + p * RS + (lb * 4 + q4) * 16 + 8 * h) = (v2u){pk2(st[4 * q4], st[4 * q4 + 1]), pk2(st[4 * q4 + 2], st[4 * q4 + 3])}; }
    }
#undef SSD_BAR
#undef SSD_ISSUE
#undef SSD_ISSUE_Z
#undef SSD_ISSUE_D
#undef SSD_SCAN
    { const int r = F.lane & 31, h = F.lane >> 5; const int p = pb * 32 + r; float* so = F.out + OUT_SP + (((size_t)(i * NBATCH + b) * NHEAD + head) * 64 + p) * 128;
#pragma unroll
      for (int q4 = 0; q4 < 4; ++q4) { const int n0 = lb * 32 + 8 * q4 + 4 * h; *(GAS f32x4*)(so + n0) = (f32x4){st[4 * q4], st[4 * q4 + 1], st[4 * q4 + 2], st[4 * q4 + 3]}; } }
    __syncthreads();
}
DI void ssd_sample(Frame& F, int i, float* ssqh) {
    const bf16* CONVX = (const bf16*)(F.ws + WS_CONVX); const bf16* PROJ = (const bf16*)(F.ws + WS_PROJ); const float* DT = (const float*)(F.ws + WS_DT); bf16* YG = (bf16*)(F.ws + WS_YG);
    const int gw = F.vcu * NWAVES + F.wave, NGW = F.G * NWAVES, psub = F.lane >> 5, n4 = (F.lane & 31) * 4;
    for (int it = gw; it < NSMP * NHEAD; it += NGW) {
        const int b = it >> 5, head = it & 31, g = head >> 3; const size_t row = TP + b;
        const size_t sbase = (((size_t)(i * NSMP + b) * NHEAD + head) * 64) * 128 + n4;
        const float* sin = F.in[I_SSSM] + sbase + (size_t)psub * 128; float* sout = F.out + OUT_SS + sbase + (size_t)psub * 128;
        f32x4 s0[32];
#pragma unroll
        for (int pp = 0; pp < 32; ++pp) s0[pp] = *(const GAS f32x4*)(sin + (size_t)pp * 256);
        const float dt = ((const GAS float*)DT)[(size_t)head * MP + row], Ah = -__expf(((const GAS float*)F.in[I_ALOG])[i * 32 + head]), Dh = ((const GAS float*)F.in[I_DSKIP])[i * 32 + head];
        const float dA = __expf(dt * Ah);
        const v2u bw = *(const GAS v2u*)(CONVX + row * CONVD + 2048 + g * 128 + n4), cw = *(const GAS v2u*)(CONVX + row * CONVD + 2560 + g * 128 + n4);
        const f32x4 B4 = (f32x4){bflo(bw.x), bfhi(bw.x), bflo(bw.y), bfhi(bw.y)}, C4 = (f32x4){bflo(cw.x), bfhi(cw.x), bflo(cw.y), bfhi(cw.y)};
        const float xl = bf1(((const GAS bf16*)CONVX)[row * CONVD + head * 64 + F.lane]), zl = bf1(((const GAS bf16*)PROJ)[row * ODD_INP + head * 64 + F.lane]);
        float sq = 0.f;
#pragma unroll
        for (int pp = 0; pp < 32; ++pp) { const int p = 2 * pp + psub;
            const float xe = __shfl(xl, 2 * pp), xo = __shfl(xl, 2 * pp + 1), xv = psub ? xo : xe, dx = dt * xv;
            const f32x4 sn = s0[pp] * dA + B4 * dx; *(GAS f32x4*)(sout + (size_t)pp * 256) = sn;
            float d = (sn[0] * C4[0] + sn[1] * C4[1]) + (sn[2] * C4[2] + sn[3] * C4[3]);
#pragma unroll
            for (int o = 1; o < 32; o <<= 1) d += __shfl_xor(d, o);
            const float ze = __shfl(zl, 2 * pp), zo = __shfl(zl, 2 * pp + 1), z = psub ? zo : ze;
            if ((F.lane & 31) == 0) { const float yv = (d + Dh * xv) * silu(z); sq += yv * yv; ((GAS bf16*)YG)[row * DIN + head * 64 + p] = (bf16)f2bf(yv); } }
        sq += __shfl_xor(sq, 32);
        if (F.lane == 0) ((GAS float*)ssqh)[(size_t)head * MP + row] = sq;
    }
}

#if MK_PER_PHASE
#define GRID_BAR() do { } while (0)
#else
#define GRID_BAR() do { for (int rb_ = 0; rb_ < REP_BAR; ++rb_) xcd_barrier(bar); } while (0)
#endif
#ifdef DBG_ONLY
#define IN(k) (lo <= (k) && (k) < hi && ((((k) < 2) ? (k) : 2 + ((k) - 2) % 11) == DBG_ONLY))
#else
#define IN(k) (lo <= (k) && (k) < hi)
#endif
#ifndef AMP_MASK
#define AMP_MASK 0
#endif
#if AMP_MASK
#define AMP_CLS(k) ((k) < 2 ? (k) : ((((k) - 2) % 11) == 0 ? 2 : (((k) - 2) % 11) == 1 ? 3 : (((k) - 2) % 11) == 2 ? 4 : (((k) - 2) % 11) == 4 ? 5 : (((k) - 2) % 11) == 6 ? 6 : (((k) - 2) % 11) == 7 ? 7 : (((k) - 2) % 11) == 9 ? 8 : 9))
#undef IN
#define IN(k) (lo <= (k) && (k) < hi && ((amp_t0 = __builtin_amdgcn_s_memrealtime()), true))
#define AMP_END(k) do { if ((AMP_MASK >> AMP_CLS(k)) & 1) { __syncthreads(); const unsigned long long t1_ = __builtin_amdgcn_s_memrealtime(); const unsigned long long d_ = t1_ - amp_t0; while (__builtin_amdgcn_s_memrealtime() - t1_ < d_) __builtin_amdgcn_s_sleep(4); } } while (0)
#else
#define AMP_END(k) do { } while (0)
#endif
#if AMP_MASK
#define AMP_SUB_BEGIN() unsigned long long amp_s0 = __builtin_amdgcn_s_memrealtime()
#define AMP_SUB_END(cls) do { if ((AMP_MASK >> (cls)) & 1) { __syncthreads(); const unsigned long long t1_ = __builtin_amdgcn_s_memrealtime(); const unsigned long long d_ = t1_ - amp_s0; while (__builtin_amdgcn_s_memrealtime() - t1_ < d_) __builtin_amdgcn_s_sleep(4); } } while (0)
#else
#define AMP_SUB_BEGIN() do { } while (0)
#define AMP_SUB_END(cls) do { } while (0)
#endif
#define SEAM(k) do { AMP_END(k); if ((k) + 1 < hi) GRID_BAR(); } while (0)
#define REFRESH() do { int t_ = threadIdx.x; asm volatile("" : "+v"(t_)); F.tid = t_; F.lane = t_ & 63; } while (0)
constexpr int PH_PER_LAYER = 11, PH_LAYER0 = 2, N_PHASES = PH_LAYER0 + 4 * PH_PER_LAYER;
template <int l> DI void layer_phases(Frame& F, const int lo, const int hi, const XcdBarrier& bar) {
#if AMP_MASK
    unsigned long long amp_t0 = 0;
#endif
    unsigned char* ws = F.ws;
    LAS unsigned char* ring = F.lds;
    bf16* H = (bf16*)(ws + WS_H); bf16* Qb = (bf16*)(ws + WS_Q); bf16* Pb = (bf16*)(ws + WS_PB); bf16* Ob = (bf16*)(ws + WS_O); bf16* DIFF = (bf16*)(ws + WS_DIFF);
    bf16* MIX = (bf16*)(ws + WS_MIX); bf16* PROJ = (bf16*)(ws + WS_PROJ);
    const int c = (int)blockIdx.x;

    constexpr int pb = PH_LAYER0 + l * PH_PER_LAYER, i = l >> 1; constexpr bool evn = (l & 1) == 0;
    unsigned long long* SSQ = (unsigned long long*)(ws + WS_SSQ);
    constexpr size_t SSQ_I = (size_t)MV;
        if (IN(pb + 0)) {
            constexpr int N = evn ? EVEN_IN : ODD_INP;
            pg8::Gemm g{H, evn ? (const bf16*)(ws + WS_WTE_IN) + (size_t)i * EVEN_IN * DM : (const bf16*)(ws + WS_WTO_IN) + (size_t)i * ODD_WROWS * DM, DM, DM, DM};
            pg8::StaticOrder S; S.init(64, N / 256, F.G, c);
            if constexpr (evn) { pg8::EpiEvenIn E{PROJ, SSQ + (2 * l) * SSQ_I};
                for (int rep = 0; rep < REP_G1; ++rep) pg8::gemm_phase<pg8::EpiEvenIn, pg8::AddrStd, true, true>(ring, g, S, E, pg8::AddrStd{}); }
            else { pg8::EpiBf16S E{PROJ, N, SSQ + (2 * l) * SSQ_I};
                for (int rep = 0; rep < REP_G1; ++rep) pg8::gemm_phase<pg8::EpiBf16S, pg8::AddrStd, true, true>(ring, g, S, E, pg8::AddrStd{}); }
            REFRESH();
            if constexpr (evn) {
                const bf16* WTU = (const bf16*)(ws + WS_WTU) + (size_t)i * DM * DM;
                for (int rep = 0; rep < REP_MINI; ++rep) {
                bf16* PS = PROJ + (size_t)TP * EVEN_P - (size_t)TP * EVEN_IN;
                mini_gemm<16>(F, H, DM, WTU, DM, DM, 64, MiniBf16{PS, N, SSQ + (2 * l) * SSQ_I}, 0);
                mini_gemm<16>(F, H, DM, g.Bt + (size_t)1024 * DM, DM, DM, (N - 1024) / 16, MiniBf16{PS + 1024, N, SSQ + (2 * l) * SSQ_I}, 64);
                mini_gemm<16>(F, H, DM, WTU, DM, DM, 64, MiniPoolState{F.out + OUT_PP + (size_t)i * NBATCH * 15 * DM, SSQ + (2 * l) * SSQ_I}, 128, nullptr, SEQ - 16, SEQ); }
            } else {
                for (int rep = 0; rep < REP_MINI; ++rep) mini_gemm<16>(F, H, DM, g.Bt, DM, DM, N / 16, MiniBf16{PROJ, N, SSQ + (2 * l) * SSQ_I}, 0);
                dt_gemm(F, H, g.Bt + (size_t)ODD_INP * DM, SSQ + (2 * l) * SSQ_I, (float*)(ws + WS_DT), F.in[I_DTB] + (size_t)i * 32);
            }
            SEAM(pb + 0);
        }
        if (IN(pb + 1)) { REFRESH(); for (int rep = 0; rep < REP_THIN; ++rep) { if constexpr (evn) t_even_mix(F, i); else t_conv(F, i); } SEAM(pb + 1); }
        if constexpr (!evn) if (IN(pb + 2)) {
                REFRESH();
                const bool stream_first = (F.vcu & 1) != 0;
                if (stream_first) { for (int rep = 0; rep < REP_SSDS; ++rep) ssd_sample(F, i, rep == 0 ? (float*)(ws + WS_SSQH) + (size_t)i * 32 * MP : (float*)(ws + WS_DIFF)); __syncthreads(); }
                for (int rep = 0; rep < REP_SSD; ++rep) for (int it = F.vcu; it < NBATCH * NHEAD; it += F.G) ssd_prompt_item(F, i, it >> 5, it & 31, rep == 0 ? (float*)(ws + WS_SSQH) + (size_t)i * 32 * MP : (float*)(ws + WS_DIFF));
                if (!stream_first) { REFRESH(); for (int rep = 0; rep < REP_SSDS; ++rep) ssd_sample(F, i, rep == 0 ? (float*)(ws + WS_SSQH) + (size_t)i * 32 * MP : (float*)(ws + WS_DIFF)); }
            SEAM(pb + 2);
        }
        if (IN(pb + 4)) {
            bf16* YGb = (bf16*)(ws + WS_YG); const float* GSSQ = (const float*)(ws + WS_SSQH) + (size_t)i * 32 * MP;
            pg8::Gemm g{evn ? MIX : YGb, evn ? (const bf16*)(ws + WS_WTE_OUT) + (size_t)i * DM * 2048 : (const bf16*)(ws + WS_WTO_OUT) + (size_t)i * DM * 2048, DIN, DIN, DIN};
            pg8::StaticOrder S; S.init(64, 4, F.G, c);
            pg8::EpiResAdd E{H, SSQ + (2 * l + 1) * SSQ_I, 0};
            pg8::EpiResAdd E0{H, SSQ, hi > 9999 ? 0 : 1};
            if constexpr (evn) {
                for (int rep = 1; rep < REP_RES; ++rep) pg8::gemm_phase<pg8::EpiResAdd, pg8::AddrStd, true, true>(ring, g, S, E0, pg8::AddrStd{});
                pg8::gemm_phase<pg8::EpiResAdd, pg8::AddrStd, true, true>(ring, g, S, E, pg8::AddrStd{});
                REFRESH(); mini_gemm<16>(F, MIX, DIN, g.Bt, DIN, DIN, 64, MiniResAdd{H, SSQ + (2 * l + 1) * SSQ_I}, 0);
            } else {
                for (int rep = 1; rep < REP_RES; ++rep) pg8::gemm_phase<pg8::EpiResAdd, pg8::AddrStd, true, true, true>(ring, g, S, E0, pg8::AddrStd{}, GSSQ);
                pg8::gemm_phase<pg8::EpiResAdd, pg8::AddrStd, true, true, true>(ring, g, S, E, pg8::AddrStd{}, GSSQ);
                REFRESH(); mini_gemm<16>(F, YGb, DIN, g.Bt, DIN, DIN, 64, MiniResAdd{H, SSQ + (2 * l + 1) * SSQ_I}, 0, GSSQ);
            }
            SEAM(pb + 4);
        }
        if (IN(pb + 6)) {
            pg8::Gemm g{H, (const bf16*)(ws + WS_WTQ) + (size_t)l * DM * DM, DM, DM, DM};
            pg8::StaticOrder S; S.init(64, 4, F.G, c);
            pg8::EpiBf16S E{Qb, DM, SSQ + (2 * l + 1) * SSQ_I};
            for (int rep = 0; rep < REP_G4; ++rep) pg8::gemm_phase<pg8::EpiBf16S, pg8::AddrStd, true, true>(ring, g, S, E, pg8::AddrStd{});
            REFRESH(); for (int rep = 0; rep < REP_MINI; ++rep) mini_gemm<16>(F, H, DM, g.Bt, DM, DM, 64, MiniBf16{Qb, DM, SSQ + (2 * l + 1) * SSQ_I}, 0);
            SEAM(pb + 6);
        }
        if (IN(pb + 7)) {
            const bool stream_first = (F.vcu & 1) != 0;
            if (stream_first) { REFRESH(); AMP_SUB_BEGIN(); for (int rep = 0; rep < REP_SATTN; ++rep) t_sattn(F, l); __syncthreads(); AMP_SUB_END(10); }
            { pg8::Gemm g{Qb, (const bf16*)(ws + WS_KB) + (size_t)l * 2048 * DM, DM, DM, 256};
              pg8::StaticOrder S; S.init(64, 4, F.G, c);
              pg8::EpiSoftmax E{Pb, DM, 0.0625f * 1.44269504089f};
              for (int rep = 0; rep < REP_G5; ++rep) { pg8::gemm_phase<pg8::EpiSoftmax, pg8::AddrScore, false, true>(ring, g, S, E, pg8::AddrScore{}); __syncthreads(); } }
            asm volatile("s_waitcnt vmcnt(0)" ::: "memory"); __syncthreads();
            { pg8::Gemm g{Pb, (const bf16*)(ws + WS_VT) + (size_t)l * 8 * 1024 * 256, DM, 256, 256};
              pg8::StaticOrder S; S.init(64, 4, F.G, c);
              pg8::EpiBf16S E{Ob, DM, nullptr};
              for (int rep = 0; rep < REP_G6; ++rep) pg8::gemm_phase<pg8::EpiBf16S, pg8::AddrPV, true, true>(ring, g, S, E, pg8::AddrPV{}); }
            __syncthreads();
            if (!stream_first) { REFRESH(); AMP_SUB_BEGIN(); for (int rep = 0; rep < REP_SATTN; ++rep) t_sattn(F, l); AMP_SUB_END(10); }
            SEAM(pb + 7);
        }
        if (IN(pb + 9)) {
            pg8::Gemm g{Ob, (const bf16*)(ws + WS_WTO) + (size_t)l * DM * DM, DM, DM, DM};
            pg8::StaticOrder S; S.init(64, 4, F.G, c);
            pg8::EpiResAdd E{H, SSQ + (2 * l + 2) * SSQ_I, 0};
            for (int rep = 1; rep < REP_RES; ++rep) { pg8::EpiResAdd E0{H, SSQ, hi > 9999 ? 0 : 1}; pg8::gemm_phase<pg8::EpiResAdd, pg8::AddrStd, true, true>(ring, g, S, E0, pg8::AddrStd{}); }
            pg8::gemm_phase<pg8::EpiResAdd, pg8::AddrStd, true, true>(ring, g, S, E, pg8::AddrStd{});
            REFRESH(); mini_gemm<16>(F, Ob, DM, g.Bt, DM, DM, 64, MiniResAdd{H, SSQ + (2 * l + 2) * SSQ_I}, 0);
            SEAM(pb + 9);
        }
        if constexpr (l == 3) if (IN(pb + 10)) { REFRESH(); t_norm(F, F.in[I_NFIN], true); SEAM(pb + 10); }
}
__global__ void __launch_bounds__(NWAVES * 64, 2) trunk_fwd(Args args) {
    extern __shared__ __attribute__((aligned(16))) unsigned char lds[];
    Frame F;
    F.lds = (LAS unsigned char*)lds;
    F.tid = threadIdx.x; F.lane = F.tid & 63; F.wave = __builtin_amdgcn_readfirstlane(F.tid >> 6);
    F.G = gridDim.x; { const int bx = blockIdx.x; F.vcu = (F.G % 8 == 0) ? (bx % 8) * (F.G / 8) + bx / 8 : bx; }
    F.in = args.in; F.out = args.out; F.ws = args.ws;
    unsigned char* ws = args.ws;
    volatile LAS unsigned* MISC = (volatile LAS unsigned*)(F.lds + MISC_OFF);
    if (F.tid < 32) MISC[F.tid] = 0u;
    __syncthreads();
#if MK_PER_PHASE
    XcdBarrier bar; bar.bar = (unsigned*)(ws + WS_CTL) + CW_BAR; bar.x = 0; bar.st = MISC + 8;
#else
    XcdBarrier bar = xcd_barrier_post((unsigned*)(ws + WS_CTL) + CW_BAR, MISC + 8);
#endif
    const int lo = args.ph_lo, hi = args.ph_hi;
    LAS unsigned char* ring = F.lds;
    const int c = (int)blockIdx.x;

#if AMP_MASK
    unsigned long long amp_t0 = 0;
#endif
    if (IN(0)) { REFRESH(); for (int rep = 0; rep < REP_P0; ++rep) p0_prologue(F); SEAM(0); }
    if (IN(1)) {
        for (int rep = 0; rep < REP_P1; ++rep) {
        { pg8::Gemm g{(const bf16*)(ws + WS_MEMB), (const bf16*)(ws + WS_WTK), DM, DM, DM}; pg8::StaticOrder S; S.init(8, 16, F.G, c);
          pg8::EpiKproj E{F.out + OUT_MK, (bf16*)(ws + WS_KB)};
          pg8::gemm_phase<pg8::EpiKproj, pg8::AddrStd, true, true>(ring, g, S, E, pg8::AddrStd{}); }
        { pg8::Gemm g{(const bf16*)(ws + WS_WTV), (const bf16*)(ws + WS_MEMB), DM, DM, DM}; pg8::StaticOrder S; S.init(16, 8, F.G, (c + F.G / 2) % F.G);
          pg8::EpiVT E{F.out + OUT_MV, (bf16*)(ws + WS_VT)};
          pg8::gemm_phase<pg8::EpiVT, pg8::AddrStd, true, true>(ring, g, S, E, pg8::AddrStd{}); }
        }
        SEAM(1);
    }
    layer_phases<0>(F, lo, hi, bar); layer_phases<1>(F, lo, hi, bar); layer_phases<2>(F, lo, hi, bar); layer_phases<3>(F, lo, hi, bar);
#undef IN
#undef SEAM
}

extern "C" void kernel_launch(void* const* d_in, const int* in_sizes, int n_in, void* d_out, int out_size, void* d_ws, size_t ws_size, hipStream_t stream) {
    static int grid = 0;
    if (grid == 0) {
        if (n_in != 29 || (size_t)out_size != OUT_TOTAL || ws_size < WS_END) { fprintf(stderr, "kernel_launch: unexpected shapes: n_in %d out %d ws %zu (need %zu)\n", n_in, out_size, ws_size, (size_t)WS_END); grid = -1; return; }
        if (hipFuncSetAttribute((const void*)trunk_fwd, hipFuncAttributeMaxDynamicSharedMemorySize, LDS_BYTES) != hipSuccess) { fprintf(stderr, "kernel_launch: hipFuncSetAttribute failed\n"); grid = -1; return; }
        int dev = 0, cus = 0;
        if (hipGetDevice(&dev) != hipSuccess || hipDeviceGetAttribute(&cus, hipDeviceAttributeMultiprocessorCount, dev) != hipSuccess) { grid = -1; return; }
        (void)hipGetLastError();
        grid = cus < 256 ? cus : 256;
        if (grid != 256) fprintf(stderr, "kernel_launch: %d CUs; this kernel is built for a 256-CU grid\n", cus);
    }
    if (grid < 0) return;
    (void)hipMemsetAsync((char*)d_ws + WS_CTL, 0, CTL_ZERO_BYTES, stream);
    Args a{};
    for (int i = 0; i < 29; ++i) a.in[i] = (const float*)d_in[i];
    a.out = (float*)d_out; a.ws = (unsigned char*)d_ws;
#if MK_PER_PHASE
    for (int p = 0; p < N_PHASES; ++p) {
        if (p >= PH_LAYER0) { const int l = (p - PH_LAYER0) / PH_PER_LAYER, k = (p - PH_LAYER0) % PH_PER_LAYER; if (k == 3 || k == 5 || k == 8 || (k == 2 && (l & 1) == 0) || (k == 10 && l != 3)) continue; }
        a.ph_lo = p; a.ph_hi = p + 1;
        hipLaunchKernelGGL(trunk_fwd, dim3(grid), dim3(NWAVES * 64), LDS_BYTES, stream, a);
    }
#else
    a.ph_lo = 0; a.ph_hi = N_PHASES;
    hipLaunchKernelGGL(trunk_fwd, dim3(grid), dim3(NWAVES * 64), LDS_BYTES, stream, a);
#endif
}
```
